# Optimizing an MI355X kernel written in HIP

```python
import jax, jax.numpy as jnp
from jax import lax
import numpy as np

D_MODEL = 2048
BATCH = 4
SEQ = 2048
DEPTH = 2

GRID_W = 64
CTX_LEN = 256
HEAD_DIM = 128
A_Q_HEADS = 8
A_KV_HEADS = 2
WINDOW = 128
A_BLOCK = 128
ROPE_THETA = 10000.0
GLA_HEADS = 4
GLA_DK = 128
GLA_DV = 256
GLA_RANK = 16
GLA_TAU = 16.0
GLA_CHUNK = 64
CONV_WIDTH = 3
CONV_INNER = D_MODEL
N_EXPERTS = 32
N_GROUPS = 4
TOP_K = 2
D_EXPERT = 1024
MOE_BLOCK = 128

EPS = 1e-6
NEG_INF = -1e30
A_Q_DIM = A_Q_HEADS * HEAD_DIM
A_KV_DIM = A_KV_HEADS * HEAD_DIM
GLA_K_DIM = GLA_HEADS * GLA_DK
GLA_V_DIM = GLA_HEADS * GLA_DV
ATTN_SPLIT_SIZES = (A_Q_DIM, A_KV_DIM, A_KV_DIM, GLA_K_DIM, GLA_K_DIM, GLA_V_DIM, GLA_V_DIM, 2 * GLA_RANK)
ATTN_IN_DIM = sum(ATTN_SPLIT_SIZES)
MIX_DIM = A_Q_DIM + GLA_V_DIM
N_ATTN_LAYERS = (DEPTH + 1) // 2
N_CONV_LAYERS = DEPTH // 2

kernel_name = "hybrid_prefix_dit_block"


def rms_norm(x, gain=None):
    xf = x.astype(jnp.float32)
    y = xf * lax.rsqrt(jnp.mean(xf * xf, axis=-1, keepdims=True) + EPS)
    if gain is not None:
        y = y * gain.astype(jnp.float32)
    return y.astype(x.dtype)


def ada_modulation(cond, w, b):
    m = jax.nn.silu(cond) @ w + b
    return jnp.split(m[..., None, :], 6, axis=-1)


def modulate(x, shift, scale):
    return rms_norm(x) * (1 + scale) + shift


def axial_rope_tables(n):
    rows = n // GRID_W
    f = HEAD_DIM // 4
    inv_freq = ROPE_THETA ** (-jnp.arange(f, dtype=jnp.float32) / f)
    r = jnp.broadcast_to(jnp.arange(rows, dtype=jnp.float32)[:, None], (rows, GRID_W)).reshape(n)
    col = jnp.broadcast_to(jnp.arange(GRID_W, dtype=jnp.float32)[None, :], (rows, GRID_W)).reshape(n)
    ang = jnp.stack([r, col], axis=-1)[..., None] * inv_freq
    return jnp.cos(ang), jnp.sin(ang)


def apply_axial_rope(x, cos, sin):
    b, n, h, d = x.shape
    xr = x.astype(jnp.float32).reshape(b, n, h, 2, 2, d // 4)
    x1, x2 = xr[..., 0, :], xr[..., 1, :]
    cs, sn = cos[None, :, None], sin[None, :, None]
    out = jnp.stack([x1 * cs - x2 * sn, x2 * cs + x1 * sn], axis=-2)
    return out.reshape(b, n, h, d).astype(x.dtype)


def band_blocks(t, nb):
    tp = jnp.pad(t, ((0, 0), (A_BLOCK, A_BLOCK), (0, 0), (0, 0)))
    tp = tp.reshape(t.shape[0], nb + 2, A_BLOCK, t.shape[2], t.shape[3])
    return jnp.concatenate([tp[:, :-2], tp[:, 1:-1], tp[:, 2:]], axis=2)


def windowed_sink_attention(q, k, v, k_ctx, v_ctx, sink):
    B, S, H, _ = q.shape
    L = k_ctx.shape[1]
    nb = S // A_BLOCK
    G = H // A_KV_HEADS
    qb = q.reshape(B, nb, A_BLOCK, A_KV_HEADS, G, HEAD_DIM)
    kw, vw = band_blocks(k, nb), band_blocks(v, nb)
    scale = HEAD_DIM ** -0.5
    s_win = jnp.einsum('bnqkgd,bnjkd->bnkgqj', qb, kw, preferred_element_type=jnp.float32) * scale
    s_ctx = jnp.einsum('bnqkgd,bjkd->bnkgqj', qb, k_ctx, preferred_element_type=jnp.float32) * scale
    qi = jnp.arange(A_BLOCK)[:, None]
    kj = jnp.arange(3 * A_BLOCK)[None, :]
    kpos = (jnp.arange(nb)[:, None, None] - 1) * A_BLOCK + kj[None]
    band = (jnp.abs(kj - A_BLOCK - qi) <= WINDOW)[None] & (kpos >= 0) & (kpos < S)
    s_win = jnp.where(band[None, :, None, None], s_win, NEG_INF)
    sink_l = jnp.broadcast_to(sink.astype(jnp.float32).reshape(A_KV_HEADS, G)[None, None, :, :, None, None],
                              s_win.shape[:-1] + (1,))
    p = jax.nn.softmax(jnp.concatenate([s_ctx, s_win, sink_l], axis=-1), axis=-1).astype(v.dtype)
    out = (jnp.einsum('bnkgqj,bjkd->bnqkgd', p[..., :L], v_ctx)
           + jnp.einsum('bnkgqj,bnjkd->bnqkgd', p[..., L:L + 3 * A_BLOCK], vw))
    return out.reshape(B, S, H * HEAD_DIM)


def context_sink_attention(q, k, v, sink):
    B, L, H, _ = q.shape
    G = H // A_KV_HEADS
    qg = q.reshape(B, L, A_KV_HEADS, G, HEAD_DIM)
    s = jnp.einsum('blkgd,bjkd->bkglj', qg, k, preferred_element_type=jnp.float32) * HEAD_DIM ** -0.5
    sink_l = jnp.broadcast_to(sink.astype(jnp.float32).reshape(A_KV_HEADS, G)[None, :, :, None, None],
                              s.shape[:-1] + (1,))
    p = jax.nn.softmax(jnp.concatenate([s, sink_l], axis=-1), axis=-1)[..., :L].astype(v.dtype)
    return jnp.einsum('bkglj,bjkd->blkgd', p, v).reshape(B, L, H * HEAD_DIM)


def gla_chunked(q, k, v, log_a, s0):
    b, n, h, _ = q.shape
    nc = n // GLA_CHUNK
    def to_chunks(t):
        return jnp.moveaxis(t.reshape(b, nc, GLA_CHUNK, h, t.shape[-1]), 1, 0)
    incl = jnp.tril(jnp.ones((GLA_CHUNK, GLA_CHUNK), dtype=bool))
    def step(s, inp):
        qc, kc, vc, ac = inp
        bcum = jnp.cumsum(ac, axis=1)
        blast = bcum[:, -1:]
        qf = qc.astype(jnp.float32) * jnp.exp(bcum)
        kf = kc.astype(jnp.float32) * jnp.exp(-bcum)
        kl = kc.astype(jnp.float32) * jnp.exp(blast - bcum)
        vf = vc.astype(jnp.float32)
        att = jnp.where(incl, jnp.einsum('bihd,bjhd->bhij', qf, kf), 0.0)
        o = jnp.einsum('bhij,bjhe->bihe', att, vf) + jnp.einsum('bihd,bhde->bihe', qf, s)
        s_new = jnp.exp(blast[:, 0])[..., None] * s + jnp.einsum('bjhd,bjhe->bhde', kl, vf)
        return s_new, o
    s_fin, o = lax.scan(step, s0, (to_chunks(q), to_chunks(k), to_chunks(v), to_chunks(log_a)))
    o = jnp.moveaxis(o, 0, 1).reshape(b, n, h, -1)
    return o.astype(v.dtype), s_fin


def gla_bidirectional(ctx_qkv, lat_qkv, la_ctx, la_lat):
    qc, kc, vc = ctx_qkv
    ql, kl, vl = lat_qkv
    s0 = jnp.zeros((ql.shape[0], GLA_HEADS, GLA_DK, GLA_DV), jnp.float32)
    rev = lambda t: t[:, ::-1]
    o_cf, s_cf = gla_chunked(qc, kc, vc, la_ctx[0], s0)
    o_lf, _ = gla_chunked(ql, kl, vl, la_lat[0], s_cf)
    o_cb, s_cb = gla_chunked(rev(qc), rev(kc), rev(vc), rev(la_ctx[1]), s0)
    o_lb, _ = gla_chunked(rev(ql), rev(kl), rev(vl), rev(la_lat[1]), s_cb)
    return o_lf + rev(o_lb), o_cf + rev(o_cb)


def hybrid_attn_gla(h_lat, h_ctx, cos, sin, w_in, q_gain, k_gain, sink, wa2, ba, o_gain, w_out, ctx_live):
    B, S, _ = h_lat.shape
    L = h_ctx.shape[1]
    idx = np.cumsum(ATTN_SPLIT_SIZES)[:-1].tolist()
    aq_l, ak_l, av_l, gq_l, gk_l, gv_l, gg_l, lr_l = jnp.split(h_lat @ w_in, idx, axis=-1)
    aq_c, ak_c, av_c, gq_c, gk_c, gv_c, gg_c, lr_c = jnp.split(h_ctx @ w_in, idx, axis=-1)
    heads = lambda t, h: t.reshape(t.shape[0], t.shape[1], h, -1)

    q_l = apply_axial_rope(rms_norm(heads(aq_l, A_Q_HEADS), q_gain), cos, sin)
    k_l = apply_axial_rope(rms_norm(heads(ak_l, A_KV_HEADS), k_gain), cos, sin)
    k_c = rms_norm(heads(ak_c, A_KV_HEADS), k_gain)
    v_l, v_c = heads(av_l, A_KV_HEADS), heads(av_c, A_KV_HEADS)
    attn_l = windowed_sink_attention(q_l, k_l, v_l, k_c, v_c, sink)

    def gla_inputs(gq, gk, gv, lr):
        q = heads(gq, GLA_HEADS) * GLA_DK ** -0.5
        las = [(jax.nn.log_sigmoid((lr_d @ wa2[d] + ba[d]).astype(jnp.float32)) / GLA_TAU)
               .reshape(lr.shape[0], lr.shape[1], GLA_HEADS, GLA_DK)
               for d, lr_d in enumerate(jnp.split(lr, 2, axis=-1))]
        return (q, heads(gk, GLA_HEADS), heads(gv, GLA_HEADS)), las
    qkv_l, la_l = gla_inputs(gq_l, gk_l, gv_l, lr_l)
    qkv_c, la_c = gla_inputs(gq_c, gk_c, gv_c, lr_c)
    o_l, o_c = gla_bidirectional(qkv_c, qkv_l, la_c, la_l)
    gla_out = lambda o, g: (rms_norm(o, o_gain) * jax.nn.silu(heads(g, GLA_HEADS))).reshape(o.shape[0], o.shape[1], GLA_V_DIM)

    mix_lat = jnp.concatenate([attn_l, gla_out(o_l, gg_l)], axis=-1) @ w_out
    mix_ctx = None
    if ctx_live:
        q_c = rms_norm(heads(aq_c, A_Q_HEADS), q_gain)
        attn_c = context_sink_attention(q_c, k_c, v_c, sink)
        mix_ctx = jnp.concatenate([attn_c, gla_out(o_c, gg_c)], axis=-1) @ w_out
    return mix_lat, mix_ctx


def short_gated_conv(h, w_in, w_conv, w_out):
    gb, gc, u = jnp.split(h @ w_in, 3, axis=-1)
    y = lax.conv_general_dilated(gc * u, w_conv[:, None, :], window_strides=(1,), padding=[(1, 1)],
                                 dimension_numbers=('NWC', 'WIO', 'NWC'), feature_group_count=CONV_INNER)
    return (gb * y) @ w_out


def grouped_moe(h, router_w, router_b, w1, w3, w2):
    T, D = h.shape
    gsz = N_EXPERTS // N_GROUPS
    scores = jax.nn.sigmoid((h @ router_w).astype(jnp.float32))
    grp = (scores + router_b.astype(jnp.float32)).reshape(T, N_GROUPS, gsz)
    gsel = jnp.argmax(lax.top_k(grp, TOP_K)[0].sum(-1), axis=-1)
    in_grp = jnp.take_along_axis(grp, gsel[:, None, None], axis=1)[:, 0]
    eidx = gsel[:, None] * gsz + lax.top_k(in_grp, TOP_K)[1]
    wsel = jnp.take_along_axis(scores, eidx, axis=1)
    wsel = wsel / jnp.sum(wsel, axis=-1, keepdims=True)

    A = T * TOP_K
    e_flat = eidx.reshape(A)
    tok_flat = jnp.repeat(jnp.arange(T), TOP_K)
    order = jnp.argsort(e_flat)
    e_s, tok_s, w_s = e_flat[order], tok_flat[order], wsel.reshape(A)[order]
    counts = jnp.bincount(e_flat, length=N_EXPERTS)
    starts = jnp.cumsum(counts) - counts
    pcounts = (counts + MOE_BLOCK - 1) // MOE_BLOCK * MOE_BLOCK
    pends = jnp.cumsum(pcounts)
    dest = (pends - pcounts)[e_s] + (jnp.arange(A) - starts[e_s])
    nblk = -(-A // MOE_BLOCK) + N_EXPERTS
    P = nblk * MOE_BLOCK
    slot_tok = jnp.zeros((P,), jnp.int32).at[dest].set(tok_s)
    slot_w = jnp.zeros((P,), jnp.float32).at[dest].set(w_s)
    blk_exp = jnp.minimum(jnp.sum(jnp.arange(nblk)[:, None] * MOE_BLOCK >= pends[None, :], axis=1), N_EXPERTS - 1)

    def expert_block(args):
        xb, e = args
        return (jax.nn.silu(xb @ w1[e]) * (xb @ w3[e])) @ w2[e]
    yb = lax.map(expert_block, (h[slot_tok].reshape(nblk, MOE_BLOCK, D), blk_exp))
    y = yb.reshape(P, D) * slot_w[:, None].astype(h.dtype)
    return jnp.zeros_like(h).at[slot_tok].add(y)


def setup_inputs(seed: int = 0) -> dict:
    key = jax.random.key(seed)
    ks = jax.random.split(key, 24)
    nrm = lambda k, shape, s: jax.random.normal(k, shape, jnp.float32) * s
    D = D_MODEL
    return {
        'x': nrm(ks[0], (BATCH, SEQ, D), 1.0),
        'c': nrm(ks[1], (BATCH, D), 1.0),
        'ctx': nrm(ks[2], (BATCH, CTX_LEN, D), 1.0),
        'c_ctx': nrm(ks[3], (D,), 1.0),
        'mod_w': nrm(ks[4], (DEPTH, D, 6 * D), 0.5 * D ** -0.5),
        'mod_b': nrm(ks[5], (DEPTH, 6 * D), 0.02),
        'attn_w_in': nrm(ks[6], (N_ATTN_LAYERS, D, ATTN_IN_DIM), D ** -0.5),
        'attn_q_norm': 1.0 + nrm(ks[7], (N_ATTN_LAYERS, HEAD_DIM), 0.02),
        'attn_k_norm': 1.0 + nrm(ks[8], (N_ATTN_LAYERS, HEAD_DIM), 0.02),
        'attn_sink': nrm(ks[9], (N_ATTN_LAYERS, A_Q_HEADS), 0.5),
        'gla_wa2': nrm(ks[10], (N_ATTN_LAYERS, 2, GLA_RANK, GLA_K_DIM), GLA_RANK ** -0.5),
        'gla_ba': nrm(ks[11], (N_ATTN_LAYERS, 2, GLA_K_DIM), 0.5),
        'gla_norm': 1.0 + nrm(ks[12], (N_ATTN_LAYERS, GLA_DV), 0.02),
        'attn_w_out': nrm(ks[13], (N_ATTN_LAYERS, MIX_DIM, D), MIX_DIM ** -0.5),
        'conv_w_in': nrm(ks[14], (N_CONV_LAYERS, D, 3 * CONV_INNER), D ** -0.5),
        'conv_w': nrm(ks[15], (N_CONV_LAYERS, CONV_WIDTH, CONV_INNER), CONV_WIDTH ** -0.5),
        'conv_w_out': nrm(ks[16], (N_CONV_LAYERS, CONV_INNER, D), CONV_INNER ** -0.5),
        'router_w': nrm(ks[17], (D, N_EXPERTS), D ** -0.5),
        'router_b': nrm(ks[18], (N_EXPERTS,), 0.01),
        'exp_w1': nrm(ks[19], (DEPTH, N_EXPERTS, D, D_EXPERT), D ** -0.5),
        'exp_w3': nrm(ks[20], (DEPTH, N_EXPERTS, D, D_EXPERT), D ** -0.5),
        'exp_w2': nrm(ks[21], (DEPTH, N_EXPERTS, D_EXPERT, D), D_EXPERT ** -0.5),
    }


def reference(x, c, ctx, c_ctx, mod_w, mod_b, attn_w_in, attn_q_norm, attn_k_norm, attn_sink,
              gla_wa2, gla_ba, gla_norm, attn_w_out, conv_w_in, conv_w, conv_w_out,
              router_w, router_b, exp_w1, exp_w3, exp_w2):
    B, S, D = x.shape
    L = ctx.shape[1]
    cos, sin = axial_rope_tables(S)
    for layer in range(DEPTH):
        ctx_live = any(j % 2 == 0 for j in range(layer + 1, DEPTH))
        m_lat = ada_modulation(c, mod_w[layer], mod_b[layer])
        m_ctx = ada_modulation(c_ctx, mod_w[layer], mod_b[layer])
        h_lat = modulate(x, m_lat[0], m_lat[1])
        i = layer // 2
        if layer % 2 == 0:
            h_ctx = modulate(ctx, m_ctx[0], m_ctx[1])
            mix_lat, mix_ctx = hybrid_attn_gla(h_lat, h_ctx, cos, sin, attn_w_in[i], attn_q_norm[i], attn_k_norm[i],
                                               attn_sink[i], gla_wa2[i], gla_ba[i], gla_norm[i], attn_w_out[i], ctx_live)
        else:
            mix_lat = short_gated_conv(h_lat, conv_w_in[i], conv_w[i], conv_w_out[i])
            mix_ctx = None
            if ctx_live:
                mix_ctx = short_gated_conv(modulate(ctx, m_ctx[0], m_ctx[1]), conv_w_in[i], conv_w[i], conv_w_out[i])
        x = x + m_lat[2] * mix_lat
        if ctx_live:
            ctx = ctx + m_ctx[2] * mix_ctx
        h2_lat = modulate(x, m_lat[3], m_lat[4]).reshape(B * S, D)
        if ctx_live:
            h2_ctx = modulate(ctx, m_ctx[3], m_ctx[4]).reshape(B * L, D)
            y = grouped_moe(jnp.concatenate([h2_lat, h2_ctx], axis=0), router_w, router_b,
                            exp_w1[layer], exp_w3[layer], exp_w2[layer])
            x = x + m_lat[5] * y[:B * S].reshape(B, S, D)
            ctx = ctx + m_ctx[5] * y[B * S:].reshape(B, L, D)
        else:
            y = grouped_moe(h2_lat, router_w, router_b, exp_w1[layer], exp_w3[layer], exp_w2[layer])
            x = x + m_lat[5] * y.reshape(B, S, D)
    return x
```

```cpp
#include <hip/hip_runtime.h>
#include <cstdio>
#include <cstdint>

#ifndef MK_N_LAUNCHES
#define MK_N_LAUNCHES 1
#endif

#define GAS __attribute__((address_space(1)))
#define LAS __attribute__((address_space(3)))
typedef unsigned short bf16;
typedef short bf16x8 __attribute__((ext_vector_type(8)));
typedef float f32x4 __attribute__((ext_vector_type(4)));
typedef float f32x2 __attribute__((ext_vector_type(2)));
typedef unsigned u32x4 __attribute__((ext_vector_type(4)));
typedef unsigned u32x2 __attribute__((ext_vector_type(2)));

constexpr int D = 2048, BATCH = 4, SEQ = 2048, CTXL = 256;
constexpr int TL = BATCH * SEQ;
constexpr int TC = BATCH * CTXL;
constexpr int TA = TL + TC;
constexpr int NPROJ = 4864;
constexpr int C_AQ = 0, C_AK = 1024, C_AV = 1280, C_GQ = 1536, C_GK = 2048, C_GV = 2560, C_GG = 3584, C_LR = 4608;
constexpr int NEXP = 32, DEXP = 1024;
constexpr float EPS = 1e-6f;

constexpr size_t MiB = 1u << 20;
constexpr size_t WS_CTL = 0, CTL_ZERO_BYTES = 128 * 1024;
constexpr size_t WS_MOD = 1 * MiB;
constexpr size_t WS_ROUTE = 2 * MiB;
constexpr size_t WS_LIST = 3 * MiB;
constexpr size_t WS_RWT_HI = 6 * MiB;
constexpr size_t WS_RWT_LO = 7 * MiB;
constexpr size_t WS_RBIAS = 1 * MiB + 512 * 1024;
constexpr size_t WS_WIN_T = 8 * MiB;
constexpr size_t WS_WOUT_T = 28 * MiB;
constexpr size_t WS_CIN_T = 36 * MiB;
constexpr size_t WS_COUT_T = 60 * MiB;
constexpr size_t WS_W13_T = 68 * MiB;
constexpr size_t WS_W2_T = 580 * MiB;
constexpr size_t WS_HA = 836 * MiB;
constexpr size_t WS_PROJ = 872 * MiB;
constexpr size_t WS_LA = 958 * MiB;
constexpr size_t WS_VTL = 994 * MiB;
constexpr size_t WS_VTC = 998 * MiB;
constexpr size_t WS_OG = 1000 * MiB;
constexpr size_t WS_MIX = 1064 * MiB;
constexpr size_t WS_X1 = 1096 * MiB;
constexpr size_t WS_HMID = 1160 * MiB;
constexpr size_t WS_Y = 1208 * MiB;
constexpr size_t WS_X2 = 1304 * MiB;
constexpr size_t WS_GB = 1368 * MiB;
constexpr size_t WS_PGU = 1400 * MiB;
constexpr size_t WS_Z = 1432 * MiB;
constexpr size_t WS_X3 = 1464 * MiB;
constexpr size_t WS_QF = 1528 * MiB;
constexpr size_t WS_KLT = 1546 * MiB;
constexpr size_t WS_ATT = 1564 * MiB;
constexpr size_t WS_VT = 1573 * MiB;
constexpr size_t WS_DEC = 1609 * MiB;
constexpr size_t WS_END = 1610 * MiB;
constexpr int CW_BAR = 4096;
constexpr int CW_CNT = 8192;
constexpr int CW_CVT = 16384;
constexpr int CW_P0 = 16384 + 512;

constexpr int RING_BYTES = 131072;
constexpr int LDS_MISC = RING_BYTES;
constexpr int LDS_PB = RING_BYTES + 256;
constexpr int LDS_TOK = RING_BYTES + 1024;
constexpr int LDS_BYTES = 147456;

__device__ __forceinline__ float bf2f(unsigned short b) { return __uint_as_float(((unsigned)b) << 16); }
__device__ __forceinline__ unsigned cvt_pk_bf16(float lo, float hi) { unsigned r; asm volatile("v_cvt_pk_bf16_f32 %0, %1, %2" : "=v"(r) : "v"(lo), "v"(hi)); return r; }
__device__ __forceinline__ float wave_sum(float v) {
#pragma unroll
    for (int o = 1; o < 64; o <<= 1) v += __shfl_xor(v, o);
    return v;
}
__device__ __forceinline__ float silu_f(float v) { return v / (1.0f + __expf(-v)); }
__device__ __forceinline__ f32x4 bf4_to_f32(u32x2 w) { f32x4 r; r[0] = __uint_as_float(w.x << 16); r[1] = __uint_as_float(w.x & 0xffff0000u); r[2] = __uint_as_float(w.y << 16); r[3] = __uint_as_float(w.y & 0xffff0000u); return r; }
__device__ __forceinline__ u32x2 f32_to_bf4(f32x4 v) { u32x2 w; w.x = cvt_pk_bf16(v[0], v[1]); w.y = cvt_pk_bf16(v[2], v[3]); return w; }
__device__ __forceinline__ void mfma_settle(f32x4& a) { asm volatile("s_nop 7\n\ts_nop 7" : "+v"(a)); }
__device__ __forceinline__ unsigned f2bf_sw(float f) { const unsigned u = __float_as_uint(f); return (u + 0x7fffu + ((u >> 16) & 1u)) >> 16; }
__device__ __forceinline__ u32x2 f32_to_bf4_sw(f32x4 v) { u32x2 w; w.x = f2bf_sw(v[0]) | (f2bf_sw(v[1]) << 16); w.y = f2bf_sw(v[2]) | (f2bf_sw(v[3]) << 16); return w; }

namespace pg8 {
constexpr int BM = 256, BK = 64, HALF = 128, HTB = HALF * BK * 2, STAGE_BYTES = 8 * HTB, NXCD = 8, WGM = 8;
__host__ __device__ __forceinline__ int lds_byte(int r, int c) { const int st = (r >> 4) * 2 + (c >> 5), rr = r & 15, cc = c & 31, ob = rr * 64 + cc * 2; return st * 1024 + (ob ^ (((ob >> 9) & 1) << 5)); }
__host__ __device__ __forceinline__ void stage_rc(int b, int& R, int& C) { const int st = b / 1024, sb = b % 1024, swz = sb ^ (((sb >> 9) & 1) << 5); R = (st >> 1) * 16 + swz / 64; C = (st & 1) * 32 + (swz % 64) / 2; }
__host__ __device__ __forceinline__ int perm32(int rho) { const int n = rho >> 4, i = rho & 15; return 8 * (i >> 2) + 4 * n + (i & 3); }

struct Unit { int pm, pn, e; };
struct Gemm { const bf16* A; const bf16* Bt; int K; };

struct StaticOrder {
    static constexpr bool GATHER = false;
    int nM, nN, nwg, G, c, ilo, ihi;
    __device__ void init(int M, int N, int G_, int c_) { nM = M / BM; nN = N / BM; nwg = nM * nN; G = G_; c = c_; ilo = 0; ihi = 1 << 30; }
    __device__ bool next(int i0, Unit& u) const {
        const int i = i0 + ilo; if (i >= ihi) return false;
        const long L = (long)i * G + c; if (L >= nwg) return false;
        int wgid = (int)L; { const int q = nwg / NXCD, r = nwg % NXCD, xcd = wgid % NXCD, off = wgid / NXCD; wgid = (xcd < r ? xcd * (q + 1) : r * (q + 1) + (xcd - r) * q) + off; }
        const int nig = WGM * nN, gid = wgid / nig, fm = gid * WGM, gsz = (nM - fm) < WGM ? (nM - fm) : WGM;
        u.pm = fm + ((wgid % nig) % gsz); u.pn = (wgid % nig) / gsz; u.e = 0; return true;
    }
    __device__ __forceinline__ const char* b_ptr(const Gemm& g, const Unit& u, size_t tstep) const { return (const char*)g.Bt + (size_t)u.pn * tstep; }
    __device__ __forceinline__ unsigned tok(int, int) const { return 0u; }
};
template <bool GATHER_> struct MoeOrder {
    static constexpr bool GATHER = GATHER_;
    const LAS int* pb; const LAS int* tokt; int G, c, nN; size_t estride;
    __device__ bool next(int i, Unit& u) const {
        const int L = i * G + c; const int total = pb[32] * nN; if (L >= total) return false;
        int e = 0;
#pragma unroll 1
        for (int j = 1; j < 32; ++j) if (pb[j] * nN <= L) e = j;
        const int r = L - pb[e] * nN, np = pb[e + 1] - pb[e];
        u.e = e; u.pn = r / np; u.pm = pb[e] + (r % np); return true;
    }
    __device__ __forceinline__ const char* b_ptr(const Gemm& g, const Unit& u, size_t tstep) const { return (const char*)g.Bt + (size_t)u.e * estride + (size_t)u.pn * tstep; }
    __device__ __forceinline__ unsigned tok(int ui, int r) const { return (unsigned)tokt[(ui & 3) * 256 + r]; }
};

struct EpiBf16 {
    static constexpr bool PERM = true;
    bf16* O; int ldc;
    __device__ __forceinline__ void operator()(const f32x4 (&acc)[2][2][4][2], const Unit& u, int wr, int wc, int fr, int fq) const {
        const int row0 = u.pm * BM + wr * 64 + fr, col0 = u.pn * BM + wc * 32 + 8 * fq;
        { f32x4 t = acc[1][1][3][1]; mfma_settle(t); }
#pragma unroll
        for (int ai = 0; ai < 2; ++ai)
#pragma unroll
            for (int m = 0; m < 4; ++m) { bf16* rowp = O + (size_t)(row0 + ai * HALF + m * 16) * ldc + col0;
#pragma unroll
                for (int bj = 0; bj < 2; ++bj) { const f32x4 v0 = acc[ai][bj][m][0], v1 = acc[ai][bj][m][1];
                    u32x4 w; w.x = cvt_pk_bf16(v0[0], v0[1]); w.y = cvt_pk_bf16(v0[2], v0[3]); w.z = cvt_pk_bf16(v1[0], v1[1]); w.w = cvt_pk_bf16(v1[2], v1[3]);
                    *(u32x4*)(rowp + bj * HALF) = w; } }
    }
};
template <bool SILU> struct EpiPair {
    static constexpr bool PERM = true;
    bf16* O; int ldo; int pn0; bf16* P; int ldp;
    __device__ __forceinline__ void operator()(const f32x4 (&acc)[2][2][4][2], const Unit& u, int wr, int wc, int fr, int fq) const {
        const int row0 = u.pm * BM + wr * 64 + fr;
        { f32x4 t = acc[1][1][3][1]; mfma_settle(t); }
        if (u.pn < pn0) {
            const int col0 = u.pn * BM + wc * 32 + 8 * fq;
#pragma unroll
            for (int ai = 0; ai < 2; ++ai)
#pragma unroll
                for (int m = 0; m < 4; ++m) { bf16* rowp = P + (size_t)(row0 + ai * HALF + m * 16) * ldp + col0;
#pragma unroll
                    for (int bj = 0; bj < 2; ++bj) { const f32x4 v0 = acc[ai][bj][m][0], v1 = acc[ai][bj][m][1];
                        u32x4 w; w.x = cvt_pk_bf16(v0[0], v0[1]); w.y = cvt_pk_bf16(v0[2], v0[3]); w.z = cvt_pk_bf16(v1[0], v1[1]); w.w = cvt_pk_bf16(v1[2], v1[3]);
                        *(u32x4*)(rowp + bj * HALF) = w; } }
        } else {
            const int col0 = (u.pn - pn0) * HALF + wc * 32 + 8 * fq;
#pragma unroll
            for (int ai = 0; ai < 2; ++ai)
#pragma unroll
                for (int m = 0; m < 4; ++m) { bf16* rowp = O + (size_t)(row0 + ai * HALF + m * 16) * ldo + col0;
                    f32x4 g0 = acc[ai][0][m][0], g1 = acc[ai][0][m][1]; const f32x4 u0 = acc[ai][1][m][0], u1 = acc[ai][1][m][1];
                    if (SILU) {
#pragma unroll
                        for (int j = 0; j < 4; ++j) { g0[j] = silu_f(g0[j]); g1[j] = silu_f(g1[j]); } }
                    g0 = g0 * u0; g1 = g1 * u1;
                    u32x4 w; w.x = cvt_pk_bf16(g0[0], g0[1]); w.y = cvt_pk_bf16(g0[2], g0[3]); w.z = cvt_pk_bf16(g1[0], g1[1]); w.w = cvt_pk_bf16(g1[2], g1[3]);
                    *(u32x4*)rowp = w; }
        }
    }
};
template <bool BASE_BF16> struct EpiResGate {
    static constexpr bool PERM = false;
    const void* base; bf16* out; const float* gate; int gstride;
    __device__ __forceinline__ void operator()(const f32x4 (&acc)[2][2][4][2], const Unit& u, int wr, int wc, int fr, int fq) const {
        const int row0 = u.pm * BM + wr * 64 + fr, col0 = u.pn * BM + wc * 32 + 4 * fq;
        const float* gp = gate + (size_t)((u.pm * BM) / SEQ) * gstride + col0;
        f32x4 gv[2][2];
#pragma unroll
        for (int bj = 0; bj < 2; ++bj)
#pragma unroll
            for (int n = 0; n < 2; ++n) gv[bj][n] = *(const f32x4*)(gp + bj * HALF + n * 16);
#pragma unroll
        for (int ai = 0; ai < 2; ++ai)
#pragma unroll
            for (int m = 0; m < 4; ++m) { const size_t off = (size_t)(row0 + ai * HALF + m * 16) * D + col0;
#pragma unroll
                for (int bj = 0; bj < 2; ++bj)
#pragma unroll
                    for (int n = 0; n < 2; ++n) { const size_t o = off + bj * HALF + n * 16;
                        const f32x4 bs = BASE_BF16 ? bf4_to_f32(*(const u32x2*)((const bf16*)base + o)) : *(const f32x4*)((const float*)base + o);
                        *(u32x2*)(out + o) = f32_to_bf4(bs + gv[bj][n] * acc[ai][bj][m][n]); } }
    }
};

template <class Epi, class Sched, bool ALIGN_EPI>
__device__ __forceinline__ void gemm_phase(LAS unsigned char* lds, const Gemm g, const Sched& S, const Epi& E) {
    const int tid = threadIdx.x, wid = __builtin_amdgcn_readfirstlane(tid >> 6), lane = tid & 63, wr = wid >> 2, wc = wid & 3, fr = lane & 15, fq = lane >> 4;
    const int K = g.K, nt = K / BK;
    unsigned voffA[2], voffB[2]; int stR[2], stC[2];
#pragma unroll
    for (int i = 0; i < 2; ++i) { int R, C; stage_rc(tid * 16 + i * 8192, R, C); const int Rb = Epi::PERM ? ((R & ~31) + perm32(R & 31)) : R;
        stR[i] = R; stC[i] = C; voffA[i] = (unsigned)(R * K + C) * 2u; voffB[i] = (unsigned)(Rb * K + C) * 2u; }
    const size_t kstep = (size_t)(BK * 2);
    const size_t hstep = (size_t)HALF * K * 2;
    const size_t tstep = 2 * hstep;
    const unsigned ldsw = (unsigned)wid * 1024u;
    const int aoff = lds_byte(wr * 64 + fr, fq * 8), boff = lds_byte(wc * 32 + fr, fq * 8);
#define PG8_SA(b, h) (((b) * 2 + (h)) * HTB)
#define PG8_SB(b, h) ((4 + (b) * 2 + (h)) * HTB)
#define PG8_STAGE(bufoff, gbase, voff) do { _Pragma("unroll") for (int _i = 0; _i < 2; ++_i) \
        __builtin_amdgcn_global_load_lds((const unsigned*)((const char*)(gbase) + (voff)[_i]), (LAS unsigned*)(lds + (bufoff) + ldsw + _i * 8192), 16, 0, 0); } while (0)
#define PG8_STAGE_A(bufoff, h, ubase, kb, vo) do { if constexpr (Sched::GATHER) { PG8_STAGE(bufoff, (const char*)g.A + (kb), (vo)[h]); } else { PG8_STAGE(bufoff, (ubase) + (h) * hstep + (kb), voffA); } } while (0)
#define PG8_LDA(dst, b, h) do { _Pragma("unroll") for (int m = 0; m < 4; ++m) _Pragma("unroll") for (int k = 0; k < 2; ++k) dst[m][k] = *(const LAS bf16x8*)(lds + PG8_SA(b, h) + aoff + m * 2048 + k * 1024); } while (0)
#define PG8_LDB(dst, b, h) do { _Pragma("unroll") for (int n = 0; n < 2; ++n) _Pragma("unroll") for (int k = 0; k < 2; ++k) dst[n][k] = *(const LAS bf16x8*)(lds + PG8_SB(b, h) + boff + n * 2048 + k * 1024); } while (0)
#define PG8_MMA(ai, bj, At, Bt) do { __builtin_amdgcn_s_setprio(1); _Pragma("unroll") for (int m = 0; m < 4; ++m) _Pragma("unroll") for (int n = 0; n < 2; ++n) _Pragma("unroll") for (int k = 0; k < 2; ++k) \
        acc[ai][bj][m][n] = __builtin_amdgcn_mfma_f32_16x16x32_bf16(Bt[n][k], At[m][k], acc[ai][bj][m][n], 0, 0, 0); __builtin_amdgcn_s_setprio(0); } while (0)
#define PG8_WAIT_V(n) asm volatile("s_waitcnt vmcnt(" #n ")" ::: "memory")
#define PG8_WAIT_L(n) asm volatile("s_waitcnt lgkmcnt(" #n ")" ::: "memory")
#define PG8_BAR __builtin_amdgcn_s_barrier()
#define PG8_SCHED __builtin_amdgcn_sched_barrier(0)
    Unit cur, nxt; int ui = 0;
    if (!S.next(0, cur)) return;
    f32x4 acc[2][2][4][2];
#pragma unroll
    for (int a = 0; a < 2; ++a)
#pragma unroll
        for (int b = 0; b < 2; ++b)
#pragma unroll
            for (int m = 0; m < 4; ++m)
#pragma unroll
                for (int n = 0; n < 2; ++n) acc[a][b][m][n] = (f32x4){0.f, 0.f, 0.f, 0.f};
    bf16x8 At[4][2], B0[2][2], B1[2][2];
    const char* cA = (const char*)g.A + (size_t)cur.pm * tstep; const char* cB = S.b_ptr(g, cur, tstep);
    unsigned voC[2][2] = {{0u, 0u}, {0u, 0u}};
    if constexpr (Sched::GATHER) {
#pragma unroll
        for (int h = 0; h < 2; ++h)
#pragma unroll
            for (int i = 0; i < 2; ++i) voC[h][i] = (S.tok(0, h * HALF + stR[i]) * (unsigned)K + (unsigned)stC[i]) * 2u;
    }
    PG8_STAGE(PG8_SB(0, 0), cB, voffB); PG8_STAGE(PG8_SB(0, 1), cB + hstep, voffB); PG8_STAGE_A(PG8_SA(0, 0), 0, cA, 0, voC); PG8_STAGE_A(PG8_SA(0, 1), 1, cA, 0, voC);
    if (wr == 1) PG8_BAR;
    PG8_WAIT_V(2); PG8_BAR;
    PG8_STAGE(PG8_SB(1, 0), cB + kstep, voffB); PG8_STAGE_A(PG8_SA(1, 0), 0, cA, kstep, voC); PG8_STAGE(PG8_SB(1, 1), cB + hstep + kstep, voffB);
    PG8_WAIT_V(6); PG8_BAR;
    for (;;) {
        const bool has_next = S.next(ui + 1, nxt);
        const char* nA = has_next ? (const char*)g.A + (size_t)nxt.pm * tstep : cA; const char* nB = has_next ? S.b_ptr(g, nxt, tstep) : cB;
        for (int t = 0; t < nt; t += 2) {
            const bool last = (t == nt - 2);
            const char* a1 = cA; const size_t k1 = (size_t)(t + 1) * kstep;
            const char* a2 = last ? nA : cA; const size_t k2 = last ? 0 : (size_t)(t + 2) * kstep; const char* b2 = last ? nB : cB + (size_t)(t + 2) * kstep;
            const size_t k3 = k2 + kstep; const char* b3 = b2 + kstep;
            unsigned vo2[2][2] = {{0u, 0u}, {0u, 0u}};
            if constexpr (Sched::GATHER) {
                if (last && has_next) {
#pragma unroll
                    for (int h = 0; h < 2; ++h)
#pragma unroll
                        for (int i = 0; i < 2; ++i) vo2[h][i] = (S.tok(ui + 1, h * HALF + stR[i]) * (unsigned)K + (unsigned)stC[i]) * 2u;
                } else {
#pragma unroll
                    for (int h = 0; h < 2; ++h)
#pragma unroll
                        for (int i = 0; i < 2; ++i) vo2[h][i] = voC[h][i];
                }
            }
            PG8_LDB(B0, 0, 0); PG8_LDB(B1, 0, 1); PG8_SCHED; PG8_LDA(At, 0, 0); PG8_STAGE_A(PG8_SA(1, 1), 1, a1, k1, voC);
            PG8_WAIT_V(8); PG8_WAIT_L(0); PG8_BAR; PG8_MMA(0, 0, At, B0); PG8_MMA(0, 1, At, B1); PG8_BAR; PG8_SCHED;
            PG8_LDA(At, 0, 1); PG8_STAGE(PG8_SB(0, 0), b2, voffB); PG8_STAGE(PG8_SB(0, 1), b2 + hstep, voffB); PG8_STAGE_A(PG8_SA(0, 0), 0, a2, k2, vo2);
            PG8_WAIT_V(8); PG8_WAIT_L(0); PG8_BAR; PG8_MMA(1, 0, At, B0); PG8_MMA(1, 1, At, B1); PG8_BAR; PG8_SCHED;
            PG8_LDB(B0, 1, 0); PG8_LDB(B1, 1, 1); PG8_SCHED; PG8_LDA(At, 1, 0); PG8_STAGE_A(PG8_SA(0, 1), 1, a2, k2, vo2);
            PG8_WAIT_V(8); PG8_WAIT_L(0); PG8_BAR; PG8_MMA(0, 0, At, B0); PG8_MMA(0, 1, At, B1); PG8_BAR; PG8_SCHED;
            PG8_LDA(At, 1, 1); PG8_STAGE(PG8_SB(1, 0), b3, voffB); PG8_STAGE(PG8_SB(1, 1), b3 + hstep, voffB); PG8_STAGE_A(PG8_SA(1, 0), 0, a2, k3, vo2);
            PG8_WAIT_V(8); PG8_WAIT_L(0); PG8_BAR; PG8_MMA(1, 0, At, B0); PG8_MMA(1, 1, At, B1); PG8_BAR; PG8_SCHED;
            if constexpr (Sched::GATHER) { if (last) {
#pragma unroll
                for (int h = 0; h < 2; ++h)
#pragma unroll
                    for (int i = 0; i < 2; ++i) voC[h][i] = vo2[h][i]; } }
        }
        if constexpr (ALIGN_EPI) { if (wr == 0) PG8_BAR; }
        E(acc, cur, wr, wc, fr, fq);
        if (!has_next) break;
#pragma unroll
        for (int a = 0; a < 2; ++a)
#pragma unroll
            for (int b = 0; b < 2; ++b)
#pragma unroll
                for (int m = 0; m < 4; ++m)
#pragma unroll
                    for (int n = 0; n < 2; ++n) acc[a][b][m][n] = (f32x4){0.f, 0.f, 0.f, 0.f};
        cur = nxt; cA = nA; cB = nB; ++ui;
        if constexpr (ALIGN_EPI) { if (wr == 1) PG8_BAR; }
    }
    PG8_WAIT_V(0);
    if constexpr (!ALIGN_EPI) { if (wr == 0) PG8_BAR; }
    PG8_BAR;
#undef PG8_SA
#undef PG8_SB
#undef PG8_STAGE
#undef PG8_STAGE_A
#undef PG8_LDA
#undef PG8_LDB
#undef PG8_MMA
#undef PG8_WAIT_V
#undef PG8_WAIT_L
#undef PG8_BAR
#undef PG8_SCHED
}
}

#define XB_TMO      128
#define XB_XCNT(j)  (256  + 64 * (j))
#define XB_XSUB(j)  (1280 + 64 * (j))
#define XB_XGEN(j)  (2304 + 64 * (j))
#define XB_TOP      3328
#define XB_TOPGEN   3392
#define XCD_BAR_WORDS 3456
#define XB_SPIN_CAP (1u << 18)
__device__ __forceinline__ unsigned xb_ld(unsigned* p)              { return __hip_atomic_load(p, __ATOMIC_RELAXED, __HIP_MEMORY_SCOPE_AGENT); }
__device__ __forceinline__ unsigned xb_add(unsigned* p, unsigned v) { return __hip_atomic_fetch_add(p, v, __ATOMIC_RELAXED, __HIP_MEMORY_SCOPE_AGENT); }
__device__ __forceinline__ unsigned xb_xcc_id() { return (unsigned)__builtin_amdgcn_s_getreg((3 << 11) | 20) & 0xFu; }
#define XB_SPIN(cond, bar) do { unsigned _sp = 0; while (cond) { __builtin_amdgcn_s_sleep(1); \
    if ((++_sp & 255u) == 0u) { if (xb_ld(&(bar)[XB_TMO])) break; if (_sp > XB_SPIN_CAP) { atomicAdd(&(bar)[XB_TMO], 1u); break; } } } } while (0)
struct XcdBarrier { unsigned* bar; unsigned x; volatile LAS unsigned* st; };
__device__ __forceinline__ XcdBarrier xcd_barrier_post(unsigned* bar, volatile LAS unsigned* st) {
    XcdBarrier b; b.bar = bar; b.x = xb_xcc_id(); b.st = st;
    if (threadIdx.x == 0) (void)xb_add(&bar[XB_XCNT(b.x)], 1u);
    return b;
}
__device__ __forceinline__ void xcd_barrier_complete(unsigned* bar, unsigned x, unsigned& nloc, unsigned& nx) {
    const unsigned G = gridDim.x * gridDim.y * gridDim.z;
    unsigned sum, cnt, mine, sp = 0u;
    for (;;) {
        sum = 0u; cnt = 0u; mine = 0u;
#pragma unroll
        for (unsigned j = 0; j < 16; ++j) { const unsigned c = xb_ld(&bar[XB_XCNT(j)]); sum += c; cnt += (c > 0u) ? 1u : 0u; mine = (j == x) ? c : mine; }
        if (sum == G) break;
        __builtin_amdgcn_s_sleep(1);
        if ((++sp & 255u) == 0u) { if (xb_ld(&bar[XB_TMO])) break; if (sp > XB_SPIN_CAP) { atomicAdd(&bar[XB_TMO], 1u); break; } }
    }
    nloc = mine > 0u ? mine : 1u; nx = cnt > 0u ? cnt : 1u;
}
__device__ __forceinline__ void xcd_barrier(const XcdBarrier& b) {
    asm volatile("s_waitcnt vmcnt(0)" ::: "memory");
    __syncthreads();
    if (threadIdx.x == 0) {
        unsigned* bar = b.bar;
        __builtin_amdgcn_s_waitcnt(0);
        unsigned nloc = b.st[0], nx = b.st[1];
        if (nloc == 0u) { xcd_barrier_complete(bar, b.x, nloc, nx); b.st[0] = nloc; b.st[1] = nx; }
        const unsigned old = xb_add(&bar[XB_XSUB(b.x)], 1u);
        const unsigned gen = old / nloc;
        if (old + 1u == (gen + 1u) * nloc) {
            __builtin_amdgcn_fence(__ATOMIC_RELEASE, "agent");
            asm volatile("s_waitcnt vmcnt(0)" ::: "memory");
            const unsigned og = xb_add(&bar[XB_TOP], 1u);
            const unsigned tg = og / nx;
            if (og + 1u == (tg + 1u) * nx) xb_add(&bar[XB_TOPGEN], 1u);
            else XB_SPIN(xb_ld(&bar[XB_TOPGEN]) == tg, bar);
            __builtin_amdgcn_fence(__ATOMIC_ACQUIRE, "agent");
            xb_add(&bar[XB_XGEN(b.x)], 1u);
            asm volatile("s_waitcnt vmcnt(0)" ::: "memory");
        } else {
            XB_SPIN(xb_ld(&bar[XB_XGEN(b.x)]) == gen, bar);
            __builtin_amdgcn_fence(__ATOMIC_ACQUIRE, "agent");
            asm volatile("s_waitcnt vmcnt(0)" ::: "memory");
        }
    }
    __syncthreads();
}

struct Args { const float* in[22]; float* out; unsigned char* ws; int ph_lo, ph_hi; };
enum { I_X = 0, I_C, I_CTX, I_CCTX, I_MODW, I_MODB, I_AWIN, I_QN, I_KN, I_SINK, I_WA2, I_BA, I_GN, I_AWOUT, I_CWIN, I_CW, I_CWOUT, I_RW, I_RB, I_W1, I_W3, I_W2 };

struct Frame {
    LAS unsigned char* lds;
    const float* in[22]; float* out; unsigned char* ws;
    int tid, lane, wave, G, vcu;
};
#define WSP(T, off) ((T*)(F.ws + (off)))

__device__ __forceinline__ int rowmap(int kind, int n) {
    if (kind == 1) { return n < 2048 ? n : (n < 4096 ? 2048 + 256 * ((n - 2048) >> 7) + ((n - 2048) & 127) : 2048 + 256 * ((n - 4096) >> 7) + 128 + ((n - 4096) & 127)); }
    if (kind == 2) return 256 * (n >> 7) + (n & 127);
    if (kind == 3) return 256 * (n >> 7) + 128 + (n & 127);
    return n;
}
__device__ __forceinline__ void transpose_tile(Frame& F, const float* src, int K, int N, bf16* dst, int kind, int tile) {
    LAS float* T = (LAS float*)F.lds;
    const int nkt = K / 64, kt = tile % nkt, ntile = tile / nkt, k0 = kt * 64, n0 = ntile * 256;
#pragma unroll
    for (int p = 0; p < 8; ++p) { const int k = 8 * p + F.wave, n4 = 4 * F.lane;
        f32x4 v = (f32x4){0.f, 0.f, 0.f, 0.f};
        if (n0 + n4 < N) v = *(const f32x4*)(src + (size_t)(k0 + k) * N + n0 + n4);
        LAS float* t = T + k * 257 + n4; t[0] = v[0]; t[1] = v[1]; t[2] = v[2]; t[3] = v[3]; }
    __syncthreads();
#pragma unroll
    for (int q = 0; q < 4; ++q) { const int piece = F.tid + 512 * q, c = piece & 7, n = piece >> 3;
        const LAS float* s = T + (8 * c) * 257 + n;
        u32x4 o; o.x = cvt_pk_bf16(s[0], s[257]); o.y = cvt_pk_bf16(s[2 * 257], s[3 * 257]); o.z = cvt_pk_bf16(s[4 * 257], s[5 * 257]); o.w = cvt_pk_bf16(s[6 * 257], s[7 * 257]);
        const int row = rowmap(kind, n0 + n);
        *(u32x4*)(dst + (size_t)row * K + k0 + 8 * c) = o; }
    __syncthreads();
}
constexpr int CV_B0 = 8192, CV_B1 = 12288, CV_B2 = 20480, CV_B3 = 24576;
struct TileDesc { const float* src; bf16* dst; int K, N, kind, k0, n0; };
__device__ __forceinline__ TileDesc expert_tile(Frame& F, int layer_unused, int g) {
    const int layer = g >= CV_B1 ? 1 : 0, gl = g - layer * CV_B1; TileDesc d; int t;
    if (gl < CV_B0) { const int le = layer * 32 + (gl >> 8), r = gl & 255; t = r & 127;
        if ((r >> 7) == 0) { d.src = F.in[I_W1] + (size_t)le * 2048 * 1024; d.kind = 2; } else { d.src = F.in[I_W3] + (size_t)le * 2048 * 1024; d.kind = 3; }
        d.dst = WSP(bf16, WS_W13_T) + (size_t)le * 2048 * 2048; d.K = 2048; d.N = 1024; }
    else { const int dd = gl - CV_B0, le = layer * 32 + (dd >> 7); t = dd & 127;
        d.src = F.in[I_W2] + (size_t)le * 1024 * 2048; d.dst = WSP(bf16, WS_W2_T) + (size_t)le * 2048 * 1024; d.K = 1024; d.N = 2048; d.kind = 0; }
    const int nnt = d.N / 64; d.n0 = (t % nnt) * 64; d.k0 = (t / nnt) * 256; return d;
}
struct TileSrc { const float* p; bf16* dst; int K, kind, n0; };
__device__ __forceinline__ void convert_tiles6(Frame& F, int layer, int tau0, int tau1) {
    constexpr int TP = 264, TB = 64 * TP * 2;
    const int ng = F.tid & 15, kqb = F.tid >> 4;
    tau0 = __builtin_amdgcn_readfirstlane(tau0);
    f32x4 va[3][2][4], vb[3][2][4]; TileSrc ta[3], tb[3];
#define CV_LOADA(V, T, t0) do { _Pragma("unroll") for (int q = 0; q < 3; ++q) { const TileDesc d = expert_tile(F, layer, (t0) + q); \
        T[q].p = d.src + (size_t)d.k0 * d.N + d.n0 + 4 * ng; T[q].dst = d.dst + d.k0; T[q].K = d.K; T[q].kind = d.kind; T[q].n0 = d.n0; const int N = d.N; \
        _Pragma("unroll") for (int h = 0; h < 2; ++h) _Pragma("unroll") for (int r = 0; r < 4; ++r) { const float* p_ = T[q].p + (size_t)(4 * (kqb + 32 * h) + r) * N; \
            asm volatile("global_load_dwordx4 %0, %1, off nt" : "=v"(V[q][h][r]) : "v"(p_) : "memory"); } } } while (0)
#define CV_PIN(V) do { _Pragma("unroll") for (int q = 0; q < 3; ++q) asm volatile("" : "+v"(V[q][0][0]), "+v"(V[q][0][1]), "+v"(V[q][0][2]), "+v"(V[q][0][3]), "+v"(V[q][1][0]), "+v"(V[q][1][1]), "+v"(V[q][1][2]), "+v"(V[q][1][3])); } while (0)
#define CV_BAR() do { asm volatile("s_waitcnt lgkmcnt(0)" ::: "memory"); __builtin_amdgcn_s_barrier(); asm volatile("" ::: "memory"); } while (0)
#define CV_WRITE(V) do { _Pragma("unroll") for (int q = 0; q < 3; ++q) { LAS bf16* T_ = (LAS bf16*)(F.lds + q * TB); \
        _Pragma("unroll") for (int h = 0; h < 2; ++h) { const int kq = kqb + 32 * h; \
            _Pragma("unroll") for (int i = 0; i < 4; ++i) { const int n = 4 * ng + i; u32x2 w; w.x = cvt_pk_bf16(V[q][h][0][i], V[q][h][1][i]); w.y = cvt_pk_bf16(V[q][h][2][i], V[q][h][3][i]); \
                *(LAS u32x2*)(T_ + n * TP + 8 * ((kq >> 1) ^ ((n >> 4) & 3)) + 4 * (kq & 1)) = w; } } } } while (0)
#define CV_OUT(T) do { _Pragma("unroll") for (int q = 0; q < 3; ++q) { const LAS bf16* T_ = (const LAS bf16*)(F.lds + q * TB); \
        _Pragma("unroll") for (int qq = 0; qq < 4; ++qq) { const int piece = F.tid + 512 * qq, c = piece & 31, n = piece >> 5; \
            const u32x4 o = *(const LAS u32x4*)(T_ + n * TP + 8 * (c ^ ((n >> 4) & 3))); \
            __builtin_nontemporal_store(o, (u32x4*)(T[q].dst + (size_t)rowmap(T[q].kind, T[q].n0 + n) * T[q].K + 8 * c)); } } } while (0)
    CV_LOADA(va, ta, tau0);
    CV_LOADA(vb, tb, tau0 + 3);
    CV_BAR();
    asm volatile("s_waitcnt vmcnt(24)" ::: "memory"); CV_PIN(va);
    CV_WRITE(va);
    CV_BAR();
    CV_OUT(ta);
    CV_BAR();
    asm volatile("s_waitcnt vmcnt(12)" ::: "memory"); CV_PIN(vb);
    CV_WRITE(vb);
    CV_BAR();
    CV_OUT(tb);
    CV_BAR();
#undef CV_LOADA
#undef CV_PIN
#undef CV_BAR
#undef CV_WRITE
#undef CV_OUT
}
__device__ __forceinline__ void convert_claim(Frame& F, int quota, int drain_to) {
    volatile LAS unsigned* W = (volatile LAS unsigned*)(F.lds + LDS_MISC) + 16;
    unsigned* ctr = WSP(unsigned, WS_CTL) + CW_CVT;
    __syncthreads();
    if (F.tid == 0) { bool want = quota > 0;
        if (!want && drain_to > 0) want = (int)__hip_atomic_load(ctr, __ATOMIC_RELAXED, __HIP_MEMORY_SCOPE_AGENT) < drain_to;
        W[0] = want ? atomicAdd(ctr, 6u) : 0x40000000u; }
    __syncthreads();
    int taken = 0;
    for (;;) {
        const int base = (int)W[0];
        if (base >= CV_B3) break;
        taken += 6;
        if (F.tid == 0) W[1] = (taken < quota || base + 6 < drain_to) ? atomicAdd(ctr, 6u) : 0x40000000u;
        convert_tiles6(F, 0, base, base + 6 < CV_B3 ? base + 6 : CV_B3);
        if (F.tid == 0) W[0] = W[1];
        __syncthreads();
    }
}
__device__ __forceinline__ void phase0(Frame& F) {
    {
        LAS float* sc = (LAS float*)F.lds;
        LAS float* red = sc + 5 * 2048;
        const float* c = F.in[I_C]; const float* cc = F.in[I_CCTX];
        for (int i = F.tid; i < 5 * 2048; i += 512) { const int r = i >> 11, k = i & 2047; const float v = r < 4 ? c[r * 2048 + k] : cc[k]; sc[i] = v / (1.0f + expf(-v)); }
        __syncthreads();
        float* MOD = WSP(float, WS_MOD);
        for (int unit = blockIdx.x; unit < 192; unit += F.G) {
            const int l = unit / 96, cg = unit % 96, col = cg * 128 + 2 * F.lane;
            const float* W = F.in[I_MODW] + (size_t)l * 2048 * 12288 + col;
            float acc[5][2];
#pragma unroll
            for (int r = 0; r < 5; ++r) { acc[r][0] = 0.f; acc[r][1] = 0.f; }
            const int kb = F.wave * 256;
#pragma unroll 8
            for (int kk = 0; kk < 256; ++kk) { const int k = kb + kk; const f32x2 w = *(const f32x2*)(W + (size_t)k * 12288);
#pragma unroll
                for (int r = 0; r < 5; ++r) { const float s = sc[r * 2048 + k]; acc[r][0] += s * w.x; acc[r][1] += s * w.y; } }
#pragma unroll
            for (int r = 0; r < 5; ++r) { red[(F.wave * 5 + r) * 128 + 2 * F.lane] = acc[r][0]; red[(F.wave * 5 + r) * 128 + 2 * F.lane + 1] = acc[r][1]; }
            __syncthreads();
            for (int o = F.tid; o < 640; o += 512) { const int r = o >> 7, ccn = o & 127; float s = 0.f;
#pragma unroll
                for (int w = 0; w < 8; ++w) s += red[(w * 5 + r) * 128 + ccn];
                MOD[(size_t)(l * 5 + r) * 12288 + cg * 128 + ccn] = s + F.in[I_MODB][l * 12288 + cg * 128 + ccn]; }
            __syncthreads();
        }
    }
    constexpr int T0 = 32 * 19, T1 = 32 * 8, T2 = 32 * 24, T3 = 32 * 8;
    constexpr int NT = T0 + T1 + T2 + T3;
    volatile LAS unsigned* Wq = (volatile LAS unsigned*)(F.lds + LDS_MISC) + 24; unsigned* head = WSP(unsigned, WS_CTL) + CW_P0;
    for (;;) {
        __syncthreads();
        if (F.tid == 0) Wq[0] = atomicAdd(head, 2u);
        __syncthreads();
        const int base = (int)Wq[0];
        if (base >= NT) break;
#pragma unroll 1
        for (int it = base; it < base + 2 && it < NT; ++it) {
        int r = it;
        if (r < T0) { transpose_tile(F, F.in[I_AWIN], 2048, 4640, WSP(bf16, WS_WIN_T), 0, r); continue; } r -= T0;
        if (r < T1) { transpose_tile(F, F.in[I_AWOUT], 2048, 2048, WSP(bf16, WS_WOUT_T), 0, r); continue; } r -= T1;
        if (r < T2) { transpose_tile(F, F.in[I_CWIN], 2048, 6144, WSP(bf16, WS_CIN_T), 1, r); continue; } r -= T2;
        transpose_tile(F, F.in[I_CWOUT], 2048, 2048, WSP(bf16, WS_COUT_T), 0, r);
        }
    }
}

__device__ __forceinline__ void modulate_store(const f32x4 (&v)[8], const float* shift, const float* scale, bf16* orow, int lane) {
    float ss = 0.f;
#pragma unroll
    for (int j = 0; j < 8; ++j) ss += (v[j][0] * v[j][0] + v[j][1] * v[j][1]) + (v[j][2] * v[j][2] + v[j][3] * v[j][3]);
    const float rstd = 1.0f / sqrtf(wave_sum(ss) * (1.0f / D) + EPS);
#pragma unroll
    for (int j = 0; j < 8; ++j) { const int c = 4 * (64 * j + lane); const f32x4 sh = *(const f32x4*)(shift + c), sc = *(const f32x4*)(scale + c);
        const f32x4 y = v[j] * rstd * (sc + 1.0f) + sh;
        u32x2 w; w.x = cvt_pk_bf16(y[0], y[1]); w.y = cvt_pk_bf16(y[2], y[3]); *(u32x2*)(orow + c) = w; }
}
__device__ __forceinline__ void phase_modulate0(Frame& F) {
    const int gw = blockIdx.x * 8 + F.wave, NGW = F.G * 8; const float* MOD = WSP(float, WS_MOD); bf16* HA = WSP(bf16, WS_HA);
    for (int row = gw; row < TA; row += NGW) {
        const float* src = row < TL ? F.in[I_X] + (size_t)row * D : F.in[I_CTX] + (size_t)(row - TL) * D;
        const int mr = row < TL ? row / SEQ : 4;
        f32x4 v[8];
#pragma unroll
        for (int j = 0; j < 8; ++j) v[j] = *(const f32x4*)(src + 4 * (64 * j + F.lane));
        modulate_store(v, MOD + (size_t)mr * 12288, MOD + (size_t)mr * 12288 + 2048, HA + (size_t)row * D, F.lane);
    }
    { bf16* RH = WSP(bf16, WS_RWT_HI); bf16* RL = WSP(bf16, WS_RWT_LO); const float* rw = F.in[I_RW];
      for (int piece = blockIdx.x * 512 + F.tid; piece < 2 * 4 * 32 * 256; piece += F.G * 512) { const int e = piece & 31, k0 = ((piece >> 5) & 255) * 8, lb = piece >> 13; unsigned hi[4], lo[4];
          const float* sc = MOD + (size_t)((lb >> 2) * 5 + (lb & 3)) * 12288 + 4 * 2048 + k0; const f32x4 s0 = *(const f32x4*)sc + 1.0f, s1 = *(const f32x4*)(sc + 4) + 1.0f;
#pragma unroll
          for (int i = 0; i < 4; ++i) { const float sa = i < 2 ? s0[2 * i] : s1[2 * i - 4], sb = i < 2 ? s0[2 * i + 1] : s1[2 * i - 3];
              const float a = rw[(size_t)(k0 + 2 * i) * 32 + e] * sa, b = rw[(size_t)(k0 + 2 * i + 1) * 32 + e] * sb;
              hi[i] = cvt_pk_bf16(a, b); lo[i] = cvt_pk_bf16(a - __uint_as_float(hi[i] << 16), b - __uint_as_float(hi[i] & 0xffff0000u)); }
          u32x4 h4, l4; h4.x = hi[0]; h4.y = hi[1]; h4.z = hi[2]; h4.w = hi[3]; l4.x = lo[0]; l4.y = lo[1]; l4.z = lo[2]; l4.w = lo[3];
          *(u32x4*)(RH + ((size_t)lb * 32 + e) * 2048 + k0) = h4; *(u32x4*)(RL + ((size_t)lb * 32 + e) * 2048 + k0) = l4; }
      for (int u = blockIdx.x; u < 128; u += F.G) { const int lb = u & 7, seg = u >> 3, e = F.tid & 31, part = F.tid >> 5; LAS float* red = (LAS float*)F.lds;
          const float* sh = MOD + (size_t)((lb >> 2) * 5 + (lb & 3)) * 12288 + 3 * 2048; const int kb = seg * 128 + part * 8; float sum = 0.f;
#pragma unroll
          for (int i = 0; i < 8; ++i) sum += sh[kb + i] * rw[(size_t)(kb + i) * 32 + e];
          __syncthreads(); red[part * 32 + e] = sum; __syncthreads();
          if (F.tid < 32) { float t = 0.f;
#pragma unroll
              for (int p = 0; p < 16; ++p) t += red[p * 32 + F.tid];
              WSP(float, WS_RBIAS)[(lb * 16 + seg) * 32 + F.tid] = t; } } }
}

__device__ __forceinline__ void phase_prep(Frame& F) {
    bf16* PROJ = WSP(bf16, WS_PROJ);
    const int gw = blockIdx.x * 8 + F.wave, NGW = F.G * 8, lane = F.lane;
    const int hs = lane >> 4, sub = lane & 15, fb = 8 * (sub & 3); const bool second = (sub & 4) != 0, axis1 = (sub & 8) != 0;
    float qg[8], kg[8], invf[8];
#pragma unroll
    for (int j = 0; j < 8; ++j) { qg[j] = F.in[I_QN][8 * sub + j]; kg[j] = F.in[I_KN][8 * sub + j]; invf[j] = __expf(-(float)(fb + j) * (9.210340371976184f / 32.0f)); }
    for (int row = gw; row < TA; row += NGW) {
        bf16* pr = PROJ + (size_t)row * NPROJ;
        const bool lat = row < TL;
        float cs[8], sn[8];
        if (lat) { const int t = row % SEQ; const float pos = (float)(axis1 ? (t % 64) : (t / 64));
#pragma unroll
            for (int j = 0; j < 8; ++j) { const float a = pos * invf[j]; cs[j] = __cosf(a); sn[j] = __sinf(a); } }
        else {
#pragma unroll
            for (int j = 0; j < 8; ++j) { cs[j] = 1.f; sn[j] = 0.f; } }
        u32x4 raw[3]; bool act[3];
#pragma unroll
        for (int p = 0; p < 3; ++p) { const int h = 4 * p + hs; act[p] = (h < 10) && (lat || h >= 8);
            raw[p] = (u32x4){0u, 0u, 0u, 0u};
            if (act[p]) raw[p] = *(const u32x4*)(pr + (h < 8 ? C_AQ + h * 128 : C_AK + (h - 8) * 128) + 8 * sub); }
#pragma unroll
        for (int p = 0; p < 3; ++p) { const int h = 4 * p + hs;
            const unsigned ww[4] = {raw[p].x, raw[p].y, raw[p].z, raw[p].w}; float x[8]; float ss = 0.f;
#pragma unroll
            for (int j = 0; j < 8; ++j) { x[j] = (j & 1) ? __uint_as_float(ww[j >> 1] & 0xffff0000u) : __uint_as_float(ww[j >> 1] << 16); ss += x[j] * x[j]; }
            ss += __shfl_xor(ss, 1); ss += __shfl_xor(ss, 2); ss += __shfl_xor(ss, 4); ss += __shfl_xor(ss, 8);
            const float rstd = 1.0f / sqrtf(ss * (1.0f / 128.0f) + EPS);
            float y[8];
#pragma unroll
            for (int j = 0; j < 8; ++j) { const float yv = x[j] * rstd * (p < 2 ? qg[j] : kg[j]); const float pv = __shfl_xor(yv, 4);
                y[j] = second ? yv * cs[j] + pv * sn[j] : yv * cs[j] - pv * sn[j]; }
            u32x4 o; o.x = cvt_pk_bf16(y[0], y[1]); o.y = cvt_pk_bf16(y[2], y[3]); o.z = cvt_pk_bf16(y[4], y[5]); o.w = cvt_pk_bf16(y[6], y[7]);
            if (act[p]) *(u32x4*)(pr + (h < 8 ? C_AQ + h * 128 : C_AK + (h - 8) * 128) + 8 * sub) = o; }
    }
    LAS bf16* T = (LAS bf16*)F.lds;
    bf16* VTL = WSP(bf16, WS_VTL); bf16* VTC = WSP(bf16, WS_VTC);
    for (int u = blockIdx.x; u < 288; u += F.G) {
        const bool isl = u < 256; const int uu = isl ? u : u - 256; const int ntile = isl ? 32 : 4;
        const int b = uu / (2 * ntile), kvh = (uu / ntile) & 1, tt = uu % ntile;
        const int row0 = isl ? b * SEQ + tt * 64 : TL + b * CTXL + tt * 64;
#pragma unroll
        for (int q = 0; q < 2; ++q) { const int j = F.lane, seg = F.wave + 8 * q;
            const u32x4 w = *(const u32x4*)(PROJ + (size_t)(row0 + j) * NPROJ + C_AV + kvh * 128 + seg * 8);
            const unsigned ww[4] = {w.x, w.y, w.z, w.w};
#pragma unroll
            for (int i = 0; i < 8; ++i) T[(seg * 8 + i) * 72 + j] = (bf16)((ww[i >> 1] >> ((i & 1) * 16)) & 0xffffu); }
        __syncthreads();
#pragma unroll
        for (int q = 0; q < 2; ++q) { const int piece = F.tid + 512 * q, d = piece >> 3, seg = piece & 7;
            const u32x4 w = *(const LAS u32x4*)(T + d * 72 + seg * 8);
            bf16* dst = isl ? VTL + ((size_t)(b * 2 + kvh) * 128 + d) * SEQ + tt * 64 + seg * 8 : VTC + ((size_t)(b * 2 + kvh) * 128 + d) * CTXL + tt * 64 + seg * 8;
            *(u32x4*)dst = w; }
        __syncthreads();
    }
}

__device__ __forceinline__ void attn_unit(Frame& F, int unit) {
    const bf16* PROJ = WSP(bf16, WS_PROJ); const bf16* VTL = WSP(bf16, WS_VTL); const bf16* VTC = WSP(bf16, WS_VTC); bf16* MIX = WSP(bf16, WS_MIX);
    const int b = unit >> 6, qb = (unit >> 2) & 15, kvh = (unit >> 1) & 1, gp = unit & 1;
    const int w = F.wave, lane = F.lane, fr = lane & 15, fq = lane >> 4;
    const int hq = kvh * 4 + gp * 2 + (w >> 2), qr0 = qb * 128 + 32 * (w & 3);
    LAS bf16* Ks = (LAS bf16*)F.lds;
    LAS bf16* Vs = Ks + 64 * 136;
    LAS bf16* Ps = Vs + 128 * 72 + w * (32 * 72);
    bf16x8 Q[2][4];
#pragma unroll
    for (int mt = 0; mt < 2; ++mt)
#pragma unroll
        for (int ks = 0; ks < 4; ++ks) Q[mt][ks] = *(const bf16x8*)(PROJ + (size_t)(b * SEQ + qr0 + 16 * mt + fr) * NPROJ + C_AQ + hq * 128 + 32 * ks + 8 * fq);
    const float sinkv = F.in[I_SINK][hq];
    float mrun[2] = {sinkv, sinkv}, lrun[2] = {1.f, 1.f};
    f32x4 o[2][8];
#pragma unroll
    for (int mt = 0; mt < 2; ++mt)
#pragma unroll
        for (int dt = 0; dt < 8; ++dt) o[mt][dt] = (f32x4){0.f, 0.f, 0.f, 0.f};
    const int kt_lo = (2 * qb - 2) < 0 ? 0 : 2 * qb - 2, kt_hi = (2 * qb + 3) > 31 ? 31 : 2 * qb + 3;
    const int ntiles = 4 + (kt_hi - kt_lo + 1);
    u32x4 rk[2], rv[2];
#define ATT_LOAD(ti_) do { const bool isc_ = (ti_) < 4; const int kt_ = isc_ ? (ti_) : kt_lo + ((ti_) - 4); \
        const size_t krow0_ = isc_ ? (size_t)(TL + b * CTXL + kt_ * 64) : (size_t)(b * SEQ + kt_ * 64); \
        const bf16* vt_ = isc_ ? VTC + (size_t)(b * 2 + kvh) * 128 * CTXL + kt_ * 64 : VTL + (size_t)(b * 2 + kvh) * 128 * SEQ + kt_ * 64; const int vld_ = isc_ ? CTXL : SEQ; \
        _Pragma("unroll") for (int q = 0; q < 2; ++q) { const int piece = F.tid + 512 * q; \
            rk[q] = *(const u32x4*)(PROJ + (krow0_ + (piece >> 4)) * NPROJ + C_AK + kvh * 128 + (piece & 15) * 8); \
            rv[q] = *(const u32x4*)(vt_ + (size_t)(piece >> 3) * vld_ + (piece & 7) * 8); } } while (0)
    ATT_LOAD(0);
    for (int ti = 0; ti < ntiles; ++ti) {
        const bool isc = ti < 4; const int kt = isc ? ti : kt_lo + (ti - 4);
        __syncthreads();
#pragma unroll
        for (int q = 0; q < 2; ++q) { const int piece = F.tid + 512 * q;
            *(LAS u32x4*)(Ks + (piece >> 4) * 136 + (piece & 15) * 8) = rk[q];
            *(LAS u32x4*)(Vs + (piece >> 3) * 72 + (piece & 7) * 8) = rv[q]; }
        __syncthreads();
        if (ti + 1 < ntiles) ATT_LOAD(ti + 1);
        f32x4 s[2][4];
#pragma unroll
        for (int mt = 0; mt < 2; ++mt)
#pragma unroll
            for (int nt = 0; nt < 4; ++nt) s[mt][nt] = (f32x4){0.f, 0.f, 0.f, 0.f};
#pragma unroll
        for (int nt = 0; nt < 4; ++nt)
#pragma unroll
            for (int ks = 0; ks < 4; ++ks) { const bf16x8 kf = *(const LAS bf16x8*)(Ks + (16 * nt + fr) * 136 + 32 * ks + 8 * fq);
#pragma unroll
                for (int mt = 0; mt < 2; ++mt) s[mt][nt] = __builtin_amdgcn_mfma_f32_16x16x32_bf16(kf, Q[mt][ks], s[mt][nt], 0, 0, 0); }
#pragma unroll
        for (int mt = 0; mt < 2; ++mt) {
            const int qpos = qr0 + 16 * mt + fr;
            float mx = -3.0e38f;
#pragma unroll
            for (int nt = 0; nt < 4; ++nt)
#pragma unroll
                for (int i = 0; i < 4; ++i) { float v = s[mt][nt][i] * 0.08838834764831845f;
                    if (!isc) { const int kpos = kt * 64 + 16 * nt + 4 * fq + i; const int dd = kpos - qpos; if (dd > 128 || dd < -128) v = -3.0e38f; }
                    s[mt][nt][i] = v; mx = fmaxf(mx, v); }
            mx = fmaxf(mx, __shfl_xor(mx, 16)); mx = fmaxf(mx, __shfl_xor(mx, 32));
            const float mnew = fmaxf(mrun[mt], mx), alpha = __expf(mrun[mt] - mnew);
            float rs = 0.f;
#pragma unroll
            for (int nt = 0; nt < 4; ++nt) { f32x4 p;
#pragma unroll
                for (int i = 0; i < 4; ++i) { const float v = s[mt][nt][i]; p[i] = v < -1.0e37f ? 0.f : __expf(v - mnew); rs += p[i]; }
                u32x2 pw; pw.x = cvt_pk_bf16(p[0], p[1]); pw.y = cvt_pk_bf16(p[2], p[3]);
                *(LAS u32x2*)(Ps + (16 * mt + fr) * 72 + 16 * nt + 4 * fq) = pw; }
            rs += __shfl_xor(rs, 16); rs += __shfl_xor(rs, 32);
            lrun[mt] = lrun[mt] * alpha + rs; mrun[mt] = mnew;
#pragma unroll
            for (int dt = 0; dt < 8; ++dt) o[mt][dt] = o[mt][dt] * alpha;
        }
        asm volatile("s_waitcnt lgkmcnt(0)" ::: "memory");
#pragma unroll
        for (int ks = 0; ks < 2; ++ks) { bf16x8 pf[2];
#pragma unroll
            for (int mt = 0; mt < 2; ++mt) pf[mt] = *(const LAS bf16x8*)(Ps + (16 * mt + fr) * 72 + 32 * ks + 8 * fq);
#pragma unroll
            for (int dt = 0; dt < 8; ++dt) { const bf16x8 vf = *(const LAS bf16x8*)(Vs + (16 * dt + fr) * 72 + 32 * ks + 8 * fq);
#pragma unroll
                for (int mt = 0; mt < 2; ++mt) o[mt][dt] = __builtin_amdgcn_mfma_f32_16x16x32_bf16(vf, pf[mt], o[mt][dt], 0, 0, 0); } }
    }
#pragma unroll
    for (int mt = 0; mt < 2; ++mt) { const float inv = 1.0f / lrun[mt]; bf16* orow = MIX + (size_t)(b * SEQ + qr0 + 16 * mt + fr) * D + hq * 128 + 4 * fq;
#pragma unroll
        for (int dt = 0; dt < 8; ++dt) { const f32x4 v = o[mt][dt] * inv; u32x2 wv; wv.x = cvt_pk_bf16(v[0], v[1]); wv.y = cvt_pk_bf16(v[2], v[3]); *(u32x2*)(orow + 16 * dt) = wv; } }
#undef ATT_LOAD
}

__device__ __forceinline__ int gla_row(int b, int dir, int tp) { return tp < CTXL ? TL + b * CTXL + (dir ? CTXL - 1 - tp : tp) : b * SEQ + (dir ? SEQ - 1 - (tp - CTXL) : tp - CTXL); }
__device__ __forceinline__ void gla_g1_all(Frame& F) {
    const bf16* PROJ = WSP(bf16, WS_PROJ);
    const int tid = F.tid, lane = F.lane, fr = lane & 15, fq = lane >> 4;
    LAS bf16* VTs = (LAS bf16*)F.lds;
    LAS float* LAs = (LAS float*)F.lds;
    LAS float* LRs = (LAS float*)(F.lds + 36864);
    LAS float* WAs = (LAS float*)(F.lds + 40960);
    LAS bf16* QFs = (LAS bf16*)(F.lds + 49152);
    LAS bf16* KFs = (LAS bf16*)(F.lds + 66560);
    LAS bf16* KLTs = (LAS bf16*)(F.lds + 83968);
    u32x4 pv[4], pq[2], pk[2]; unsigned short pl[2]; float pw[4], pba;
#define G1_LOAD(un) do { const int sidx_ = (un) / 36, c_ = (un) % 36, b_ = sidx_ >> 3, h_ = (sidx_ >> 1) & 3, dir_ = sidx_ & 1, tp0_ = c_ * 64; \
        const size_t rowl_ = (size_t)gla_row(b_, dir_, tp0_ + lane) * NPROJ; \
        _Pragma("unroll") for (int q = 0; q < 4; ++q) pv[q] = *(const u32x4*)(PROJ + rowl_ + C_GV + h_ * 256 + (F.wave + 8 * q) * 8); \
        _Pragma("unroll") for (int q = 0; q < 2; ++q) { pq[q] = *(const u32x4*)(PROJ + rowl_ + C_GQ + h_ * 128 + (F.wave + 8 * q) * 8); pk[q] = *(const u32x4*)(PROJ + rowl_ + C_GK + h_ * 128 + (F.wave + 8 * q) * 8); \
            const int i_ = tid + 512 * q; pl[q] = PROJ[(size_t)gla_row(b_, dir_, tp0_ + (i_ >> 4)) * NPROJ + C_LR + dir_ * 16 + (i_ & 15)]; } \
        _Pragma("unroll") for (int q = 0; q < 4; ++q) { const int i_ = tid + 512 * q; pw[q] = F.in[I_WA2][(dir_ * 16 + (i_ >> 7)) * 512 + h_ * 128 + (i_ & 127)]; } \
        pba = F.in[I_BA][dir_ * 512 + h_ * 128 + (tid & 127)]; } while (0)
    if ((int)blockIdx.x < 1152) G1_LOAD(blockIdx.x);
    for (int unit = blockIdx.x; unit < 1152; unit += F.G) {
        const int sidx = unit / 36, c = unit % 36, h = (sidx >> 1) & 3, dir = sidx & 1;
        bf16* QFg = WSP(bf16, WS_QF) + (size_t)unit * 64 * 128; bf16* KLTg = WSP(bf16, WS_KLT) + (size_t)unit * 128 * 64; bf16* ATTg = WSP(bf16, WS_ATT) + (size_t)unit * 64 * 64;
        bf16* VTg = WSP(bf16, WS_VT) + (size_t)unit * 256 * 64; float* DECg = WSP(float, WS_DEC) + (size_t)unit * 128;
#pragma unroll
        for (int q = 0; q < 4; ++q) { const int j = lane, sg = F.wave + 8 * q; const unsigned ww[4] = {pv[q].x, pv[q].y, pv[q].z, pv[q].w};
#pragma unroll
            for (int i = 0; i < 8; ++i) VTs[(sg * 8 + i) * 72 + j] = (bf16)((ww[i >> 1] >> ((i & 1) * 16)) & 0xffffu); }
#pragma unroll
        for (int q = 0; q < 2; ++q) LRs[tid + 512 * q] = bf2f(pl[q]);
#pragma unroll
        for (int q = 0; q < 4; ++q) WAs[tid + 512 * q] = pw[q];
        const float bav = pba;
        __syncthreads();
#pragma unroll
        for (int q = 0; q < 4; ++q) { const int piece = tid + 512 * q, e = piece >> 3, sg = piece & 7;
            *(u32x4*)(VTg + (size_t)e * 64 + sg * 8) = *(const LAS u32x4*)(VTs + e * 72 + sg * 8); }
        __syncthreads();
        { const int d = tid & 127, ig = tid >> 7; float wv[16];
#pragma unroll
          for (int r = 0; r < 16; ++r) wv[r] = WAs[r * 128 + d];
          float run = 0.f;
#pragma unroll 4
          for (int ii = 0; ii < 16; ++ii) { const int i = ig * 16 + ii; float z = bav;
#pragma unroll
              for (int r = 0; r < 16; ++r) z += LRs[i * 16 + r] * wv[r];
              const float ls = (fminf(z, 0.f) - __logf(1.0f + __expf(-fabsf(z)))) * (1.0f / 16.0f);
              run += ls; LAs[i * 132 + d] = run; }
          __syncthreads();
          float off = 0.f;
#pragma unroll
          for (int sgm = 0; sgm < 3; ++sgm) if (sgm < ig) off += LAs[(sgm * 16 + 15) * 132 + d];
          __syncthreads();
          if (ig > 0) {
#pragma unroll 4
              for (int ii = 0; ii < 16; ++ii) LAs[(ig * 16 + ii) * 132 + d] += off; }
          __syncthreads();
        }
#pragma unroll
        for (int q = 0; q < 2; ++q) { const int i = lane, sg = F.wave + 8 * q, d0 = sg * 8;
            const unsigned qa[4] = {pq[q].x, pq[q].y, pq[q].z, pq[q].w}, ka[4] = {pk[q].x, pk[q].y, pk[q].z, pk[q].w};
            float qf[8], kf[8], kl[8];
#pragma unroll
            for (int ii = 0; ii < 8; ++ii) { const float bc = LAs[i * 132 + d0 + ii], bl = LAs[63 * 132 + d0 + ii];
                const float qv = (ii & 1) ? __uint_as_float(qa[ii >> 1] & 0xffff0000u) : __uint_as_float(qa[ii >> 1] << 16);
                const float kv = (ii & 1) ? __uint_as_float(ka[ii >> 1] & 0xffff0000u) : __uint_as_float(ka[ii >> 1] << 16);
                const float e1 = __expf(bc);
                qf[ii] = qv * 0.08838834764831845f * e1; kf[ii] = kv * __builtin_amdgcn_rcpf(e1); kl[ii] = kv * __expf(bl - bc); }
            u32x4 qo, ko; qo.x = cvt_pk_bf16(qf[0], qf[1]); qo.y = cvt_pk_bf16(qf[2], qf[3]); qo.z = cvt_pk_bf16(qf[4], qf[5]); qo.w = cvt_pk_bf16(qf[6], qf[7]);
            ko.x = cvt_pk_bf16(kf[0], kf[1]); ko.y = cvt_pk_bf16(kf[2], kf[3]); ko.z = cvt_pk_bf16(kf[4], kf[5]); ko.w = cvt_pk_bf16(kf[6], kf[7]);
            *(LAS u32x4*)(QFs + i * 136 + d0) = qo; *(LAS u32x4*)(KFs + i * 136 + d0) = ko;
            if (c >= 4) *(u32x4*)(QFg + (size_t)i * 128 + d0) = qo;
#pragma unroll
            for (int ii = 0; ii < 8; ++ii) KLTs[(d0 + ii) * 72 + i] = (bf16)(cvt_pk_bf16(kl[ii], 0.f) & 0xffffu); }
        if (tid < 128) DECg[tid] = __expf(LAs[63 * 132 + tid]);
        if (unit + F.G < 1152) G1_LOAD(unit + F.G);
        __syncthreads();
        if (c >= 4) {
            const int it = F.wave >> 1;
#pragma unroll
            for (int jj = 0; jj < 2; ++jj) { const int jt = 2 * (F.wave & 1) + jj; f32x4 acc = (f32x4){0.f, 0.f, 0.f, 0.f};
#pragma unroll
                for (int ks = 0; ks < 4; ++ks) { const bf16x8 kfr = *(const LAS bf16x8*)(KFs + (16 * jt + fr) * 136 + 32 * ks + 8 * fq), qfr = *(const LAS bf16x8*)(QFs + (16 * it + fr) * 136 + 32 * ks + 8 * fq);
                    acc = __builtin_amdgcn_mfma_f32_16x16x32_bf16(kfr, qfr, acc, 0, 0, 0); }
                const int i = 16 * it + fr, j0 = 16 * jt + 4 * fq;
#pragma unroll
                for (int ii = 0; ii < 4; ++ii) if (j0 + ii > i) acc[ii] = 0.f;
                u32x2 w; w.x = cvt_pk_bf16(acc[0], acc[1]); w.y = cvt_pk_bf16(acc[2], acc[3]);
                *(u32x2*)(ATTg + (size_t)i * 64 + j0) = w; }
        }
#pragma unroll
        for (int q = 0; q < 2; ++q) { const int piece = tid + 512 * q, d = piece >> 3, sg = piece & 7;
            *(u32x4*)(KLTg + (size_t)d * 64 + sg * 8) = *(const LAS u32x4*)(KLTs + d * 72 + sg * 8); }
        __syncthreads();
    }
#undef G1_LOAD
}
__device__ __forceinline__ void gla_g2(Frame& F, int blk) {
    const int sidx = blk >> 2, sl = blk & 3, b = sidx >> 3, h = (sidx >> 1) & 3, dir = sidx & 1, tid = F.tid, lane = F.lane, fr = lane & 15, fq = lane >> 4, w = F.wave;
    bf16* OG = WSP(bf16, WS_OG);
    LAS bf16* QFs = (LAS bf16*)F.lds;
    LAS bf16* ATs = (LAS bf16*)(F.lds + 17408);
    LAS bf16* VTs = (LAS bf16*)(F.lds + 26624);
    LAS bf16* KLTs = (LAS bf16*)(F.lds + 35840);
    LAS float* DECs = (LAS float*)(F.lds + 54272);
    LAS bf16* STs = (LAS bf16*)(F.lds + 54784);
    const int et_s = w >> 1, dt0 = 4 * (w & 1);
    const int it_o = w >> 1, et0 = 2 * (w & 1);
    f32x4 Sacc[4];
#pragma unroll
    for (int i = 0; i < 4; ++i) Sacc[i] = (f32x4){0.f, 0.f, 0.f, 0.f};
    u32x4 rq[2], rk[2], ra, rv; f32x4 rd;
    rq[0] = rq[1] = ra = (u32x4){0u, 0u, 0u, 0u}; rd = (f32x4){0.f, 0.f, 0.f, 0.f};
#define G2_LOAD(cc) do { const size_t un = (size_t)sidx * 36 + (cc); \
        const bf16* kg = WSP(bf16, WS_KLT) + un * 128 * 64; const bf16* vg = WSP(bf16, WS_VT) + un * 256 * 64 + (size_t)sl * 64 * 64; \
        rk[0] = *(const u32x4*)(kg + (size_t)tid * 8); rk[1] = *(const u32x4*)(kg + (size_t)(tid + 512) * 8); rv = *(const u32x4*)(vg + (size_t)tid * 8); \
        if (tid < 32) rd = *(const f32x4*)(WSP(float, WS_DEC) + un * 128 + tid * 4); \
        if ((cc) >= 4) { const bf16* qg = WSP(bf16, WS_QF) + un * 64 * 128; const bf16* ag = WSP(bf16, WS_ATT) + un * 64 * 64; \
            rq[0] = *(const u32x4*)(qg + (size_t)tid * 8); rq[1] = *(const u32x4*)(qg + (size_t)(tid + 512) * 8); ra = *(const u32x4*)(ag + (size_t)tid * 8); } } while (0)
#define G2_STORE() do { \
        { const int d = tid >> 3, sg = tid & 7; *(LAS u32x4*)(KLTs + d * 72 + sg * 8) = rk[0]; *(LAS u32x4*)(KLTs + (d + 64) * 72 + sg * 8) = rk[1]; \
          *(LAS u32x4*)(VTs + d * 72 + sg * 8) = rv; *(LAS u32x4*)(ATs + d * 72 + sg * 8) = ra; } \
        { const int i = tid >> 4, sg = tid & 15; *(LAS u32x4*)(QFs + i * 136 + sg * 8) = rq[0]; *(LAS u32x4*)(QFs + (i + 32) * 136 + sg * 8) = rq[1]; } \
        if (tid < 32) *(LAS f32x4*)(DECs + tid * 4) = rd; } while (0)
    __syncthreads();
    G2_LOAD(0); G2_STORE();
    for (int i = tid; i < 64 * 136 / 2; i += 512) ((LAS unsigned*)STs)[i] = 0u;
    __syncthreads();
    for (int c = 0; c < 36; ++c) {
        if (c + 1 < 36) G2_LOAD(c + 1);
        if (c >= 4) {
#pragma unroll
            for (int ee = 0; ee < 2; ++ee) { const int et = et0 + ee; f32x4 acc = (f32x4){0.f, 0.f, 0.f, 0.f};
#pragma unroll
                for (int ks = 0; ks < 2; ++ks) acc = __builtin_amdgcn_mfma_f32_16x16x32_bf16(*(const LAS bf16x8*)(VTs + (16 * et + fr) * 72 + 32 * ks + 8 * fq), *(const LAS bf16x8*)(ATs + (16 * it_o + fr) * 72 + 32 * ks + 8 * fq), acc, 0, 0, 0);
#pragma unroll
                for (int ks = 0; ks < 4; ++ks) acc = __builtin_amdgcn_mfma_f32_16x16x32_bf16(*(const LAS bf16x8*)(STs + (16 * et + fr) * 136 + 32 * ks + 8 * fq), *(const LAS bf16x8*)(QFs + (16 * it_o + fr) * 136 + 32 * ks + 8 * fq), acc, 0, 0, 0);
                const int tp = c * 64 + 16 * it_o + fr, lrow = b * SEQ + (dir ? SEQ - 1 - (tp - CTXL) : tp - CTXL);
                *(u32x2*)(OG + ((size_t)dir * TL + lrow) * 1024 + h * 256 + sl * 64 + 16 * et + 4 * fq) = (mfma_settle(acc), f32_to_bf4(acc)); }
        }
#pragma unroll
        for (int dd = 0; dd < 4; ++dd) { const int dt = dt0 + dd; const f32x4 dec = *(const LAS f32x4*)(DECs + 16 * dt + 4 * fq);
            f32x4 acc = Sacc[dd] * dec;
#pragma unroll
            for (int ks = 0; ks < 2; ++ks) acc = __builtin_amdgcn_mfma_f32_16x16x32_bf16(*(const LAS bf16x8*)(KLTs + (16 * dt + fr) * 72 + 32 * ks + 8 * fq), *(const LAS bf16x8*)(VTs + (16 * et_s + fr) * 72 + 32 * ks + 8 * fq), acc, 0, 0, 0);
            Sacc[dd] = acc; }
        __syncthreads();
#pragma unroll
        for (int dd = 0; dd < 4; ++dd) { mfma_settle(Sacc[dd]); u32x2 wv; wv.x = cvt_pk_bf16(Sacc[dd][0], Sacc[dd][1]); wv.y = cvt_pk_bf16(Sacc[dd][2], Sacc[dd][3]);
            *(LAS u32x2*)(STs + (16 * et_s + fr) * 136 + 16 * (dt0 + dd) + 4 * fq) = wv; }
        if (c + 1 < 36) G2_STORE();
        __syncthreads();
    }
#undef G2_LOAD
#undef G2_STORE
}

__device__ __forceinline__ void phase_gla_out(Frame& F) {
    const int gw = blockIdx.x * 8 + F.wave, NGW = F.G * 8, lane = F.lane;
    const bf16* OG = WSP(bf16, WS_OG); const bf16* PROJ = WSP(bf16, WS_PROJ); bf16* MIX = WSP(bf16, WS_MIX);
    const f32x4 gn = *(const f32x4*)(F.in[I_GN] + 4 * lane);
    for (int row = gw; row < TL; row += NGW) {
#pragma unroll
        for (int h = 0; h < 4; ++h) {
            const f32x4 of = bf4_to_f32(*(const u32x2*)(OG + (size_t)row * 1024 + h * 256 + 4 * lane)), ob = bf4_to_f32(*(const u32x2*)(OG + ((size_t)TL + row) * 1024 + h * 256 + 4 * lane));
            const f32x4 ov = of + ob;
            const float rstd = 1.0f / sqrtf(wave_sum((ov[0] * ov[0] + ov[1] * ov[1]) + (ov[2] * ov[2] + ov[3] * ov[3])) * (1.0f / 256.0f) + EPS);
            const u32x2 gw2 = *(const u32x2*)(PROJ + (size_t)row * NPROJ + C_GG + h * 256 + 4 * lane);
            const float g0 = __uint_as_float(gw2.x << 16), g1 = __uint_as_float(gw2.x & 0xffff0000u), g2 = __uint_as_float(gw2.y << 16), g3 = __uint_as_float(gw2.y & 0xffff0000u);
            const float y0 = ov[0] * rstd * gn[0] * silu_f(g0), y1 = ov[1] * rstd * gn[1] * silu_f(g1), y2 = ov[2] * rstd * gn[2] * silu_f(g2), y3 = ov[3] * rstd * gn[3] * silu_f(g3);
            u32x2 wv; wv.x = cvt_pk_bf16(y0, y1); wv.y = cvt_pk_bf16(y2, y3);
            *(u32x2*)(MIX + (size_t)row * D + 1024 + h * 256 + 4 * lane) = wv;
        }
    }
}

__device__ __forceinline__ void phase_route(Frame& F, int layer, const bf16* xin) {
    const int lane = F.lane, w = F.wave, fr = lane & 15, fq = lane >> 4;
    const float* MOD = WSP(float, WS_MOD) + (size_t)layer * 5 * 12288; bf16* HA = WSP(bf16, WS_HA);
    unsigned* route = WSP(unsigned, WS_ROUTE) + (size_t)layer * TL * 8; int* list = WSP(int, WS_LIST) + (size_t)layer * 32 * 8192;
    unsigned* cnt = WSP(unsigned, WS_CTL) + CW_CNT + layer * 32 * 64;
    const float* rb = F.in[I_RB];
    LAS unsigned char* XS = F.lds; LAS unsigned char* HI0 = F.lds + LDS_TOK + 4096;
    LAS float* RS = (LAS float*)HI0;
    LAS unsigned* LCNT = (LAS unsigned*)(HI0 + 128); LAS unsigned* LBASE = (LAS unsigned*)(HI0 + 256); LAS float* RBL = (LAS float*)(HI0 + 384);
    LAS float* LOG = (LAS float*)(HI0 + 512);
    LAS float* PART = (LAS float*)F.lds;
    for (int it = 0; it * F.G * 32 < TL; ++it) {
        const int row0b = (it * F.G + (int)blockIdx.x) * 32;
        if (row0b >= TL) break;
        const int b = row0b / SEQ; const float* shift = MOD + (size_t)b * 12288 + 3 * 2048; const float* scale = MOD + (size_t)b * 12288 + 4 * 2048;
        const bf16* RH = WSP(bf16, WS_RWT_HI) + (size_t)(layer * 4 + b) * 32 * 2048; const bf16* RL = WSP(bf16, WS_RWT_LO) + (size_t)(layer * 4 + b) * 32 * 2048;
        __syncthreads();
        if (F.tid < 32) { LCNT[F.tid] = 0u; const float* bp = WSP(float, WS_RBIAS) + (size_t)(layer * 4 + b) * 16 * 32 + F.tid; float t = 0.f;
#pragma unroll
            for (int p = 0; p < 16; ++p) t += bp[p * 32];
            RBL[F.tid] = t; }
        { u32x4 v[4][4];
#pragma unroll
          for (int k = 0; k < 4; ++k)
#pragma unroll
              for (int j = 0; j < 4; ++j) v[k][j] = *(const u32x4*)(xin + (size_t)(row0b + 4 * w + k) * D + 8 * (64 * j + lane));
#pragma unroll
          for (int k = 0; k < 4; ++k)
#pragma unroll
              for (int j = 0; j < 4; ++j) { const int rr = 4 * w + k; *(LAS u32x4*)(XS + rr * 4096 + 16 * ((64 * j + lane) ^ (rr & 15))) = v[k][j]; }
#pragma unroll
          for (int k = 0; k < 4; ++k) { float ss = 0.f; f32x4 xa[4][2];
#pragma unroll
              for (int j = 0; j < 4; ++j) { u32x2 lo2, hi2; lo2.x = v[k][j].x; lo2.y = v[k][j].y; hi2.x = v[k][j].z; hi2.y = v[k][j].w; xa[j][0] = bf4_to_f32(lo2); xa[j][1] = bf4_to_f32(hi2);
#pragma unroll
                  for (int q = 0; q < 2; ++q) ss += (xa[j][q][0] * xa[j][q][0] + xa[j][q][1] * xa[j][q][1]) + (xa[j][q][2] * xa[j][q][2] + xa[j][q][3] * xa[j][q][3]); }
              const float rsk = 1.0f / sqrtf(wave_sum(ss) * (1.0f / D) + EPS);
              if (lane == 0) RS[4 * w + k] = rsk;
#pragma unroll
              for (int j = 0; j < 4; ++j) { const int c = 8 * (64 * j + lane); u32x4 o;
#pragma unroll
                  for (int q = 0; q < 2; ++q) { const f32x4 sh = *(const f32x4*)(shift + c + 4 * q), sc = *(const f32x4*)(scale + c + 4 * q);
                      const f32x4 y = xa[j][q] * rsk * (sc + 1.0f) + sh; const u32x2 p = f32_to_bf4(y); if (q == 0) { o.x = p.x; o.y = p.y; } else { o.z = p.x; o.w = p.y; } }
                  *(u32x4*)(HA + (size_t)(row0b + 4 * w + k) * D + c) = o; } } }
        asm volatile("s_waitcnt lgkmcnt(0)" ::: "memory"); __builtin_amdgcn_s_barrier(); asm volatile("" ::: "memory");
        { f32x4 acc[2][2];
#pragma unroll
          for (int mt = 0; mt < 2; ++mt)
#pragma unroll
              for (int nt = 0; nt < 2; ++nt) acc[mt][nt] = (f32x4){0.f, 0.f, 0.f, 0.f};
#pragma unroll 4
          for (int ks = 0; ks < 8; ++ks) { const int k0 = 256 * w + 32 * ks + 8 * fq;
              bf16x8 ax[2];
#pragma unroll
              for (int mt = 0; mt < 2; ++mt) ax[mt] = *(const LAS bf16x8*)(XS + (16 * mt + fr) * 4096 + 16 * ((32 * w + 4 * ks + fq) ^ fr));
#pragma unroll
              for (int nt = 0; nt < 2; ++nt) { const bf16x8 bhi = *(const bf16x8*)(RH + (size_t)(16 * nt + fr) * 2048 + k0), blo = *(const bf16x8*)(RL + (size_t)(16 * nt + fr) * 2048 + k0);
#pragma unroll
                  for (int mt = 0; mt < 2; ++mt) { acc[mt][nt] = __builtin_amdgcn_mfma_f32_16x16x32_bf16(bhi, ax[mt], acc[mt][nt], 0, 0, 0);
                      acc[mt][nt] = __builtin_amdgcn_mfma_f32_16x16x32_bf16(blo, ax[mt], acc[mt][nt], 0, 0, 0); } } }
          asm volatile("s_waitcnt lgkmcnt(0)" ::: "memory"); __builtin_amdgcn_s_barrier(); asm volatile("" ::: "memory");
#pragma unroll
          for (int mt = 0; mt < 2; ++mt)
#pragma unroll
              for (int nt = 0; nt < 2; ++nt) *(LAS f32x4*)(PART + (w * 32 + 16 * mt + fr) * 32 + 16 * nt + 4 * fq) = acc[mt][nt]; }
        __syncthreads();
#pragma unroll
        for (int q = 0; q < 2; ++q) { const int o = F.tid + 512 * q; float sum = 0.f;
#pragma unroll
            for (int ww = 0; ww < 8; ++ww) sum += PART[ww * 1024 + o];
            LOG[o] = RS[o >> 5] * sum + RBL[o & 31]; }
        __syncthreads();
        int i1s[4], i2s[4]; float a1s[4], a2s[4];
#pragma unroll
        for (int k = 0; k < 4; ++k) {
            const float mylg = LOG[(4 * w + k) * 32 + (lane & 31)];
            const float myscore = 1.0f / (1.0f + expf(-mylg)), mybias = myscore + rb[lane & 31];
            float m1 = -3.0e38f, m2 = -3.0e38f, w1 = 0.f, w2 = 0.f; int i1 = 0, i2 = 0;
            const int gbase = lane & 24;
#pragma unroll
            for (int i = 0; i < 8; ++i) { const float x = __shfl(mybias, gbase + i), sx = __shfl(myscore, gbase + i);
                if (x > m1) { m2 = m1; i2 = i1; w2 = w1; m1 = x; i1 = i; w1 = sx; } else if (x > m2) { m2 = x; i2 = i; w2 = sx; } }
            const float gs = m1 + m2;
            int gsel = 0; float gbest = __shfl(gs, 0);
#pragma unroll
            for (int g = 1; g < 4; ++g) { const float x = __shfl(gs, 8 * g); if (x > gbest) { gbest = x; gsel = g; } }
            i1 = __shfl(i1, 8 * gsel) + 8 * gsel; i2 = __shfl(i2, 8 * gsel) + 8 * gsel; w1 = __shfl(w1, 8 * gsel); w2 = __shfl(w2, 8 * gsel);
            const float wsum = w1 + w2; i1s[k] = i1; i2s[k] = i2; a1s[k] = w1 / wsum; a2s[k] = w2 / wsum;
        }
        { const int tk = (lane >> 1) & 3, ch = lane & 1;
          int e1 = i1s[0], e2 = i2s[0]; float q1 = a1s[0], q2 = a2s[0];
#pragma unroll
          for (int k = 1; k < 4; ++k) { e1 = (tk == k) ? i1s[k] : e1; e2 = (tk == k) ? i2s[k] : e2; q1 = (tk == k) ? a1s[k] : q1; q2 = (tk == k) ? a2s[k] : q2; }
          const int e = ch ? e2 : e1; const int row = row0b + 4 * w + tk;
          unsigned pos = 0u;
          if (lane < 8) pos = __hip_atomic_fetch_add(LCNT + e, 1u, __ATOMIC_RELAXED, __HIP_MEMORY_SCOPE_WORKGROUP);
          __syncthreads();
          if (F.tid < 32) { const unsigned n = LCNT[F.tid]; LBASE[F.tid] = n ? atomicAdd(cnt + F.tid * 64, n) : 0u; }
          __syncthreads();
          if (lane < 8) { pos += LBASE[e]; list[e * 8192 + pos] = row; }
          const unsigned pa = __shfl(pos, lane & ~1), pb2 = __shfl(pos, lane | 1);
          if (lane < 8 && ch == 0) { u32x4 r0; r0.x = (unsigned)e1; r0.y = (unsigned)e2; r0.z = pa; r0.w = pb2; *(u32x4*)(route + (size_t)row * 8) = r0;
              u32x2 r1; r1.x = __float_as_uint(q1); r1.y = __float_as_uint(q2); *(u32x2*)(route + (size_t)row * 8 + 4) = r1; } }
    }
}
__device__ __forceinline__ void moe_setup(Frame& F, int layer, bool want_tok, int nN) {
    LAS int* pb = (LAS int*)(F.lds + LDS_PB); LAS int* tokt = (LAS int*)(F.lds + LDS_TOK);
    const unsigned* cnt = WSP(unsigned, WS_CTL) + CW_CNT + layer * 32 * 64; const int* list = WSP(int, WS_LIST) + (size_t)layer * 32 * 8192;
    if (F.tid == 0) { int s = 0; for (int e = 0; e < 32; ++e) { pb[e] = s; s += ((int)cnt[e * 64] + 255) >> 8; } pb[32] = s; }
    __syncthreads();
    if (want_tok) {
        pg8::MoeOrder<true> S; S.pb = pb; S.tokt = tokt; S.G = F.G; S.c = F.vcu; S.nN = nN; S.estride = 0;
        for (int i = 0; i < 4; ++i) { pg8::Unit u; if (!S.next(i, u)) break;
            if (F.tid < 256) { const int pos = (u.pm - pb[u.e]) * 256 + F.tid; const int n = (int)cnt[u.e * 64]; tokt[i * 256 + F.tid] = pos < n ? list[u.e * 8192 + pos] : 0; } }
        __syncthreads();
    }
}
struct CombRow { u32x2 ya[8], yb[8], xi[8]; float w0, w1; };
struct CombRoute { u32x4 r0; u32x2 r1; };
__device__ __forceinline__ CombRoute comb_route(const unsigned* route, int row) { CombRoute r; r.r0 = *(const u32x4*)(route + (size_t)row * 8); r.r1 = *(const u32x2*)(route + (size_t)row * 8 + 4); return r; }
__device__ __forceinline__ void comb_issue(CombRow& R, const CombRoute& rt, const LAS int* pb, const bf16* Y, const bf16* xin, int row, int lane) {
    const size_t s0 = (size_t)pb[rt.r0.x] * 256 + rt.r0.z, s1 = (size_t)pb[rt.r0.y] * 256 + rt.r0.w; R.w0 = __uint_as_float(rt.r1.x); R.w1 = __uint_as_float(rt.r1.y);
#pragma unroll
    for (int j = 0; j < 8; ++j) { const int c = 4 * (64 * j + lane);
        R.ya[j] = *(const u32x2*)(Y + s0 * D + c); R.yb[j] = *(const u32x2*)(Y + s1 * D + c); R.xi[j] = *(const u32x2*)(xin + (size_t)row * D + c); }
}
template <class TO> __device__ __forceinline__ void comb_finish(const CombRow& R, const float* gate, TO* xout, bool next_mod, const float* modn, bf16* HA, int row, int lane) {
    f32x4 v[8]; const float w0 = R.w0, w1 = R.w1;
#pragma unroll
    for (int j = 0; j < 8; ++j) { const int c = 4 * (64 * j + lane); const u32x2 ya = R.ya[j], yb = R.yb[j];
        f32x4 y; y[0] = w0 * __uint_as_float(ya.x << 16) + w1 * __uint_as_float(yb.x << 16); y[1] = w0 * __uint_as_float(ya.x & 0xffff0000u) + w1 * __uint_as_float(yb.x & 0xffff0000u);
        y[2] = w0 * __uint_as_float(ya.y << 16) + w1 * __uint_as_float(yb.y << 16); y[3] = w0 * __uint_as_float(ya.y & 0xffff0000u) + w1 * __uint_as_float(yb.y & 0xffff0000u);
        const f32x4 xi = bf4_to_f32(R.xi[j]), g = *(const f32x4*)(gate + c);
        v[j] = xi + g * y;
        if constexpr (sizeof(TO) == 4) *(f32x4*)((float*)xout + (size_t)row * D + c) = v[j]; else *(u32x2*)((bf16*)xout + (size_t)row * D + c) = f32_to_bf4(v[j]); }
    if (next_mod) modulate_store(v, modn, modn + 2048, HA + (size_t)row * D, lane);
}
template <class TO> __device__ __forceinline__ void phase_combine(Frame& F, int layer, const bf16* xin, TO* xout, bool next_mod) {
    const int gw = blockIdx.x * 8 + F.wave, NGW = F.G * 8, lane = F.lane;
    const float* MOD = WSP(float, WS_MOD) + (size_t)layer * 5 * 12288; const float* MODN = WSP(float, WS_MOD) + (size_t)(layer + 1) * 5 * 12288;
    const unsigned* route = WSP(unsigned, WS_ROUTE) + (size_t)layer * TL * 8; const bf16* Y = WSP(bf16, WS_Y); bf16* HA = WSP(bf16, WS_HA);
    const LAS int* pb = (const LAS int*)(F.lds + LDS_PB);
    if (gw >= TL) return;
    CombRoute ra = comb_route(route, gw), rb = comb_route(route, min(gw + NGW, TL - 1));
    for (int row = gw; row < TL; row += 2 * NGW) {
        const int rowA = row, rowB = row + NGW; const bool hasB = rowB < TL; const int rB = hasB ? rowB : rowA;
        CombRow A, B;
        comb_issue(A, ra, pb, Y, xin, rowA, lane);
        comb_issue(B, hasB ? rb : ra, pb, Y, xin, rB, lane);
        ra = comb_route(route, min(row + 2 * NGW, TL - 1)); rb = comb_route(route, min(row + 3 * NGW, TL - 1));
        const int bA = rowA / SEQ, bB = rB / SEQ;
        comb_finish<TO>(A, MOD + (size_t)bA * 12288 + 5 * 2048, xout, next_mod, MODN + (size_t)bA * 12288, HA, rowA, lane);
        if (hasB) comb_finish<TO>(B, MOD + (size_t)bB * 12288 + 5 * 2048, xout, next_mod, MODN + (size_t)bB * 12288, HA, rowB, lane);
    }
}
__device__ __forceinline__ void phase_conv(Frame& F) {
    const bf16* GB = WSP(bf16, WS_GB); const bf16* P = WSP(bf16, WS_PGU); bf16* Z = WSP(bf16, WS_Z); const float* cw = F.in[I_CW];
    const size_t total = (size_t)TL * D / 8;
    for (size_t i = (size_t)blockIdx.x * 512 + F.tid; i < total; i += (size_t)F.G * 512) {
        const int row = (int)(i >> 8), c = (int)(i & 255) * 8, t = row % SEQ;
        const u32x4 pc = *(const u32x4*)(P + (size_t)row * D + c), gb = *(const u32x4*)(GB + (size_t)row * D + c);
        u32x4 pm = (u32x4){0u, 0u, 0u, 0u}, pp = (u32x4){0u, 0u, 0u, 0u};
        if (t > 0) pm = *(const u32x4*)(P + (size_t)(row - 1) * D + c);
        if (t < SEQ - 1) pp = *(const u32x4*)(P + (size_t)(row + 1) * D + c);
        const unsigned am[4] = {pm.x, pm.y, pm.z, pm.w}, ac[4] = {pc.x, pc.y, pc.z, pc.w}, ap[4] = {pp.x, pp.y, pp.z, pp.w}, ag[4] = {gb.x, gb.y, gb.z, gb.w};
        unsigned ow[4];
#pragma unroll
        for (int q = 0; q < 4; ++q) { float r[2];
#pragma unroll
            for (int hh = 0; hh < 2; ++hh) { const int cc = c + 2 * q + hh;
                const float vm = hh ? __uint_as_float(am[q] & 0xffff0000u) : __uint_as_float(am[q] << 16), vc = hh ? __uint_as_float(ac[q] & 0xffff0000u) : __uint_as_float(ac[q] << 16);
                const float vp = hh ? __uint_as_float(ap[q] & 0xffff0000u) : __uint_as_float(ap[q] << 16), vg = hh ? __uint_as_float(ag[q] & 0xffff0000u) : __uint_as_float(ag[q] << 16);
                r[hh] = vg * (cw[cc] * vm + cw[2048 + cc] * vc + cw[4096 + cc] * vp); }
            ow[q] = cvt_pk_bf16(r[0], r[1]); }
        u32x4 o; o.x = ow[0]; o.y = ow[1]; o.z = ow[2]; o.w = ow[3];
        *(u32x4*)(Z + (size_t)row * D + c) = o;
    }
}

constexpr int NPHASE = 18;
__global__ void __launch_bounds__(512, 2) fwd_kernel(Args args) {
    extern __shared__ __attribute__((aligned(16))) unsigned char lds_raw[];
    Frame F;
    F.lds = (LAS unsigned char*)lds_raw; F.out = args.out; F.ws = args.ws;
#pragma unroll
    for (int i = 0; i < 22; ++i) F.in[i] = args.in[i];
    F.tid = threadIdx.x; F.lane = F.tid & 63; F.wave = __builtin_amdgcn_readfirstlane(F.tid >> 6); F.G = gridDim.x;
    { const int bx = blockIdx.x; F.vcu = (F.G % 8 == 0) ? (bx % 8) * (F.G / 8) + bx / 8 : bx; }
    volatile LAS unsigned* MISC = (volatile LAS unsigned*)(F.lds + LDS_MISC);
    if (F.tid < 64) MISC[F.tid] = 0u;
    __syncthreads();
    const int lo = args.ph_lo, hi = args.ph_hi;
    XcdBarrier bar; bar.bar = WSP(unsigned, WS_CTL) + CW_BAR; bar.x = 0; bar.st = nullptr;
    if (hi - lo > 1) bar = xcd_barrier_post(WSP(unsigned, WS_CTL) + CW_BAR, MISC + 8);
#ifndef PH_MASK
#define PH_MASK 0xFFFFFFFFu
#endif
#define IN(k) (((PH_MASK >> (k)) & 1u) && lo <= (k) && (k) < hi)
#define SEAM(k) do { if (IN(k) && IN((k) + 1)) xcd_barrier(bar); } while (0)
    const float* MOD = WSP(float, WS_MOD);

    if (IN(0)) { phase0(F); } SEAM(0);
    if (IN(1)) { phase_modulate0(F); } SEAM(1);
    if (IN(2)) {
        pg8::Gemm g{WSP(bf16, WS_HA), WSP(bf16, WS_WIN_T), D}; pg8::StaticOrder S; S.init(TA, NPROJ, F.G, (int)blockIdx.x);
        pg8::EpiBf16 E{WSP(bf16, WS_PROJ), NPROJ};
        const int grp = F.vcu & 3;
        pg8::StaticOrder Sa; Sa.init(TA, NPROJ, F.G, (int)blockIdx.x); Sa.ilo = 0; Sa.ihi = grp;
        pg8::StaticOrder Sb; Sb.init(TA, NPROJ, F.G, (int)blockIdx.x); Sb.ilo = grp; Sb.ihi = 1 << 30;
        pg8::gemm_phase<pg8::EpiBf16, pg8::StaticOrder, true>(F.lds, g, Sa, E);
        convert_claim(F, 30, 0);
        pg8::gemm_phase<pg8::EpiBf16, pg8::StaticOrder, true>(F.lds, g, Sb, E);
        if (2L * F.G + (long)blockIdx.x >= (long)(TA / 256) * (NPROJ / 256)) convert_claim(F, 18, 0);
    } SEAM(2);
    if (IN(3)) { phase_prep(F); gla_g1_all(F); } SEAM(3);
    if (IN(4)) {
        if (blockIdx.x < 128) { gla_g2(F, blockIdx.x); convert_claim(F, 6, 0); }
        else { const int st = F.G > 129 ? F.G - 128 : 1; for (int u = blockIdx.x - 128; u < 256; u += st) attn_unit(F, u); }
    } SEAM(4);
    if (IN(5)) { phase_gla_out(F); } SEAM(5);
    if (IN(6)) {
        pg8::Gemm g{WSP(bf16, WS_MIX), WSP(bf16, WS_WOUT_T), D}; pg8::StaticOrder S; S.init(TL, D, F.G, (int)blockIdx.x);
        pg8::EpiResGate<false> E{F.in[I_X], WSP(bf16, WS_X1), MOD + 2 * 2048, 12288};
        if ((F.vcu & 1) == 0) convert_claim(F, 12, 0);
        pg8::gemm_phase<pg8::EpiResGate<false>, pg8::StaticOrder, false>(F.lds, g, S, E);
        convert_claim(F, 0, CV_B0);
    } SEAM(6);
#define MOE_PHASES(layer, pbase, xin, xout, nextmod) \
    if (IN(pbase)) { phase_route(F, layer, xin); } SEAM(pbase); \
    if (IN((pbase) + 1)) { \
        moe_setup(F, layer, true, 8); \
        pg8::Gemm g{WSP(bf16, WS_HA), WSP(bf16, WS_W13_T) + (size_t)(layer) * 32 * 2048 * 2048, D}; \
        pg8::MoeOrder<true> S; S.pb = (const LAS int*)(F.lds + LDS_PB); S.tokt = (const LAS int*)(F.lds + LDS_TOK); S.G = F.G; S.c = F.vcu; S.nN = 8; S.estride = (size_t)2048 * 2048 * 2; \
        pg8::EpiPair<true> E{WSP(bf16, WS_HMID), DEXP, 0, nullptr, 0}; \
        pg8::gemm_phase<pg8::EpiPair<true>, pg8::MoeOrder<true>, true>(F.lds, g, S, E); \
        { const int tot = S.pb[32] * 8, mx = (tot + F.G - 1) / F.G, mine = tot > F.vcu ? (tot - F.vcu + F.G - 1) / F.G : 0; convert_claim(F, mine < mx ? 12 : 0, (layer) == 0 ? CV_B1 : CV_B3); } \
    } SEAM((pbase) + 1); \
    if (IN((pbase) + 2)) { \
        moe_setup(F, layer, false, 8); \
        pg8::Gemm g{WSP(bf16, WS_HMID), WSP(bf16, WS_W2_T) + (size_t)(layer) * 32 * 2048 * 1024, DEXP}; \
        pg8::MoeOrder<false> S; S.pb = (const LAS int*)(F.lds + LDS_PB); S.tokt = nullptr; S.G = F.G; S.c = F.vcu; S.nN = 8; S.estride = (size_t)2048 * 1024 * 2; \
        pg8::EpiBf16 E{WSP(bf16, WS_Y), D}; \
        pg8::gemm_phase<pg8::EpiBf16, pg8::MoeOrder<false>, true>(F.lds, g, S, E); \
        if ((layer) == 0) { const int tot = S.pb[32] * 8, mx = (tot + F.G - 1) / F.G, mine = tot > F.vcu ? (tot - F.vcu + F.G - 1) / F.G : 0; if (mine < mx) convert_claim(F, 6, 0); } \
    } SEAM((pbase) + 2); \
    if (IN((pbase) + 3)) { moe_setup(F, layer, false, 8); phase_combine(F, layer, xin, xout, nextmod); }

    MOE_PHASES(0, 7, WSP(bf16, WS_X1), WSP(bf16, WS_X2), true)
    SEAM(10);
    if (IN(11)) {
        pg8::Gemm g{WSP(bf16, WS_HA), WSP(bf16, WS_CIN_T), D}; pg8::StaticOrder S; S.init(TL, 6144, F.G, (int)blockIdx.x);
        pg8::EpiPair<false> E{WSP(bf16, WS_PGU), D, 8, WSP(bf16, WS_GB), D};
        const int grp = F.vcu & 3;
        pg8::StaticOrder Sa; Sa.init(TL, 6144, F.G, (int)blockIdx.x); Sa.ilo = 0; Sa.ihi = grp;
        pg8::StaticOrder Sb; Sb.init(TL, 6144, F.G, (int)blockIdx.x); Sb.ilo = grp; Sb.ihi = 1 << 30;
        pg8::gemm_phase<pg8::EpiPair<false>, pg8::StaticOrder, true>(F.lds, g, Sa, E);
        convert_claim(F, 30, 0);
        pg8::gemm_phase<pg8::EpiPair<false>, pg8::StaticOrder, true>(F.lds, g, Sb, E);
    } SEAM(11);
    if (IN(12)) { phase_conv(F); } SEAM(12);
    if (IN(13)) {
        pg8::Gemm g{WSP(bf16, WS_Z), WSP(bf16, WS_COUT_T), D}; pg8::StaticOrder S; S.init(TL, D, F.G, (int)blockIdx.x);
        pg8::EpiResGate<true> E{WSP(bf16, WS_X2), WSP(bf16, WS_X3), MOD + 5 * 12288 + 2 * 2048, 12288};
        if ((F.vcu & 1) == 0) convert_claim(F, 12, 0);
        pg8::gemm_phase<pg8::EpiResGate<true>, pg8::StaticOrder, false>(F.lds, g, S, E);
        convert_claim(F, 0, CV_B2);
    } SEAM(13);
    MOE_PHASES(1, 14, WSP(bf16, WS_X3), F.out, false)
#undef MOE_PHASES
#undef IN
#undef SEAM
}

extern "C" void kernel_launch(void* const* d_in, const int* in_sizes, int n_in, void* d_out, int out_size, void* d_ws, size_t ws_size, hipStream_t stream) {
    static int grid = 0;
    if (grid == 0) {
        if (n_in != 22 || out_size != TL * D || ws_size < WS_END) { fprintf(stderr, "kernel_launch: unexpected problem (n_in %d, out %d, ws %zu < %zu)\n", n_in, out_size, ws_size, (size_t)WS_END); grid = -1; return; }
        int dev = 0, cus = 0, per_cu = 0;
        if (hipGetDevice(&dev) != hipSuccess || hipDeviceGetAttribute(&cus, hipDeviceAttributeMultiprocessorCount, dev) != hipSuccess) { grid = -1; return; }
        if (hipFuncSetAttribute((const void*)fwd_kernel, hipFuncAttributeMaxDynamicSharedMemorySize, LDS_BYTES) != hipSuccess) { fprintf(stderr, "kernel_launch: hipFuncSetAttribute failed\n"); grid = -1; return; }
        if (hipOccupancyMaxActiveBlocksPerMultiprocessor(&per_cu, (const void*)fwd_kernel, 512, LDS_BYTES) != hipSuccess || per_cu < 1) { fprintf(stderr, "kernel_launch: occupancy query says %d\n", per_cu); }
        (void)hipGetLastError();
        grid = cus;
    }
    if (grid < 0) return;
    (void)hipMemsetAsync((char*)d_ws + WS_CTL, 0, CTL_ZERO_BYTES, stream);
    Args a{};
    for (int i = 0; i < 22; ++i) a.in[i] = (const float*)d_in[i];
    a.out = (float*)d_out; a.ws = (unsigned char*)d_ws;
#if MK_N_LAUNCHES == 1
    a.ph_lo = 0; a.ph_hi = NPHASE;
    hipLaunchKernelGGL(fwd_kernel, dim3(grid), dim3(512), LDS_BYTES, stream, a);
#else
    for (int p = 0; p < NPHASE; ++p) { a.ph_lo = p; a.ph_hi = p + 1; hipLaunchKernelGGL(fwd_kernel, dim3(grid), dim3(512), LDS_BYTES, stream, a); }
#endif
}
```

```cpp
#include <hip/hip_runtime.h>
#include <cstdio>
#include <cstdint>

#ifndef MK_N_LAUNCHES
#define MK_N_LAUNCHES 1
#endif

#define GAS __attribute__((address_space(1)))
#define LAS __attribute__((address_space(3)))
typedef unsigned short bf16;
typedef short bf16x8 __attribute__((ext_vector_type(8)));
typedef float f32x4 __attribute__((ext_vector_type(4)));
typedef float f32x2 __attribute__((ext_vector_type(2)));
typedef unsigned u32x4 __attribute__((ext_vector_type(4)));
typedef unsigned u32x2 __attribute__((ext_vector_type(2)));

constexpr int D = 2048, BATCH = 4, SEQ = 2048, CTXL = 256;
constexpr int TL = BATCH * SEQ;
constexpr int TC = BATCH * CTXL;
constexpr int TA = TL + TC;
constexpr int NPROJ = 4864;
constexpr int C_AQ = 0, C_AK = 1024, C_AV = 1280, C_GQ = 1536, C_GK = 2048, C_GV = 2560, C_GG = 3584, C_LR = 4608;
constexpr int NEXP = 32, DEXP = 1024;
constexpr float EPS = 1e-6f;

constexpr size_t MiB = 1u << 20;
constexpr size_t WS_CTL = 0, CTL_ZERO_BYTES = 128 * 1024;
constexpr size_t WS_MOD = 1 * MiB;
constexpr size_t WS_ROUTE = 2 * MiB;
constexpr size_t WS_LIST = 3 * MiB;
constexpr size_t WS_RWT_HI = 6 * MiB;
constexpr size_t WS_RWT_LO = 7 * MiB;
constexpr size_t WS_RBIAS = 1 * MiB + 512 * 1024;
constexpr size_t WS_WIN_T = 8 * MiB;
constexpr size_t WS_WOUT_T = 28 * MiB;
constexpr size_t WS_CIN_T = 36 * MiB;
constexpr size_t WS_COUT_T = 60 * MiB;
constexpr size_t WS_W13_T = 68 * MiB;
constexpr size_t WS_W2_T = 580 * MiB;
constexpr size_t WS_HA = 836 * MiB;
constexpr size_t WS_PROJ = 872 * MiB;
constexpr size_t WS_LA = 958 * MiB;
constexpr size_t WS_VTL = 994 * MiB;
constexpr size_t WS_VTC = 998 * MiB;
constexpr size_t WS_OG = 1000 * MiB;
constexpr size_t WS_MIX = 1064 * MiB;
constexpr size_t WS_X1 = 1096 * MiB;
constexpr size_t WS_HMID = 1160 * MiB;
constexpr size_t WS_Y = 1208 * MiB;
constexpr size_t WS_X2 = 1304 * MiB;
constexpr size_t WS_GB = 1368 * MiB;
constexpr size_t WS_PGU = 1400 * MiB;
constexpr size_t WS_Z = 1432 * MiB;
constexpr size_t WS_X3 = 1464 * MiB;
constexpr size_t WS_QF = 1528 * MiB;
constexpr size_t WS_KLT = 1546 * MiB;
constexpr size_t WS_ATT = 1564 * MiB;
constexpr size_t WS_VT = 1573 * MiB;
constexpr size_t WS_DEC = 1609 * MiB;
constexpr size_t WS_END = 1610 * MiB;
constexpr int CW_BAR = 4096;
constexpr int CW_CNT = 8192;
constexpr int CW_CVT = 16384;
constexpr int CW_P0 = 16384 + 512;

constexpr int RING_BYTES = 131072;
constexpr int LDS_MISC = RING_BYTES;
constexpr int LDS_PB = RING_BYTES + 256;
constexpr int LDS_TOK = RING_BYTES + 1024;
constexpr int LDS_BYTES = 147456;

__device__ __forceinline__ float bf2f(unsigned short b) { return __uint_as_float(((unsigned)b) << 16); }
__device__ __forceinline__ unsigned cvt_pk_bf16(float lo, float hi) { unsigned r; asm volatile("v_cvt_pk_bf16_f32 %0, %1, %2" : "=v"(r) : "v"(lo), "v"(hi)); return r; }
__device__ __forceinline__ float wave_sum(float v) {
#pragma unroll
    for (int o = 1; o < 64; o <<= 1) v += __shfl_xor(v, o);
    return v;
}
__device__ __forceinline__ float silu_f(float v) { return v / (1.0f + __expf(-v)); }
__device__ __forceinline__ f32x4 bf4_to_f32(u32x2 w) { f32x4 r; r[0] = __uint_as_float(w.x << 16); r[1] = __uint_as_float(w.x & 0xffff0000u); r[2] = __uint_as_float(w.y << 16); r[3] = __uint_as_float(w.y & 0xffff0000u); return r; }
__device__ __forceinline__ u32x2 f32_to_bf4(f32x4 v) { u32x2 w; w.x = cvt_pk_bf16(v[0], v[1]); w.y = cvt_pk_bf16(v[2], v[3]); return w; }
__device__ __forceinline__ void mfma_settle(f32x4& a) { asm volatile("s_nop 7\n\ts_nop 7" : "+v"(a)); }
__device__ __forceinline__ unsigned f2bf_sw(float f) { const unsigned u = __float_as_uint(f); return (u + 0x7fffu + ((u >> 16) & 1u)) >> 16; }
__device__ __forceinline__ u32x2 f32_to_bf4_sw(f32x4 v) { u32x2 w; w.x = f2bf_sw(v[0]) | (f2bf_sw(v[1]) << 16); w.y = f2bf_sw(v[2]) | (f2bf_sw(v[3]) << 16); return w; }

namespace pg8 {
constexpr int BM = 256, BK = 64, HALF = 128, HTB = HALF * BK * 2, STAGE_BYTES = 8 * HTB, NXCD = 8, WGM = 8;
__host__ __device__ __forceinline__ int lds_byte(int r, int c) { const int st = (r >> 4) * 2 + (c >> 5), rr = r & 15, cc = c & 31, ob = rr * 64 + cc * 2; return st * 1024 + (ob ^ (((ob >> 9) & 1) << 5)); }
__host__ __device__ __forceinline__ void stage_rc(int b, int& R, int& C) { const int st = b / 1024, sb = b % 1024, swz = sb ^ (((sb >> 9) & 1) << 5); R = (st >> 1) * 16 + swz / 64; C = (st & 1) * 32 + (swz % 64) / 2; }
__host__ __device__ __forceinline__ int perm32(int rho) { const int n = rho >> 4, i = rho & 15; return 8 * (i >> 2) + 4 * n + (i & 3); }

struct Unit { int pm, pn, e; };
struct Gemm { const bf16* A; const bf16* Bt; int K; };

struct StaticOrder {
    static constexpr bool GATHER = false;
    int nM, nN, nwg, G, c, ilo, ihi;
    __device__ void init(int M, int N, int G_, int c_) { nM = M / BM; nN = N / BM; nwg = nM * nN; G = G_; c = c_; ilo = 0; ihi = 1 << 30; }
    __device__ bool next(int i0, Unit& u) const {
        const int i = i0 + ilo; if (i >= ihi) return false;
        const long L = (long)i * G + c; if (L >= nwg) return false;
        int wgid = (int)L; { const int q = nwg / NXCD, r = nwg % NXCD, xcd = wgid % NXCD, off = wgid / NXCD; wgid = (xcd < r ? xcd * (q + 1) : r * (q + 1) + (xcd - r) * q) + off; }
        const int nig = WGM * nN, gid = wgid / nig, fm = gid * WGM, gsz = (nM - fm) < WGM ? (nM - fm) : WGM;
        u.pm = fm + ((wgid % nig) % gsz); u.pn = (wgid % nig) / gsz; u.e = 0; return true;
    }
    __device__ __forceinline__ const char* b_ptr(const Gemm& g, const Unit& u, size_t tstep) const { return (const char*)g.Bt + (size_t)u.pn * tstep; }
    __device__ __forceinline__ unsigned tok(int, int) const { return 0u; }
};
template <bool GATHER_> struct MoeOrder {
    static constexpr bool GATHER = GATHER_;
    const LAS int* pb; const LAS int* tokt; int G, c, nN; size_t estride;
    __device__ bool next(int i, Unit& u) const {
        const int L = i * G + c; const int total = pb[32] * nN; if (L >= total) return false;
        int e = 0;
#pragma unroll 1
        for (int j = 1; j < 32; ++j) if (pb[j] * nN <= L) e = j;
        const int r = L - pb[e] * nN, np = pb[e + 1] - pb[e];
        u.e = e; u.pn = r / np; u.pm = pb[e] + (r % np); return true;
    }
    __device__ __forceinline__ const char* b_ptr(const Gemm& g, const Unit& u, size_t tstep) const { return (const char*)g.Bt + (size_t)u.e * estride + (size_t)u.pn * tstep; }
    __device__ __forceinline__ unsigned tok(int ui, int r) const { return (unsigned)tokt[(ui & 3) * 256 + r]; }
};

struct EpiBf16 {
    static constexpr bool PERM = true;
    bf16* O; int ldc;
    __device__ __forceinline__ void operator()(const f32x4 (&acc)[2][2][4][2], const Unit& u, int wr, int wc, int fr, int fq) const {
        const int row0 = u.pm * BM + wr * 64 + fr, col0 = u.pn * BM + wc * 32 + 8 * fq;
        { f32x4 t = acc[1][1][3][1]; mfma_settle(t); }
#pragma unroll
        for (int ai = 0; ai < 2; ++ai)
#pragma unroll
            for (int m = 0; m < 4; ++m) { bf16* rowp = O + (size_t)(row0 + ai * HALF + m * 16) * ldc + col0;
#pragma unroll
                for (int bj = 0; bj < 2; ++bj) { const f32x4 v0 = acc[ai][bj][m][0], v1 = acc[ai][bj][m][1];
                    u32x4 w; w.x = cvt_pk_bf16(v0[0], v0[1]); w.y = cvt_pk_bf16(v0[2], v0[3]); w.z = cvt_pk_bf16(v1[0], v1[1]); w.w = cvt_pk_bf16(v1[2], v1[3]);
                    *(u32x4*)(rowp + bj * HALF) = w; } }
    }
};
template <bool SILU> struct EpiPair {
    static constexpr bool PERM = true;
    bf16* O; int ldo; int pn0; bf16* P; int ldp;
    __device__ __forceinline__ void operator()(const f32x4 (&acc)[2][2][4][2], const Unit& u, int wr, int wc, int fr, int fq) const {
        const int row0 = u.pm * BM + wr * 64 + fr;
        { f32x4 t = acc[1][1][3][1]; mfma_settle(t); }
        if (u.pn < pn0) {
            const int col0 = u.pn * BM + wc * 32 + 8 * fq;
#pragma unroll
            for (int ai = 0; ai < 2; ++ai)
#pragma unroll
                for (int m = 0; m < 4; ++m) { bf16* rowp = P + (size_t)(row0 + ai * HALF + m * 16) * ldp + col0;
#pragma unroll
                    for (int bj = 0; bj < 2; ++bj) { const f32x4 v0 = acc[ai][bj][m][0], v1 = acc[ai][bj][m][1];
                        u32x4 w; w.x = cvt_pk_bf16(v0[0], v0[1]); w.y = cvt_pk_bf16(v0[2], v0[3]); w.z = cvt_pk_bf16(v1[0], v1[1]); w.w = cvt_pk_bf16(v1[2], v1[3]);
                        *(u32x4*)(rowp + bj * HALF) = w; } }
        } else {
            const int col0 = (u.pn - pn0) * HALF + wc * 32 + 8 * fq;
#pragma unroll
            for (int ai = 0; ai < 2; ++ai)
#pragma unroll
                for (int m = 0; m < 4; ++m) { bf16* rowp = O + (size_t)(row0 + ai * HALF + m * 16) * ldo + col0;
                    f32x4 g0 = acc[ai][0][m][0], g1 = acc[ai][0][m][1]; const f32x4 u0 = acc[ai][1][m][0], u1 = acc[ai][1][m][1];
                    if (SILU) {
#pragma unroll
                        for (int j = 0; j < 4; ++j) { g0[j] = silu_f(g0[j]); g1[j] = silu_f(g1[j]); } }
                    g0 = g0 * u0; g1 = g1 * u1;
                    u32x4 w; w.x = cvt_pk_bf16(g0[0], g0[1]); w.y = cvt_pk_bf16(g0[2], g0[3]); w.z = cvt_pk_bf16(g1[0], g1[1]); w.w = cvt_pk_bf16(g1[2], g1[3]);
                    *(u32x4*)rowp = w; }
        }
    }
};
template <bool BASE_BF16> struct EpiResGate {
    static constexpr bool PERM = false;
    const void* base; bf16* out; const float* gate; int gstride;
    __device__ __forceinline__ void operator()(const f32x4 (&acc)[2][2][4][2], const Unit& u, int wr, int wc, int fr, int fq) const {
        const int row0 = u.pm * BM + wr * 64 + fr, col0 = u.pn * BM + wc * 32 + 4 * fq;
        const float* gp = gate + (size_t)((u.pm * BM) / SEQ) * gstride + col0;
        f32x4 gv[2][2];
#pragma unroll
        for (int bj = 0; bj < 2; ++bj)
#pragma unroll
            for (int n = 0; n < 2; ++n) gv[bj][n] = *(const f32x4*)(gp + bj * HALF + n * 16);
#pragma unroll
        for (int ai = 0; ai < 2; ++ai)
#pragma unroll
            for (int m = 0; m < 4; ++m) { const size_t off = (size_t)(row0 + ai * HALF + m * 16) * D + col0;
#pragma unroll
                for (int bj = 0; bj < 2; ++bj)
#pragma unroll
                    for (int n = 0; n < 2; ++n) { const size_t o = off + bj * HALF + n * 16;
                        const f32x4 bs = BASE_BF16 ? bf4_to_f32(*(const u32x2*)((const bf16*)base + o)) : *(const f32x4*)((const float*)base + o);
                        *(u32x2*)(out + o) = f32_to_bf4(bs + gv[bj][n] * acc[ai][bj][m][n]); } }
    }
};

template <class Epi, class Sched, bool ALIGN_EPI>
__device__ __forceinline__ void gemm_phase(LAS unsigned char* lds, const Gemm g, const Sched& S, const Epi& E) {
    const int tid = threadIdx.x, wid = __builtin_amdgcn_readfirstlane(tid >> 6), lane = tid & 63, wr = wid >> 2, wc = wid & 3, fr = lane & 15, fq = lane >> 4;
    const int K = g.K, nt = K / BK;
    unsigned voffA[2], voffB[2]; int stR[2], stC[2];
#pragma unroll
    for (int i = 0; i < 2; ++i) { int R, C; stage_rc(tid * 16 + i * 8192, R, C); const int Rb = Epi::PERM ? ((R & ~31) + perm32(R & 31)) : R;
        stR[i] = R; stC[i] = C; voffA[i] = (unsigned)(R * K + C) * 2u; voffB[i] = (unsigned)(Rb * K + C) * 2u; }
    const size_t kstep = (size_t)(BK * 2);
    const size_t hstep = (size_t)HALF * K * 2;
    const size_t tstep = 2 * hstep;
    const unsigned ldsw = (unsigned)wid * 1024u;
    const int aoff = lds_byte(wr * 64 + fr, fq * 8), boff = lds_byte(wc * 32 + fr, fq * 8);
#define PG8_SA(b, h) (((b) * 2 + (h)) * HTB)
#define PG8_SB(b, h) ((4 + (b) * 2 + (h)) * HTB)
#define PG8_STAGE(bufoff, gbase, voff) do { _Pragma("unroll") for (int _i = 0; _i < 2; ++_i) \
        __builtin_amdgcn_global_load_lds((const unsigned*)((const char*)(gbase) + (voff)[_i]), (LAS unsigned*)(lds + (bufoff) + ldsw + _i * 8192), 16, 0, 0); } while (0)
#define PG8_STAGE_A(bufoff, h, ubase, kb, vo) do { if constexpr (Sched::GATHER) { PG8_STAGE(bufoff, (const char*)g.A + (kb), (vo)[h]); } else { PG8_STAGE(bufoff, (ubase) + (h) * hstep + (kb), voffA); } } while (0)
#define PG8_LDA(dst, b, h) do { _Pragma("unroll") for (int m = 0; m < 4; ++m) _Pragma("unroll") for (int k = 0; k < 2; ++k) dst[m][k] = *(const LAS bf16x8*)(lds + PG8_SA(b, h) + aoff + m * 2048 + k * 1024); } while (0)
#define PG8_LDB(dst, b, h) do { _Pragma("unroll") for (int n = 0; n < 2; ++n) _Pragma("unroll") for (int k = 0; k < 2; ++k) dst[n][k] = *(const LAS bf16x8*)(lds + PG8_SB(b, h) + boff + n * 2048 + k * 1024); } while (0)
#define PG8_MMA(ai, bj, At, Bt) do { __builtin_amdgcn_s_setprio(1); _Pragma("unroll") for (int m = 0; m < 4; ++m) _Pragma("unroll") for (int n = 0; n < 2; ++n) _Pragma("unroll") for (int k = 0; k < 2; ++k) \
        acc[ai][bj][m][n] = __builtin_amdgcn_mfma_f32_16x16x32_bf16(Bt[n][k], At[m][k], acc[ai][bj][m][n], 0, 0, 0); __builtin_amdgcn_s_setprio(0); } while (0)
#define PG8_WAIT_V(n) asm volatile("s_waitcnt vmcnt(" #n ")" ::: "memory")
#define PG8_WAIT_L(n) asm volatile("s_waitcnt lgkmcnt(" #n ")" ::: "memory")
#define PG8_BAR __builtin_amdgcn_s_barrier()
#define PG8_SCHED __builtin_amdgcn_sched_barrier(0)
    Unit cur, nxt; int ui = 0;
    if (!S.next(0, cur)) return;
    f32x4 acc[2][2][4][2];
#pragma unroll
    for (int a = 0; a < 2; ++a)
#pragma unroll
        for (int b = 0; b < 2; ++b)
#pragma unroll
            for (int m = 0; m < 4; ++m)
#pragma unroll
                for (int n = 0; n < 2; ++n) acc[a][b][m][n] = (f32x4){0.f, 0.f, 0.f, 0.f};
    bf16x8 At[4][2], B0[2][2], B1[2][2];
    const char* cA = (const char*)g.A + (size_t)cur.pm * tstep; const char* cB = S.b_ptr(g, cur, tstep);
    unsigned voC[2][2] = {{0u, 0u}, {0u, 0u}};
    if constexpr (Sched::GATHER) {
#pragma unroll
        for (int h = 0; h < 2; ++h)
#pragma unroll
            for (int i = 0; i < 2; ++i) voC[h][i] = (S.tok(0, h * HALF + stR[i]) * (unsigned)K + (unsigned)stC[i]) * 2u;
    }
    PG8_STAGE(PG8_SB(0, 0), cB, voffB); PG8_STAGE(PG8_SB(0, 1), cB + hstep, voffB); PG8_STAGE_A(PG8_SA(0, 0), 0, cA, 0, voC); PG8_STAGE_A(PG8_SA(0, 1), 1, cA, 0, voC);
    if (wr == 1) PG8_BAR;
    PG8_WAIT_V(2); PG8_BAR;
    PG8_STAGE(PG8_SB(1, 0), cB + kstep, voffB); PG8_STAGE_A(PG8_SA(1, 0), 0, cA, kstep, voC); PG8_STAGE(PG8_SB(1, 1), cB + hstep + kstep, voffB);
    PG8_WAIT_V(6); PG8_BAR;
    for (;;) {
        const bool has_next = S.next(ui + 1, nxt);
        const char* nA = has_next ? (const char*)g.A + (size_t)nxt.pm * tstep : cA; const char* nB = has_next ? S.b_ptr(g, nxt, tstep) : cB;
        for (int t = 0; t < nt; t += 2) {
            const bool last = (t == nt - 2);
            const char* a1 = cA; const size_t k1 = (size_t)(t + 1) * kstep;
            const char* a2 = last ? nA : cA; const size_t k2 = last ? 0 : (size_t)(t + 2) * kstep; const char* b2 = last ? nB : cB + (size_t)(t + 2) * kstep;
            const size_t k3 = k2 + kstep; const char* b3 = b2 + kstep;
            unsigned vo2[2][2] = {{0u, 0u}, {0u, 0u}};
            if constexpr (Sched::GATHER) {
                if (last && has_next) {
#pragma unroll
                    for (int h = 0; h < 2; ++h)
#pragma unroll
                        for (int i = 0; i < 2; ++i) vo2[h][i] = (S.tok(ui + 1, h * HALF + stR[i]) * (unsigned)K + (unsigned)stC[i]) * 2u;
                } else {
#pragma unroll
                    for (int h = 0; h < 2; ++h)
#pragma unroll
                        for (int i = 0; i < 2; ++i) vo2[h][i] = voC[h][i];
                }
            }
            PG8_LDB(B0, 0, 0); PG8_LDB(B1, 0, 1); PG8_SCHED; PG8_LDA(At, 0, 0); PG8_STAGE_A(PG8_SA(1, 1), 1, a1, k1, voC);
            PG8_WAIT_V(8); PG8_WAIT_L(0); PG8_BAR; PG8_MMA(0, 0, At, B0); PG8_MMA(0, 1, At, B1); PG8_BAR; PG8_SCHED;
            PG8_LDA(At, 0, 1); PG8_STAGE(PG8_SB(0, 0), b2, voffB); PG8_STAGE(PG8_SB(0, 1), b2 + hstep, voffB); PG8_STAGE_A(PG8_SA(0, 0), 0, a2, k2, vo2);
            PG8_WAIT_V(8); PG8_WAIT_L(0); PG8_BAR; PG8_MMA(1, 0, At, B0); PG8_MMA(1, 1, At, B1); PG8_BAR; PG8_SCHED;
            PG8_LDB(B0, 1, 0); PG8_LDB(B1, 1, 1); PG8_SCHED; PG8_LDA(At, 1, 0); PG8_STAGE_A(PG8_SA(0, 1), 1, a2, k2, vo2);
            PG8_WAIT_V(8); PG8_WAIT_L(0); PG8_BAR; PG8_MMA(0, 0, At, B0); PG8_MMA(0, 1, At, B1); PG8_BAR; PG8_SCHED;
            PG8_LDA(At, 1, 1); PG8_STAGE(PG8_SB(1, 0), b3, voffB); PG8_STAGE(PG8_SB(1, 1), b3 + hstep, voffB); PG8_STAGE_A(PG8_SA(1, 0), 0, a2, k3, vo2);
            PG8_WAIT_V(8); PG8_WAIT_L(0); PG8_BAR; PG8_MMA(1, 0, At, B0); PG8_MMA(1, 1, At, B1); PG8_BAR; PG8_SCHED;
            if constexpr (Sched::GATHER) { if (last) {
#pragma unroll
                for (int h = 0; h < 2; ++h)
#pragma unroll
                    for (int i = 0; i < 2; ++i) voC[h][i] = vo2[h][i]; } }
        }
        if constexpr (ALIGN_EPI) { if (wr == 0) PG8_BAR; }
        E(acc, cur, wr, wc, fr, fq);
        if (!has_next) break;
#pragma unroll
        for (int a = 0; a < 2; ++a)
#pragma unroll
            for (int b = 0; b < 2; ++b)
#pragma unroll
                for (int m = 0; m < 4; ++m)
#pragma unroll
                    for (int n = 0; n < 2; ++n) acc[a][b][m][n] = (f32x4){0.f, 0.f, 0.f, 0.f};
        cur = nxt; cA = nA; cB = nB; ++ui;
        if constexpr (ALIGN_EPI) { if (wr == 1) PG8_BAR; }
    }
    PG8_WAIT_V(0);
    if constexpr (!ALIGN_EPI) { if (wr == 0) PG8_BAR; }
    PG8_BAR;
#undef PG8_SA
#undef PG8_SB
#undef PG8_STAGE
#undef PG8_STAGE_A
#undef PG8_LDA
#undef PG8_LDB
#undef PG8_MMA
#undef PG8_WAIT_V
#undef PG8_WAIT_L
#undef PG8_BAR
#undef PG8_SCHED
}
}

#define XB_TMO      128
#define XB_XCNT(j)  (256  + 64 * (j))
#define XB_XSUB(j)  (1280 + 64 * (j))
#define XB_XGEN(j)  (2304 + 64 * (j))
#define XB_TOP      3328
#define XB_TOPGEN   3392
#define XCD_BAR_WORDS 3456
#define XB_SPIN_CAP (1u << 18)
__device__ __forceinline__ unsigned xb_ld(unsigned* p)              { return __hip_atomic_load(p, __ATOMIC_RELAXED, __HIP_MEMORY_SCOPE_AGENT); }
__device__ __forceinline__ unsigned xb_add(unsigned* p, unsigned v) { return __hip_atomic_fetch_add(p, v, __ATOMIC_RELAXED, __HIP_MEMORY_SCOPE_AGENT); }
__device__ __forceinline__ unsigned xb_xcc_id() { return (unsigned)__builtin_amdgcn_s_getreg((3 << 11) | 20) & 0xFu; }
#define XB_SPIN(cond, bar) do { unsigned _sp = 0; while (cond) { __builtin_amdgcn_s_sleep(1); \
    if ((++_sp & 255u) == 0u) { if (xb_ld(&(bar)[XB_TMO])) break; if (_sp > XB_SPIN_CAP) { atomicAdd(&(bar)[XB_TMO], 1u); break; } } } } while (0)
struct XcdBarrier { unsigned* bar; unsigned x; volatile LAS unsigned* st; };
__device__ __forceinline__ XcdBarrier xcd_barrier_post(unsigned* bar, volatile LAS unsigned* st) {
    XcdBarrier b; b.bar = bar; b.x = xb_xcc_id(); b.st = st;
    if (threadIdx.x == 0) (void)xb_add(&bar[XB_XCNT(b.x)], 1u);
    return b;
}
__device__ __forceinline__ void xcd_barrier_complete(unsigned* bar, unsigned x, unsigned& nloc, unsigned& nx) {
    const unsigned G = gridDim.x * gridDim.y * gridDim.z;
    unsigned sum, cnt, mine, sp = 0u;
    for (;;) {
        sum = 0u; cnt = 0u; mine = 0u;
#pragma unroll
        for (unsigned j = 0; j < 16; ++j) { const unsigned c = xb_ld(&bar[XB_XCNT(j)]); sum += c; cnt += (c > 0u) ? 1u : 0u; mine = (j == x) ? c : mine; }
        if (sum == G) break;
        __builtin_amdgcn_s_sleep(1);
        if ((++sp & 255u) == 0u) { if (xb_ld(&bar[XB_TMO])) break; if (sp > XB_SPIN_CAP) { atomicAdd(&bar[XB_TMO], 1u); break; } }
    }
    nloc = mine > 0u ? mine : 1u; nx = cnt > 0u ? cnt : 1u;
}
__device__ __forceinline__ void xcd_barrier(const XcdBarrier& b) {
    asm volatile("s_waitcnt vmcnt(0)" ::: "memory");
    __syncthreads();
    if (threadIdx.x == 0) {
        unsigned* bar = b.bar;
        __builtin_amdgcn_s_waitcnt(0);
        unsigned nloc = b.st[0], nx = b.st[1];
        if (nloc == 0u) { xcd_barrier_complete(bar, b.x, nloc, nx); b.st[0] = nloc; b.st[1] = nx; }
        const unsigned old = xb_add(&bar[XB_XSUB(b.x)], 1u);
        const unsigned gen = old / nloc;
        if (old + 1u == (gen + 1u) * nloc) {
            __builtin_amdgcn_fence(__ATOMIC_RELEASE, "agent");
            asm volatile("s_waitcnt vmcnt(0)" ::: "memory");
            const unsigned og = xb_add(&bar[XB_TOP], 1u);
            const unsigned tg = og / nx;
            if (og + 1u == (tg + 1u) * nx) xb_add(&bar[XB_TOPGEN], 1u);
            else XB_SPIN(xb_ld(&bar[XB_TOPGEN]) == tg, bar);
            __builtin_amdgcn_fence(__ATOMIC_ACQUIRE, "agent");
            xb_add(&bar[XB_XGEN(b.x)], 1u);
            asm volatile("s_waitcnt vmcnt(0)" ::: "memory");
        } else {
            XB_SPIN(xb_ld(&bar[XB_XGEN(b.x)]) == gen, bar);
            __builtin_amdgcn_fence(__ATOMIC_ACQUIRE, "agent");
            asm volatile("s_waitcnt vmcnt(0)" ::: "memory");
        }
    }
    __syncthreads();
}

struct Args { const float* in[22]; float* out; unsigned char* ws; int ph_lo, ph_hi; };
enum { I_X = 0, I_C, I_CTX, I_CCTX, I_MODW, I_MODB, I_AWIN, I_QN, I_KN, I_SINK, I_WA2, I_BA, I_GN, I_AWOUT, I_CWIN, I_CW, I_CWOUT, I_RW, I_RB, I_W1, I_W3, I_W2 };

struct Frame {
    LAS unsigned char* lds;
    const float* in[22]; float* out; unsigned char* ws;
    int tid, lane, wave, G, vcu;
};
#define WSP(T, off) ((T*)(F.ws + (off)))

__device__ __forceinline__ int rowmap(int kind, int n) {
    if (kind == 1) { return n < 2048 ? n : (n < 4096 ? 2048 + 256 * ((n - 2048) >> 7) + ((n - 2048) & 127) : 2048 + 256 * ((n - 4096) >> 7) + 128 + ((n - 4096) & 127)); }
    if (kind == 2) return 256 * (n >> 7) + (n & 127);
    if (kind == 3) return 256 * (n >> 7) + 128 + (n & 127);
    return n;
}
__device__ __forceinline__ void transpose_tile(Frame& F, const float* src, int K, int N, bf16* dst, int kind, int tile) {
    LAS float* T = (LAS float*)F.lds;
    const int nkt = K / 64, kt = tile % nkt, ntile = tile / nkt, k0 = kt * 64, n0 = ntile * 256;
#pragma unroll
    for (int p = 0; p < 8; ++p) { const int k = 8 * p + F.wave, n4 = 4 * F.lane;
        f32x4 v = (f32x4){0.f, 0.f, 0.f, 0.f};
        if (n0 + n4 < N) v = *(const f32x4*)(src + (size_t)(k0 + k) * N + n0 + n4);
        LAS float* t = T + k * 257 + n4; t[0] = v[0]; t[1] = v[1]; t[2] = v[2]; t[3] = v[3]; }
    __syncthreads();
#pragma unroll
    for (int q = 0; q < 4; ++q) { const int piece = F.tid + 512 * q, c = piece & 7, n = piece >> 3;
        const LAS float* s = T + (8 * c) * 257 + n;
        u32x4 o; o.x = cvt_pk_bf16(s[0], s[257]); o.y = cvt_pk_bf16(s[2 * 257], s[3 * 257]); o.z = cvt_pk_bf16(s[4 * 257], s[5 * 257]); o.w = cvt_pk_bf16(s[6 * 257], s[7 * 257]);
        const int row = rowmap(kind, n0 + n);
        *(u32x4*)(dst + (size_t)row * K + k0 + 8 * c) = o; }
    __syncthreads();
}
constexpr int CV_B0 = 8192, CV_B1 = 12288, CV_B2 = 20480, CV_B3 = 24576;
struct TileDesc { const float* src; bf16* dst; int K, N, kind, k0, n0; };
__device__ __forceinline__ TileDesc expert_tile(Frame& F, int layer_unused, int g) {
    const int layer = g >= CV_B1 ? 1 : 0, gl = g - layer * CV_B1; TileDesc d; int t;
    if (gl < CV_B0) { const int le = layer * 32 + (gl >> 8), r = gl & 255; t = r & 127;
        if ((r >> 7) == 0) { d.src = F.in[I_W1] + (size_t)le * 2048 * 1024; d.kind = 2; } else { d.src = F.in[I_W3] + (size_t)le * 2048 * 1024; d.kind = 3; }
        d.dst = WSP(bf16, WS_W13_T) + (size_t)le * 2048 * 2048; d.K = 2048; d.N = 1024; }
    else { const int dd = gl - CV_B0, le = layer * 32 + (dd >> 7); t = dd & 127;
        d.src = F.in[I_W2] + (size_t)le * 1024 * 2048; d.dst = WSP(bf16, WS_W2_T) + (size_t)le * 2048 * 1024; d.K = 1024; d.N = 2048; d.kind = 0; }
    const int nnt = d.N / 64; d.n0 = (t % nnt) * 64; d.k0 = (t / nnt) * 256; return d;
}
struct TileSrc { const float* p; bf16* dst; int K, kind, n0; };
__device__ __forceinline__ void convert_tiles6(Frame& F, int layer, int tau0, int tau1) {
    constexpr int TP = 264, TB = 64 * TP * 2;
    const int ng = F.tid & 15, kqb = F.tid >> 4;
    tau0 = __builtin_amdgcn_readfirstlane(tau0);
    f32x4 va[3][2][4], vb[3][2][4]; TileSrc ta[3], tb[3];
#define CV_LOADA(V, T, t0) do { _Pragma("unroll") for (int q = 0; q < 3; ++q) { const TileDesc d = expert_tile(F, layer, (t0) + q); \
        T[q].p = d.src + (size_t)d.k0 * d.N + d.n0 + 4 * ng; T[q].dst = d.dst + d.k0; T[q].K = d.K; T[q].kind = d.kind; T[q].n0 = d.n0; const int N = d.N; \
        _Pragma("unroll") for (int h = 0; h < 2; ++h) _Pragma("unroll") for (int r = 0; r < 4; ++r) { const float* p_ = T[q].p + (size_t)(4 * (kqb + 32 * h) + r) * N; \
            asm volatile("global_load_dwordx4 %0, %1, off nt" : "=v"(V[q][h][r]) : "v"(p_) : "memory"); } } } while (0)
#define CV_PIN(V) do { _Pragma("unroll") for (int q = 0; q < 3; ++q) asm volatile("" : "+v"(V[q][0][0]), "+v"(V[q][0][1]), "+v"(V[q][0][2]), "+v"(V[q][0][3]), "+v"(V[q][1][0]), "+v"(V[q][1][1]), "+v"(V[q][1][2]), "+v"(V[q][1][3])); } while (0)
#define CV_BAR() do { asm volatile("s_waitcnt lgkmcnt(0)" ::: "memory"); __builtin_amdgcn_s_barrier(); asm volatile("" ::: "memory"); } while (0)
#define CV_WRITE(V) do { _Pragma("unroll") for (int q = 0; q < 3; ++q) { LAS bf16* T_ = (LAS bf16*)(F.lds + q * TB); \
        _Pragma("unroll") for (int h = 0; h < 2; ++h) { const int kq = kqb + 32 * h; \
            _Pragma("unroll") for (int i = 0; i < 4; ++i) { const int n = 4 * ng + i; u32x2 w; w.x = cvt_pk_bf16(V[q][h][0][i], V[q][h][1][i]); w.y = cvt_pk_bf16(V[q][h][2][i], V[q][h][3][i]); \
                *(LAS u32x2*)(T_ + n * TP + 8 * ((kq >> 1) ^ ((n >> 4) & 3)) + 4 * (kq & 1)) = w; } } } } while (0)
#define CV_OUT(T) do { _Pragma("unroll") for (int q = 0; q < 3; ++q) { const LAS bf16* T_ = (const LAS bf16*)(F.lds + q * TB); \
        _Pragma("unroll") for (int qq = 0; qq < 4; ++qq) { const int piece = F.tid + 512 * qq, c = piece & 31, n = piece >> 5; \
            const u32x4 o = *(const LAS u32x4*)(T_ + n * TP + 8 * (c ^ ((n >> 4) & 3))); \
            __builtin_nontemporal_store(o, (u32x4*)(T[q].dst + (size_t)rowmap(T[q].kind, T[q].n0 + n) * T[q].K + 8 * c)); } } } while (0)
    CV_LOADA(va, ta, tau0);
    CV_LOADA(vb, tb, tau0 + 3);
    CV_BAR();
    asm volatile("s_waitcnt vmcnt(24)" ::: "memory"); CV_PIN(va);
    CV_WRITE(va);
    CV_BAR();
    CV_OUT(ta);
    CV_BAR();
    asm volatile("s_waitcnt vmcnt(12)" ::: "memory"); CV_PIN(vb);
    CV_WRITE(vb);
    CV_BAR();
    CV_OUT(tb);
    CV_BAR();
#undef CV_LOADA
#undef CV_PIN
#undef CV_BAR
#undef CV_WRITE
#undef CV_OUT
}
__device__ __forceinline__ void convert_claim(Frame& F, int quota, int drain_to) {
    volatile LAS unsigned* W = (volatile LAS unsigned*)(F.lds + LDS_MISC) + 16;
    unsigned* ctr = WSP(unsigned, WS_CTL) + CW_CVT;
    __syncthreads();
    if (F.tid == 0) { bool want = quota > 0;
        if (!want && drain_to > 0) want = (int)__hip_atomic_load(ctr, __ATOMIC_RELAXED, __HIP_MEMORY_SCOPE_AGENT) < drain_to;
        W[0] = want ? atomicAdd(ctr, 6u) : 0x40000000u; }
    __syncthreads();
    int taken = 0;
    for (;;) {
        const int base = (int)W[0];
        if (base >= CV_B3) break;
        taken += 6;
        if (F.tid == 0) W[1] = (taken < quota || base + 6 < drain_to) ? atomicAdd(ctr, 6u) : 0x40000000u;
        convert_tiles6(F, 0, base, base + 6 < CV_B3 ? base + 6 : CV_B3);
        if (F.tid == 0) W[0] = W[1];
        __syncthreads();
    }
}
__device__ __forceinline__ void phase0(Frame& F) {
    {
        LAS float* sc = (LAS float*)F.lds;
        LAS float* red = sc + 5 * 2048;
        const float* c = F.in[I_C]; const float* cc = F.in[I_CCTX];
        for (int i = F.tid; i < 5 * 2048; i += 512) { const int r = i >> 11, k = i & 2047; const float v = r < 4 ? c[r * 2048 + k] : cc[k]; sc[i] = v / (1.0f + expf(-v)); }
        __syncthreads();
        float* MOD = WSP(float, WS_MOD);
        for (int unit = blockIdx.x; unit < 192; unit += F.G) {
            const int l = unit / 96, cg = unit % 96, col = cg * 128 + 2 * F.lane;
            const float* W = F.in[I_MODW] + (size_t)l * 2048 * 12288 + col;
            float acc[5][2];
#pragma unroll
            for (int r = 0; r < 5; ++r) { acc[r][0] = 0.f; acc[r][1] = 0.f; }
            const int kb = F.wave * 256;
#pragma unroll 8
            for (int kk = 0; kk < 256; ++kk) { const int k = kb + kk; const f32x2 w = *(const f32x2*)(W + (size_t)k * 12288);
#pragma unroll
                for (int r = 0; r < 5; ++r) { const float s = sc[r * 2048 + k]; acc[r][0] += s * w.x; acc[r][1] += s * w.y; } }
#pragma unroll
            for (int r = 0; r < 5; ++r) { red[(F.wave * 5 + r) * 128 + 2 * F.lane] = acc[r][0]; red[(F.wave * 5 + r) * 128 + 2 * F.lane + 1] = acc[r][1]; }
            __syncthreads();
            for (int o = F.tid; o < 640; o += 512) { const int r = o >> 7, ccn = o & 127; float s = 0.f;
#pragma unroll
                for (int w = 0; w < 8; ++w) s += red[(w * 5 + r) * 128 + ccn];
                MOD[(size_t)(l * 5 + r) * 12288 + cg * 128 + ccn] = s + F.in[I_MODB][l * 12288 + cg * 128 + ccn]; }
            __syncthreads();
        }
    }
    constexpr int T0 = 32 * 19, T1 = 32 * 8, T2 = 32 * 24, T3 = 32 * 8;
    constexpr int NT = T0 + T1 + T2 + T3;
    volatile LAS unsigned* Wq = (volatile LAS unsigned*)(F.lds + LDS_MISC) + 24; unsigned* head = WSP(unsigned, WS_CTL) + CW_P0;
    for (;;) {
        __syncthreads();
        if (F.tid == 0) Wq[0] = atomicAdd(head, 2u);
        __syncthreads();
        const int base = (int)Wq[0];
        if (base >= NT) break;
#pragma unroll 1
        for (int it = base; it < base + 2 && it < NT; ++it) {
        int r = it;
        if (r < T0) { transpose_tile(F, F.in[I_AWIN], 2048, 4640, WSP(bf16, WS_WIN_T), 0, r); continue; } r -= T0;
        if (r < T1) { transpose_tile(F, F.in[I_AWOUT], 2048, 2048, WSP(bf16, WS_WOUT_T), 0, r); continue; } r -= T1;
        if (r < T2) { transpose_tile(F, F.in[I_CWIN], 2048, 6144, WSP(bf16, WS_CIN_T), 1, r); continue; } r -= T2;
        transpose_tile(F, F.in[I_CWOUT], 2048, 2048, WSP(bf16, WS_COUT_T), 0, r);
        }
    }
}

__device__ __forceinline__ void modulate_store(const f32x4 (&v)[8], const float* shift, const float* scale, bf16* orow, int lane) {
    float ss = 0.f;
#pragma unroll
    for (int j = 0; j < 8; ++j) ss += (v[j][0] * v[j][0] + v[j][1] * v[j][1]) + (v[j][2] * v[j][2] + v[j][3] * v[j][3]);
    const float rstd = 1.0f / sqrtf(wave_sum(ss) * (1.0f / D) + EPS);
#pragma unroll
    for (int j = 0; j < 8; ++j) { const int c = 4 * (64 * j + lane); const f32x4 sh = *(const f32x4*)(shift + c), sc = *(const f32x4*)(scale + c);
        const f32x4 y = v[j] * rstd * (sc + 1.0f) + sh;
        u32x2 w; w.x = cvt_pk_bf16(y[0], y[1]); w.y = cvt_pk_bf16(y[2], y[3]); *(u32x2*)(orow + c) = w; }
}
__device__ __forceinline__ void phase_modulate0(Frame& F) {
    const int gw = blockIdx.x * 8 + F.wave, NGW = F.G * 8; const float* MOD = WSP(float, WS_MOD); bf16* HA = WSP(bf16, WS_HA);
    for (int row = gw; row < TA; row += NGW) {
        const float* src = row < TL ? F.in[I_X] + (size_t)row * D : F.in[I_CTX] + (size_t)(row - TL) * D;
        const int mr = row < TL ? row / SEQ : 4;
        f32x4 v[8];
#pragma unroll
        for (int j = 0; j < 8; ++j) v[j] = *(const f32x4*)(src + 4 * (64 * j + F.lane));
        modulate_store(v, MOD + (size_t)mr * 12288, MOD + (size_t)mr * 12288 + 2048, HA + (size_t)row * D, F.lane);
    }
    { bf16* RH = WSP(bf16, WS_RWT_HI); bf16* RL = WSP(bf16, WS_RWT_LO); const float* rw = F.in[I_RW];
      for (int piece = blockIdx.x * 512 + F.tid; piece < 2 * 4 * 32 * 256; piece += F.G * 512) { const int e = piece & 31, k0 = ((piece >> 5) & 255) * 8, lb = piece >> 13; unsigned hi[4], lo[4];
          const float* sc = MOD + (size_t)((lb >> 2) * 5 + (lb & 3)) * 12288 + 4 * 2048 + k0; const f32x4 s0 = *(const f32x4*)sc + 1.0f, s1 = *(const f32x4*)(sc + 4) + 1.0f;
#pragma unroll
          for (int i = 0; i < 4; ++i) { const float sa = i < 2 ? s0[2 * i] : s1[2 * i - 4], sb = i < 2 ? s0[2 * i + 1] : s1[2 * i - 3];
              const float a = rw[(size_t)(k0 + 2 * i) * 32 + e] * sa, b = rw[(size_t)(k0 + 2 * i + 1) * 32 + e] * sb;
              hi[i] = cvt_pk_bf16(a, b); lo[i] = cvt_pk_bf16(a - __uint_as_float(hi[i] << 16), b - __uint_as_float(hi[i] & 0xffff0000u)); }
          u32x4 h4, l4; h4.x = hi[0]; h4.y = hi[1]; h4.z = hi[2]; h4.w = hi[3]; l4.x = lo[0]; l4.y = lo[1]; l4.z = lo[2]; l4.w = lo[3];
          const size_t fi = ((((size_t)lb * 8 + (k0 >> 8)) * 8 + ((k0 >> 5) & 7)) * 2 + (e >> 4)) * 64 + ((k0 >> 3) & 3) * 16 + (e & 15);
          *(u32x4*)(RH + fi * 8) = h4; *(u32x4*)(RL + fi * 8) = l4; }
      for (int u = blockIdx.x; u < 128; u += F.G) { const int lb = u & 7, seg = u >> 3, e = F.tid & 31, part = F.tid >> 5; LAS float* red = (LAS float*)F.lds;
          const float* sh = MOD + (size_t)((lb >> 2) * 5 + (lb & 3)) * 12288 + 3 * 2048; const int kb = seg * 128 + part * 8; float sum = 0.f;
#pragma unroll
          for (int i = 0; i < 8; ++i) sum += sh[kb + i] * rw[(size_t)(kb + i) * 32 + e];
          __syncthreads(); red[part * 32 + e] = sum; __syncthreads();
          if (F.tid < 32) { float t = 0.f;
#pragma unroll
              for (int p = 0; p < 16; ++p) t += red[p * 32 + F.tid];
              WSP(float, WS_RBIAS)[(lb * 16 + seg) * 32 + F.tid] = t; } } }
}

__device__ __forceinline__ void phase_prep(Frame& F) {
    bf16* PROJ = WSP(bf16, WS_PROJ);
    const int gw = blockIdx.x * 8 + F.wave, NGW = F.G * 8, lane = F.lane;
    const int hs = lane >> 4, sub = lane & 15, fb = 8 * (sub & 3); const bool second = (sub & 4) != 0, axis1 = (sub & 8) != 0;
    float qg[8], kg[8], invf[8];
#pragma unroll
    for (int j = 0; j < 8; ++j) { qg[j] = F.in[I_QN][8 * sub + j]; kg[j] = F.in[I_KN][8 * sub + j]; invf[j] = __expf(-(float)(fb + j) * (9.210340371976184f / 32.0f)); }
    for (int row = gw; row < TA; row += NGW) {
        bf16* pr = PROJ + (size_t)row * NPROJ;
        const bool lat = row < TL;
        float cs[8], sn[8];
        if (lat) { const int t = row % SEQ; const float pos = (float)(axis1 ? (t % 64) : (t / 64));
#pragma unroll
            for (int j = 0; j < 8; ++j) { const float a = pos * invf[j]; cs[j] = __cosf(a); sn[j] = __sinf(a); } }
        else {
#pragma unroll
            for (int j = 0; j < 8; ++j) { cs[j] = 1.f; sn[j] = 0.f; } }
        u32x4 raw[3]; bool act[3];
#pragma unroll
        for (int p = 0; p < 3; ++p) { const int h = 4 * p + hs; act[p] = (h < 10) && (lat || h >= 8);
            raw[p] = (u32x4){0u, 0u, 0u, 0u};
            if (act[p]) raw[p] = *(const u32x4*)(pr + (h < 8 ? C_AQ + h * 128 : C_AK + (h - 8) * 128) + 8 * sub); }
#pragma unroll
        for (int p = 0; p < 3; ++p) { const int h = 4 * p + hs;
            const unsigned ww[4] = {raw[p].x, raw[p].y, raw[p].z, raw[p].w}; float x[8]; float ss = 0.f;
#pragma unroll
            for (int j = 0; j < 8; ++j) { x[j] = (j & 1) ? __uint_as_float(ww[j >> 1] & 0xffff0000u) : __uint_as_float(ww[j >> 1] << 16); ss += x[j] * x[j]; }
            ss += __shfl_xor(ss, 1); ss += __shfl_xor(ss, 2); ss += __shfl_xor(ss, 4); ss += __shfl_xor(ss, 8);
            const float rstd = 1.0f / sqrtf(ss * (1.0f / 128.0f) + EPS);
            float y[8];
#pragma unroll
            for (int j = 0; j < 8; ++j) { const float yv = x[j] * rstd * (p < 2 ? qg[j] : kg[j]); const float pv = __shfl_xor(yv, 4);
                y[j] = second ? yv * cs[j] + pv * sn[j] : yv * cs[j] - pv * sn[j]; }
            u32x4 o; o.x = cvt_pk_bf16(y[0], y[1]); o.y = cvt_pk_bf16(y[2], y[3]); o.z = cvt_pk_bf16(y[4], y[5]); o.w = cvt_pk_bf16(y[6], y[7]);
            if (act[p]) *(u32x4*)(pr + (h < 8 ? C_AQ + h * 128 : C_AK + (h - 8) * 128) + 8 * sub) = o; }
    }
    LAS bf16* T = (LAS bf16*)F.lds;
    bf16* VTL = WSP(bf16, WS_VTL); bf16* VTC = WSP(bf16, WS_VTC);
    for (int u = blockIdx.x; u < 288; u += F.G) {
        const bool isl = u < 256; const int uu = isl ? u : u - 256; const int ntile = isl ? 32 : 4;
        const int b = uu / (2 * ntile), kvh = (uu / ntile) & 1, tt = uu % ntile;
        const int row0 = isl ? b * SEQ + tt * 64 : TL + b * CTXL + tt * 64;
#pragma unroll
        for (int q = 0; q < 2; ++q) { const int j = F.lane, seg = F.wave + 8 * q;
            const u32x4 w = *(const u32x4*)(PROJ + (size_t)(row0 + j) * NPROJ + C_AV + kvh * 128 + seg * 8);
            const unsigned ww[4] = {w.x, w.y, w.z, w.w};
#pragma unroll
            for (int i = 0; i < 8; ++i) T[(seg * 8 + i) * 72 + j] = (bf16)((ww[i >> 1] >> ((i & 1) * 16)) & 0xffffu); }
        __syncthreads();
#pragma unroll
        for (int q = 0; q < 2; ++q) { const int piece = F.tid + 512 * q, d = piece >> 3, seg = piece & 7;
            const u32x4 w = *(const LAS u32x4*)(T + d * 72 + seg * 8);
            bf16* dst = isl ? VTL + ((size_t)(b * 2 + kvh) * 128 + d) * SEQ + tt * 64 + seg * 8 : VTC + ((size_t)(b * 2 + kvh) * 128 + d) * CTXL + tt * 64 + seg * 8;
            *(u32x4*)dst = w; }
        __syncthreads();
    }
}

__device__ __forceinline__ void attn_unit(Frame& F, int unit) {
    const bf16* PROJ = WSP(bf16, WS_PROJ); const bf16* VTL = WSP(bf16, WS_VTL); const bf16* VTC = WSP(bf16, WS_VTC); bf16* MIX = WSP(bf16, WS_MIX);
    const int b = unit >> 6, qb = (unit >> 2) & 15, kvh = (unit >> 1) & 1, gp = unit & 1;
    const int w = F.wave, lane = F.lane, fr = lane & 15, fq = lane >> 4;
    const int hq = kvh * 4 + gp * 2 + (w >> 2), qr0 = qb * 128 + 32 * (w & 3);
    LAS bf16* Ks = (LAS bf16*)F.lds;
    LAS bf16* Vs = Ks + 64 * 136;
    LAS bf16* Ps = Vs + 128 * 72 + w * (32 * 72);
    bf16x8 Q[2][4];
#pragma unroll
    for (int mt = 0; mt < 2; ++mt)
#pragma unroll
        for (int ks = 0; ks < 4; ++ks) Q[mt][ks] = *(const bf16x8*)(PROJ + (size_t)(b * SEQ + qr0 + 16 * mt + fr) * NPROJ + C_AQ + hq * 128 + 32 * ks + 8 * fq);
    const float sinkv = F.in[I_SINK][hq];
    float mrun[2] = {sinkv, sinkv}, lrun[2] = {1.f, 1.f};
    f32x4 o[2][8];
#pragma unroll
    for (int mt = 0; mt < 2; ++mt)
#pragma unroll
        for (int dt = 0; dt < 8; ++dt) o[mt][dt] = (f32x4){0.f, 0.f, 0.f, 0.f};
    const int kt_lo = (2 * qb - 2) < 0 ? 0 : 2 * qb - 2, kt_hi = (2 * qb + 3) > 31 ? 31 : 2 * qb + 3;
    const int ntiles = 4 + (kt_hi - kt_lo + 1);
    u32x4 rk[2], rv[2];
#define ATT_LOAD(ti_) do { const bool isc_ = (ti_) < 4; const int kt_ = isc_ ? (ti_) : kt_lo + ((ti_) - 4); \
        const size_t krow0_ = isc_ ? (size_t)(TL + b * CTXL + kt_ * 64) : (size_t)(b * SEQ + kt_ * 64); \
        const bf16* vt_ = isc_ ? VTC + (size_t)(b * 2 + kvh) * 128 * CTXL + kt_ * 64 : VTL + (size_t)(b * 2 + kvh) * 128 * SEQ + kt_ * 64; const int vld_ = isc_ ? CTXL : SEQ; \
        _Pragma("unroll") for (int q = 0; q < 2; ++q) { const int piece = F.tid + 512 * q; \
            rk[q] = *(const u32x4*)(PROJ + (krow0_ + (piece >> 4)) * NPROJ + C_AK + kvh * 128 + (piece & 15) * 8); \
            rv[q] = *(const u32x4*)(vt_ + (size_t)(piece >> 3) * vld_ + (piece & 7) * 8); } } while (0)
    ATT_LOAD(0);
    for (int ti = 0; ti < ntiles; ++ti) {
        const bool isc = ti < 4; const int kt = isc ? ti : kt_lo + (ti - 4);
        __syncthreads();
#pragma unroll
        for (int q = 0; q < 2; ++q) { const int piece = F.tid + 512 * q;
            *(LAS u32x4*)(Ks + (piece >> 4) * 136 + (piece & 15) * 8) = rk[q];
            *(LAS u32x4*)(Vs + (piece >> 3) * 72 + (piece & 7) * 8) = rv[q]; }
        __syncthreads();
        if (ti + 1 < ntiles) ATT_LOAD(ti + 1);
        f32x4 s[2][4];
#pragma unroll
        for (int mt = 0; mt < 2; ++mt)
#pragma unroll
            for (int nt = 0; nt < 4; ++nt) s[mt][nt] = (f32x4){0.f, 0.f, 0.f, 0.f};
#pragma unroll
        for (int nt = 0; nt < 4; ++nt)
#pragma unroll
            for (int ks = 0; ks < 4; ++ks) { const bf16x8 kf = *(const LAS bf16x8*)(Ks + (16 * nt + fr) * 136 + 32 * ks + 8 * fq);
#pragma unroll
                for (int mt = 0; mt < 2; ++mt) s[mt][nt] = __builtin_amdgcn_mfma_f32_16x16x32_bf16(kf, Q[mt][ks], s[mt][nt], 0, 0, 0); }
#pragma unroll
        for (int mt = 0; mt < 2; ++mt) {
            const int qpos = qr0 + 16 * mt + fr;
            float mx = -3.0e38f;
#pragma unroll
            for (int nt = 0; nt < 4; ++nt)
#pragma unroll
                for (int i = 0; i < 4; ++i) { float v = s[mt][nt][i] * 0.08838834764831845f;
                    if (!isc) { const int kpos = kt * 64 + 16 * nt + 4 * fq + i; const int dd = kpos - qpos; if (dd > 128 || dd < -128) v = -3.0e38f; }
                    s[mt][nt][i] = v; mx = fmaxf(mx, v); }
            mx = fmaxf(mx, __shfl_xor(mx, 16)); mx = fmaxf(mx, __shfl_xor(mx, 32));
            const float mnew = fmaxf(mrun[mt], mx), alpha = __expf(mrun[mt] - mnew);
            float rs = 0.f;
#pragma unroll
            for (int nt = 0; nt < 4; ++nt) { f32x4 p;
#pragma unroll
                for (int i = 0; i < 4; ++i) { const float v = s[mt][nt][i]; p[i] = v < -1.0e37f ? 0.f : __expf(v - mnew); rs += p[i]; }
                u32x2 pw; pw.x = cvt_pk_bf16(p[0], p[1]); pw.y = cvt_pk_bf16(p[2], p[3]);
                *(LAS u32x2*)(Ps + (16 * mt + fr) * 72 + 16 * nt + 4 * fq) = pw; }
            rs += __shfl_xor(rs, 16); rs += __shfl_xor(rs, 32);
            lrun[mt] = lrun[mt] * alpha + rs; mrun[mt] = mnew;
#pragma unroll
            for (int dt = 0; dt < 8; ++dt) o[mt][dt] = o[mt][dt] * alpha;
        }
        asm volatile("s_waitcnt lgkmcnt(0)" ::: "memory");
#pragma unroll
        for (int ks = 0; ks < 2; ++ks) { bf16x8 pf[2];
#pragma unroll
            for (int mt = 0; mt < 2; ++mt) pf[mt] = *(const LAS bf16x8*)(Ps + (16 * mt + fr) * 72 + 32 * ks + 8 * fq);
#pragma unroll
            for (int dt = 0; dt < 8; ++dt) { const bf16x8 vf = *(const LAS bf16x8*)(Vs + (16 * dt + fr) * 72 + 32 * ks + 8 * fq);
#pragma unroll
                for (int mt = 0; mt < 2; ++mt) o[mt][dt] = __builtin_amdgcn_mfma_f32_16x16x32_bf16(vf, pf[mt], o[mt][dt], 0, 0, 0); } }
    }
#pragma unroll
    for (int mt = 0; mt < 2; ++mt) { const float inv = 1.0f / lrun[mt]; bf16* orow = MIX + (size_t)(b * SEQ + qr0 + 16 * mt + fr) * D + hq * 128 + 4 * fq;
#pragma unroll
        for (int dt = 0; dt < 8; ++dt) { const f32x4 v = o[mt][dt] * inv; u32x2 wv; wv.x = cvt_pk_bf16(v[0], v[1]); wv.y = cvt_pk_bf16(v[2], v[3]); *(u32x2*)(orow + 16 * dt) = wv; } }
#undef ATT_LOAD
}

__device__ __forceinline__ int gla_row(int b, int dir, int tp) { return tp < CTXL ? TL + b * CTXL + (dir ? CTXL - 1 - tp : tp) : b * SEQ + (dir ? SEQ - 1 - (tp - CTXL) : tp - CTXL); }
__device__ __forceinline__ void gla_g1_all(Frame& F) {
    const bf16* PROJ = WSP(bf16, WS_PROJ);
    const int tid = F.tid, lane = F.lane, fr = lane & 15, fq = lane >> 4;
    LAS bf16* VTs = (LAS bf16*)F.lds;
    LAS float* LAs = (LAS float*)F.lds;
    LAS float* LRs = (LAS float*)(F.lds + 36864);
    LAS float* WAs = (LAS float*)(F.lds + 40960);
    LAS bf16* QFs = (LAS bf16*)(F.lds + 49152);
    LAS bf16* KFs = (LAS bf16*)(F.lds + 66560);
    LAS bf16* KLTs = (LAS bf16*)(F.lds + 83968);
    u32x4 pv[4], pq[2], pk[2]; unsigned short pl[2]; float pw[4], pba;
#define G1_LOAD(un) do { const int sidx_ = (un) / 36, c_ = (un) % 36, b_ = sidx_ >> 3, h_ = (sidx_ >> 1) & 3, dir_ = sidx_ & 1, tp0_ = c_ * 64; \
        const size_t rowl_ = (size_t)gla_row(b_, dir_, tp0_ + lane) * NPROJ; \
        _Pragma("unroll") for (int q = 0; q < 4; ++q) pv[q] = *(const u32x4*)(PROJ + rowl_ + C_GV + h_ * 256 + (F.wave + 8 * q) * 8); \
        _Pragma("unroll") for (int q = 0; q < 2; ++q) { pq[q] = *(const u32x4*)(PROJ + rowl_ + C_GQ + h_ * 128 + (F.wave + 8 * q) * 8); pk[q] = *(const u32x4*)(PROJ + rowl_ + C_GK + h_ * 128 + (F.wave + 8 * q) * 8); \
            const int i_ = tid + 512 * q; pl[q] = PROJ[(size_t)gla_row(b_, dir_, tp0_ + (i_ >> 4)) * NPROJ + C_LR + dir_ * 16 + (i_ & 15)]; } \
        _Pragma("unroll") for (int q = 0; q < 4; ++q) { const int i_ = tid + 512 * q; pw[q] = F.in[I_WA2][(dir_ * 16 + (i_ >> 7)) * 512 + h_ * 128 + (i_ & 127)]; } \
        pba = F.in[I_BA][dir_ * 512 + h_ * 128 + (tid & 127)]; } while (0)
    if ((int)blockIdx.x < 1152) G1_LOAD(blockIdx.x);
    for (int unit = blockIdx.x; unit < 1152; unit += F.G) {
        const int sidx = unit / 36, c = unit % 36, h = (sidx >> 1) & 3, dir = sidx & 1;
        bf16* QFg = WSP(bf16, WS_QF) + (size_t)unit * 64 * 128; bf16* KLTg = WSP(bf16, WS_KLT) + (size_t)unit * 128 * 64; bf16* ATTg = WSP(bf16, WS_ATT) + (size_t)unit * 64 * 64;
        bf16* VTg = WSP(bf16, WS_VT) + (size_t)unit * 256 * 64; float* DECg = WSP(float, WS_DEC) + (size_t)unit * 128;
#pragma unroll
        for (int q = 0; q < 4; ++q) { const int j = lane, sg = F.wave + 8 * q; const unsigned ww[4] = {pv[q].x, pv[q].y, pv[q].z, pv[q].w};
#pragma unroll
            for (int i = 0; i < 8; ++i) VTs[(sg * 8 + i) * 72 + j] = (bf16)((ww[i >> 1] >> ((i & 1) * 16)) & 0xffffu); }
#pragma unroll
        for (int q = 0; q < 2; ++q) LRs[tid + 512 * q] = bf2f(pl[q]);
#pragma unroll
        for (int q = 0; q < 4; ++q) WAs[tid + 512 * q] = pw[q];
        const float bav = pba;
        __syncthreads();
#pragma unroll
        for (int q = 0; q < 4; ++q) { const int piece = tid + 512 * q, e = piece >> 3, sg = piece & 7;
            *(u32x4*)(VTg + (size_t)e * 64 + sg * 8) = *(const LAS u32x4*)(VTs + e * 72 + sg * 8); }
        __syncthreads();
        { const int d = tid & 127, ig = tid >> 7; float wv[16];
#pragma unroll
          for (int r = 0; r < 16; ++r) wv[r] = WAs[r * 128 + d];
          float run = 0.f;
#pragma unroll 4
          for (int ii = 0; ii < 16; ++ii) { const int i = ig * 16 + ii; float z = bav;
#pragma unroll
              for (int r = 0; r < 16; ++r) z += LRs[i * 16 + r] * wv[r];
              const float ls = (fminf(z, 0.f) - __logf(1.0f + __expf(-fabsf(z)))) * (1.0f / 16.0f);
              run += ls; LAs[i * 132 + d] = run; }
          __syncthreads();
          float off = 0.f;
#pragma unroll
          for (int sgm = 0; sgm < 3; ++sgm) if (sgm < ig) off += LAs[(sgm * 16 + 15) * 132 + d];
          __syncthreads();
          if (ig > 0) {
#pragma unroll 4
              for (int ii = 0; ii < 16; ++ii) LAs[(ig * 16 + ii) * 132 + d] += off; }
          __syncthreads();
        }
#pragma unroll
        for (int q = 0; q < 2; ++q) { const int i = lane, sg = F.wave + 8 * q, d0 = sg * 8;
            const unsigned qa[4] = {pq[q].x, pq[q].y, pq[q].z, pq[q].w}, ka[4] = {pk[q].x, pk[q].y, pk[q].z, pk[q].w};
            float qf[8], kf[8], kl[8];
#pragma unroll
            for (int ii = 0; ii < 8; ++ii) { const float bc = LAs[i * 132 + d0 + ii], bl = LAs[63 * 132 + d0 + ii];
                const float qv = (ii & 1) ? __uint_as_float(qa[ii >> 1] & 0xffff0000u) : __uint_as_float(qa[ii >> 1] << 16);
                const float kv = (ii & 1) ? __uint_as_float(ka[ii >> 1] & 0xffff0000u) : __uint_as_float(ka[ii >> 1] << 16);
                const float e1 = __expf(bc);
                qf[ii] = qv * 0.08838834764831845f * e1; kf[ii] = kv * __builtin_amdgcn_rcpf(e1); kl[ii] = kv * __expf(bl - bc); }
            u32x4 qo, ko; qo.x = cvt_pk_bf16(qf[0], qf[1]); qo.y = cvt_pk_bf16(qf[2], qf[3]); qo.z = cvt_pk_bf16(qf[4], qf[5]); qo.w = cvt_pk_bf16(qf[6], qf[7]);
            ko.x = cvt_pk_bf16(kf[0], kf[1]); ko.y = cvt_pk_bf16(kf[2], kf[3]); ko.z = cvt_pk_bf16(kf[4], kf[5]); ko.w = cvt_pk_bf16(kf[6], kf[7]);
            *(LAS u32x4*)(QFs + i * 136 + d0) = qo; *(LAS u32x4*)(KFs + i * 136 + d0) = ko;
            if (c >= 4) *(u32x4*)(QFg + (size_t)i * 128 + d0) = qo;
#pragma unroll
            for (int ii = 0; ii < 8; ++ii) KLTs[(d0 + ii) * 72 + i] = (bf16)(cvt_pk_bf16(kl[ii], 0.f) & 0xffffu); }
        if (tid < 128) DECg[tid] = __expf(LAs[63 * 132 + tid]);
        if (unit + F.G < 1152) G1_LOAD(unit + F.G);
        __syncthreads();
        if (c >= 4) {
            const int it = F.wave >> 1;
#pragma unroll
            for (int jj = 0; jj < 2; ++jj) { const int jt = 2 * (F.wave & 1) + jj; f32x4 acc = (f32x4){0.f, 0.f, 0.f, 0.f};
#pragma unroll
                for (int ks = 0; ks < 4; ++ks) { const bf16x8 kfr = *(const LAS bf16x8*)(KFs + (16 * jt + fr) * 136 + 32 * ks + 8 * fq), qfr = *(const LAS bf16x8*)(QFs + (16 * it + fr) * 136 + 32 * ks + 8 * fq);
                    acc = __builtin_amdgcn_mfma_f32_16x16x32_bf16(kfr, qfr, acc, 0, 0, 0); }
                const int i = 16 * it + fr, j0 = 16 * jt + 4 * fq;
#pragma unroll
                for (int ii = 0; ii < 4; ++ii) if (j0 + ii > i) acc[ii] = 0.f;
                u32x2 w; w.x = cvt_pk_bf16(acc[0], acc[1]); w.y = cvt_pk_bf16(acc[2], acc[3]);
                *(u32x2*)(ATTg + (size_t)i * 64 + j0) = w; }
        }
#pragma unroll
        for (int q = 0; q < 2; ++q) { const int piece = tid + 512 * q, d = piece >> 3, sg = piece & 7;
            *(u32x4*)(KLTg + (size_t)d * 64 + sg * 8) = *(const LAS u32x4*)(KLTs + d * 72 + sg * 8); }
        __syncthreads();
    }
#undef G1_LOAD
}
__device__ __forceinline__ void gla_g2(Frame& F, int blk) {
    const int sidx = blk >> 2, sl = blk & 3, b = sidx >> 3, h = (sidx >> 1) & 3, dir = sidx & 1, tid = F.tid, lane = F.lane, fr = lane & 15, fq = lane >> 4, w = F.wave;
    bf16* OG = WSP(bf16, WS_OG);
    LAS bf16* QFs = (LAS bf16*)F.lds;
    LAS bf16* ATs = (LAS bf16*)(F.lds + 17408);
    LAS bf16* VTs = (LAS bf16*)(F.lds + 26624);
    LAS bf16* KLTs = (LAS bf16*)(F.lds + 35840);
    LAS float* DECs = (LAS float*)(F.lds + 54272);
    LAS bf16* STs = (LAS bf16*)(F.lds + 54784);
    const int et_s = w >> 1, dt0 = 4 * (w & 1);
    const int it_o = w >> 1, et0 = 2 * (w & 1);
    f32x4 Sacc[4];
#pragma unroll
    for (int i = 0; i < 4; ++i) Sacc[i] = (f32x4){0.f, 0.f, 0.f, 0.f};
    u32x4 rq[2], rk[2], ra, rv; f32x4 rd;
    rq[0] = rq[1] = ra = (u32x4){0u, 0u, 0u, 0u}; rd = (f32x4){0.f, 0.f, 0.f, 0.f};
#define G2_LOAD(cc) do { const size_t un = (size_t)sidx * 36 + (cc); \
        const bf16* kg = WSP(bf16, WS_KLT) + un * 128 * 64; const bf16* vg = WSP(bf16, WS_VT) + un * 256 * 64 + (size_t)sl * 64 * 64; \
        rk[0] = *(const u32x4*)(kg + (size_t)tid * 8); rk[1] = *(const u32x4*)(kg + (size_t)(tid + 512) * 8); rv = *(const u32x4*)(vg + (size_t)tid * 8); \
        if (tid < 32) rd = *(const f32x4*)(WSP(float, WS_DEC) + un * 128 + tid * 4); \
        if ((cc) >= 4) { const bf16* qg = WSP(bf16, WS_QF) + un * 64 * 128; const bf16* ag = WSP(bf16, WS_ATT) + un * 64 * 64; \
            rq[0] = *(const u32x4*)(qg + (size_t)tid * 8); rq[1] = *(const u32x4*)(qg + (size_t)(tid + 512) * 8); ra = *(const u32x4*)(ag + (size_t)tid * 8); } } while (0)
#define G2_STORE() do { \
        { const int d = tid >> 3, sg = tid & 7; *(LAS u32x4*)(KLTs + d * 72 + sg * 8) = rk[0]; *(LAS u32x4*)(KLTs + (d + 64) * 72 + sg * 8) = rk[1]; \
          *(LAS u32x4*)(VTs + d * 72 + sg * 8) = rv; *(LAS u32x4*)(ATs + d * 72 + sg * 8) = ra; } \
        { const int i = tid >> 4, sg = tid & 15; *(LAS u32x4*)(QFs + i * 136 + sg * 8) = rq[0]; *(LAS u32x4*)(QFs + (i + 32) * 136 + sg * 8) = rq[1]; } \
        if (tid < 32) *(LAS f32x4*)(DECs + tid * 4) = rd; } while (0)
    __syncthreads();
    G2_LOAD(0); G2_STORE();
    for (int i = tid; i < 64 * 136 / 2; i += 512) ((LAS unsigned*)STs)[i] = 0u;
    __syncthreads();
    for (int c = 0; c < 36; ++c) {
        if (c + 1 < 36) G2_LOAD(c + 1);
        if (c >= 4) {
#pragma unroll
            for (int ee = 0; ee < 2; ++ee) { const int et = et0 + ee; f32x4 acc = (f32x4){0.f, 0.f, 0.f, 0.f};
#pragma unroll
                for (int ks = 0; ks < 2; ++ks) acc = __builtin_amdgcn_mfma_f32_16x16x32_bf16(*(const LAS bf16x8*)(VTs + (16 * et + fr) * 72 + 32 * ks + 8 * fq), *(const LAS bf16x8*)(ATs + (16 * it_o + fr) * 72 + 32 * ks + 8 * fq), acc, 0, 0, 0);
#pragma unroll
                for (int ks = 0; ks < 4; ++ks) acc = __builtin_amdgcn_mfma_f32_16x16x32_bf16(*(const LAS bf16x8*)(STs + (16 * et + fr) * 136 + 32 * ks + 8 * fq), *(const LAS bf16x8*)(QFs + (16 * it_o + fr) * 136 + 32 * ks + 8 * fq), acc, 0, 0, 0);
                const int tp = c * 64 + 16 * it_o + fr, lrow = b * SEQ + (dir ? SEQ - 1 - (tp - CTXL) : tp - CTXL);
                *(u32x2*)(OG + ((size_t)dir * TL + lrow) * 1024 + h * 256 + sl * 64 + 16 * et + 4 * fq) = (mfma_settle(acc), f32_to_bf4(acc)); }
        }
#pragma unroll
        for (int dd = 0; dd < 4; ++dd) { const int dt = dt0 + dd; const f32x4 dec = *(const LAS f32x4*)(DECs + 16 * dt + 4 * fq);
            f32x4 acc = Sacc[dd] * dec;
#pragma unroll
            for (int ks = 0; ks < 2; ++ks) acc = __builtin_amdgcn_mfma_f32_16x16x32_bf16(*(const LAS bf16x8*)(KLTs + (16 * dt + fr) * 72 + 32 * ks + 8 * fq), *(const LAS bf16x8*)(VTs + (16 * et_s + fr) * 72 + 32 * ks + 8 * fq), acc, 0, 0, 0);
            Sacc[dd] = acc; }
        __syncthreads();
#pragma unroll
        for (int dd = 0; dd < 4; ++dd) { mfma_settle(Sacc[dd]); u32x2 wv; wv.x = cvt_pk_bf16(Sacc[dd][0], Sacc[dd][1]); wv.y = cvt_pk_bf16(Sacc[dd][2], Sacc[dd][3]);
            *(LAS u32x2*)(STs + (16 * et_s + fr) * 136 + 16 * (dt0 + dd) + 4 * fq) = wv; }
        if (c + 1 < 36) G2_STORE();
        __syncthreads();
    }
#undef G2_LOAD
#undef G2_STORE
}

__device__ __forceinline__ void phase_gla_out(Frame& F) {
    const int gw = blockIdx.x * 8 + F.wave, NGW = F.G * 8, lane = F.lane;
    const bf16* OG = WSP(bf16, WS_OG); const bf16* PROJ = WSP(bf16, WS_PROJ); bf16* MIX = WSP(bf16, WS_MIX);
    const f32x4 gn = *(const f32x4*)(F.in[I_GN] + 4 * lane);
    for (int row = gw; row < TL; row += NGW) {
#pragma unroll
        for (int h = 0; h < 4; ++h) {
            const f32x4 of = bf4_to_f32(*(const u32x2*)(OG + (size_t)row * 1024 + h * 256 + 4 * lane)), ob = bf4_to_f32(*(const u32x2*)(OG + ((size_t)TL + row) * 1024 + h * 256 + 4 * lane));
            const f32x4 ov = of + ob;
            const float rstd = 1.0f / sqrtf(wave_sum((ov[0] * ov[0] + ov[1] * ov[1]) + (ov[2] * ov[2] + ov[3] * ov[3])) * (1.0f / 256.0f) + EPS);
            const u32x2 gw2 = *(const u32x2*)(PROJ + (size_t)row * NPROJ + C_GG + h * 256 + 4 * lane);
            const float g0 = __uint_as_float(gw2.x << 16), g1 = __uint_as_float(gw2.x & 0xffff0000u), g2 = __uint_as_float(gw2.y << 16), g3 = __uint_as_float(gw2.y & 0xffff0000u);
            const float y0 = ov[0] * rstd * gn[0] * silu_f(g0), y1 = ov[1] * rstd * gn[1] * silu_f(g1), y2 = ov[2] * rstd * gn[2] * silu_f(g2), y3 = ov[3] * rstd * gn[3] * silu_f(g3);
            u32x2 wv; wv.x = cvt_pk_bf16(y0, y1); wv.y = cvt_pk_bf16(y2, y3);
            *(u32x2*)(MIX + (size_t)row * D + 1024 + h * 256 + 4 * lane) = wv;
        }
    }
}

__device__ __forceinline__ void phase_route(Frame& F, int layer, const bf16* xin) {
    const int lane = F.lane, w = F.wave, fr = lane & 15, fq = lane >> 4;
    const float* MOD = WSP(float, WS_MOD) + (size_t)layer * 5 * 12288; bf16* HA = WSP(bf16, WS_HA);
    unsigned* route = WSP(unsigned, WS_ROUTE) + (size_t)layer * TL * 8; int* list = WSP(int, WS_LIST) + (size_t)layer * 32 * 8192;
    unsigned* cnt = WSP(unsigned, WS_CTL) + CW_CNT + layer * 32 * 64;
    const float* rb = F.in[I_RB];
    LAS unsigned char* XS = F.lds; LAS unsigned char* HI0 = F.lds + LDS_TOK + 4096;
    LAS float* RS = (LAS float*)HI0;
    LAS unsigned* LCNT = (LAS unsigned*)(HI0 + 128); LAS unsigned* LBASE = (LAS unsigned*)(HI0 + 256); LAS float* RBL = (LAS float*)(HI0 + 384);
    LAS float* LOG = (LAS float*)(HI0 + 512);
    LAS float* PART = (LAS float*)F.lds;
    for (int it = 0; it * F.G * 32 < TL; ++it) {
        const int row0b = (it * F.G + (int)blockIdx.x) * 32;
        if (row0b >= TL) break;
        const int b = row0b / SEQ; const float* shift = MOD + (size_t)b * 12288 + 3 * 2048; const float* scale = MOD + (size_t)b * 12288 + 4 * 2048;
        const bf16* RH = WSP(bf16, WS_RWT_HI) + ((size_t)((layer * 4 + b) * 8 + w) * 1024 + lane) * 8; const bf16* RL = WSP(bf16, WS_RWT_LO) + ((size_t)((layer * 4 + b) * 8 + w) * 1024 + lane) * 8;
        __syncthreads();
        if (F.tid < 32) { LCNT[F.tid] = 0u; const float* bp = WSP(float, WS_RBIAS) + (size_t)(layer * 4 + b) * 16 * 32 + F.tid; float t = 0.f;
#pragma unroll
            for (int p = 0; p < 16; ++p) t += bp[p * 32];
            RBL[F.tid] = t; }
        bf16x8 bh[8][2], bl[8][2];
        { u32x4 v[4][4];
#pragma unroll
          for (int k = 0; k < 4; ++k)
#pragma unroll
              for (int j = 0; j < 4; ++j) v[k][j] = *(const u32x4*)(xin + (size_t)(row0b + 4 * w + k) * D + 8 * (64 * j + lane));
#pragma unroll
          for (int ks = 0; ks < 4; ++ks)
#pragma unroll
              for (int nt = 0; nt < 2; ++nt) { bh[ks][nt] = *(const bf16x8*)(RH + (size_t)(ks * 2 + nt) * 512); bl[ks][nt] = *(const bf16x8*)(RL + (size_t)(ks * 2 + nt) * 512); }
#pragma unroll
          for (int k = 0; k < 4; ++k)
#pragma unroll
              for (int j = 0; j < 4; ++j) { const int rr = 4 * w + k; *(LAS u32x4*)(XS + rr * 4096 + 16 * ((64 * j + lane) ^ (rr & 15))) = v[k][j]; }
#pragma unroll
          for (int k = 0; k < 4; ++k) { float ss = 0.f; f32x4 xa[4][2];
#pragma unroll
              for (int j = 0; j < 4; ++j) { u32x2 lo2, hi2; lo2.x = v[k][j].x; lo2.y = v[k][j].y; hi2.x = v[k][j].z; hi2.y = v[k][j].w; xa[j][0] = bf4_to_f32(lo2); xa[j][1] = bf4_to_f32(hi2);
#pragma unroll
                  for (int q = 0; q < 2; ++q) ss += (xa[j][q][0] * xa[j][q][0] + xa[j][q][1] * xa[j][q][1]) + (xa[j][q][2] * xa[j][q][2] + xa[j][q][3] * xa[j][q][3]); }
              const float rsk = 1.0f / sqrtf(wave_sum(ss) * (1.0f / D) + EPS);
              if (lane == 0) RS[4 * w + k] = rsk;
#pragma unroll
              for (int j = 0; j < 4; ++j) { const int c = 8 * (64 * j + lane); u32x4 o;
#pragma unroll
                  for (int q = 0; q < 2; ++q) { const f32x4 sh = *(const f32x4*)(shift + c + 4 * q), sc = *(const f32x4*)(scale + c + 4 * q);
                      const f32x4 y = xa[j][q] * rsk * (sc + 1.0f) + sh; const u32x2 p = f32_to_bf4(y); if (q == 0) { o.x = p.x; o.y = p.y; } else { o.z = p.x; o.w = p.y; } }
                  *(u32x4*)(HA + (size_t)(row0b + 4 * w + k) * D + c) = o; } } }
#pragma unroll
        for (int ks = 4; ks < 8; ++ks)
#pragma unroll
            for (int nt = 0; nt < 2; ++nt) { bh[ks][nt] = *(const bf16x8*)(RH + (size_t)(ks * 2 + nt) * 512); bl[ks][nt] = *(const bf16x8*)(RL + (size_t)(ks * 2 + nt) * 512); }
        asm volatile("s_waitcnt lgkmcnt(0)" ::: "memory"); __builtin_amdgcn_s_barrier(); asm volatile("" ::: "memory");
        { f32x4 acc[2][2];
#pragma unroll
          for (int mt = 0; mt < 2; ++mt)
#pragma unroll
              for (int nt = 0; nt < 2; ++nt) acc[mt][nt] = (f32x4){0.f, 0.f, 0.f, 0.f};
#pragma unroll
          for (int ks = 0; ks < 8; ++ks) {
              bf16x8 ax[2];
#pragma unroll
              for (int mt = 0; mt < 2; ++mt) ax[mt] = *(const LAS bf16x8*)(XS + (16 * mt + fr) * 4096 + 16 * ((32 * w + 4 * ks + fq) ^ fr));
#pragma unroll
              for (int nt = 0; nt < 2; ++nt)
#pragma unroll
                  for (int mt = 0; mt < 2; ++mt) { acc[mt][nt] = __builtin_amdgcn_mfma_f32_16x16x32_bf16(bh[ks][nt], ax[mt], acc[mt][nt], 0, 0, 0);
                      acc[mt][nt] = __builtin_amdgcn_mfma_f32_16x16x32_bf16(bl[ks][nt], ax[mt], acc[mt][nt], 0, 0, 0); } }
          asm volatile("s_waitcnt lgkmcnt(0)" ::: "memory"); __builtin_amdgcn_s_barrier(); asm volatile("" ::: "memory");
#pragma unroll
          for (int mt = 0; mt < 2; ++mt)
#pragma unroll
              for (int nt = 0; nt < 2; ++nt) *(LAS f32x4*)(PART + (w * 32 + 16 * mt + fr) * 32 + 16 * nt + 4 * fq) = acc[mt][nt]; }
        __syncthreads();
#pragma unroll
        for (int q = 0; q < 2; ++q) { const int o = F.tid + 512 * q; float sum = 0.f;
#pragma unroll
            for (int ww = 0; ww < 8; ++ww) sum += PART[ww * 1024 + o];
            LOG[o] = RS[o >> 5] * sum + RBL[o & 31]; }
        __syncthreads();
        int i1s[4], i2s[4]; float a1s[4], a2s[4];
#pragma unroll
        for (int k = 0; k < 4; ++k) {
            const float mylg = LOG[(4 * w + k) * 32 + (lane & 31)];
            const float myscore = 1.0f / (1.0f + expf(-mylg)), mybias = myscore + rb[lane & 31];
            float m1 = -3.0e38f, m2 = -3.0e38f, w1 = 0.f, w2 = 0.f; int i1 = 0, i2 = 0;
            const int gbase = lane & 24;
#pragma unroll
            for (int i = 0; i < 8; ++i) { const float x = __shfl(mybias, gbase + i), sx = __shfl(myscore, gbase + i);
                if (x > m1) { m2 = m1; i2 = i1; w2 = w1; m1 = x; i1 = i; w1 = sx; } else if (x > m2) { m2 = x; i2 = i; w2 = sx; } }
            const float gs = m1 + m2;
            int gsel = 0; float gbest = __shfl(gs, 0);
#pragma unroll
            for (int g = 1; g < 4; ++g) { const float x = __shfl(gs, 8 * g); if (x > gbest) { gbest = x; gsel = g; } }
            i1 = __shfl(i1, 8 * gsel) + 8 * gsel; i2 = __shfl(i2, 8 * gsel) + 8 * gsel; w1 = __shfl(w1, 8 * gsel); w2 = __shfl(w2, 8 * gsel);
            const float wsum = w1 + w2; i1s[k] = i1; i2s[k] = i2; a1s[k] = w1 / wsum; a2s[k] = w2 / wsum;
        }
        { const int tk = (lane >> 1) & 3, ch = lane & 1;
          int e1 = i1s[0], e2 = i2s[0]; float q1 = a1s[0], q2 = a2s[0];
#pragma unroll
          for (int k = 1; k < 4; ++k) { e1 = (tk == k) ? i1s[k] : e1; e2 = (tk == k) ? i2s[k] : e2; q1 = (tk == k) ? a1s[k] : q1; q2 = (tk == k) ? a2s[k] : q2; }
          const int e = ch ? e2 : e1; const int row = row0b + 4 * w + tk;
          unsigned pos = 0u;
          if (lane < 8) pos = __hip_atomic_fetch_add(LCNT + e, 1u, __ATOMIC_RELAXED, __HIP_MEMORY_SCOPE_WORKGROUP);
          __syncthreads();
          if (F.tid < 32) { const unsigned n = LCNT[F.tid]; LBASE[F.tid] = n ? atomicAdd(cnt + F.tid * 64, n) : 0u; }
          __syncthreads();
          if (lane < 8) { pos += LBASE[e]; list[e * 8192 + pos] = row; }
          const unsigned pa = __shfl(pos, lane & ~1), pb2 = __shfl(pos, lane | 1);
          if (lane < 8 && ch == 0) { u32x4 r0; r0.x = (unsigned)e1; r0.y = (unsigned)e2; r0.z = pa; r0.w = pb2; *(u32x4*)(route + (size_t)row * 8) = r0;
              u32x2 r1; r1.x = __float_as_uint(q1); r1.y = __float_as_uint(q2); *(u32x2*)(route + (size_t)row * 8 + 4) = r1; } }
    }
}
__device__ __forceinline__ void moe_setup(Frame& F, int layer, bool want_tok, int nN) {
    LAS int* pb = (LAS int*)(F.lds + LDS_PB); LAS int* tokt = (LAS int*)(F.lds + LDS_TOK);
    const unsigned* cnt = WSP(unsigned, WS_CTL) + CW_CNT + layer * 32 * 64; const int* list = WSP(int, WS_LIST) + (size_t)layer * 32 * 8192;
    if (F.tid == 0) { int s = 0; for (int e = 0; e < 32; ++e) { pb[e] = s; s += ((int)cnt[e * 64] + 255) >> 8; } pb[32] = s; }
    __syncthreads();
    if (want_tok) {
        pg8::MoeOrder<true> S; S.pb = pb; S.tokt = tokt; S.G = F.G; S.c = F.vcu; S.nN = nN; S.estride = 0;
        for (int i = 0; i < 4; ++i) { pg8::Unit u; if (!S.next(i, u)) break;
            if (F.tid < 256) { const int pos = (u.pm - pb[u.e]) * 256 + F.tid; const int n = (int)cnt[u.e * 64]; tokt[i * 256 + F.tid] = pos < n ? list[u.e * 8192 + pos] : 0; } }
        __syncthreads();
    }
}
struct CombRow { u32x2 ya[8], yb[8], xi[8]; float w0, w1; };
struct CombRoute { u32x4 r0; u32x2 r1; };
__device__ __forceinline__ CombRoute comb_route(const unsigned* route, int row) { CombRoute r; r.r0 = *(const u32x4*)(route + (size_t)row * 8); r.r1 = *(const u32x2*)(route + (size_t)row * 8 + 4); return r; }
__device__ __forceinline__ void comb_issue(CombRow& R, const CombRoute& rt, const LAS int* pb, const bf16* Y, const bf16* xin, int row, int lane) {
    const size_t s0 = (size_t)pb[rt.r0.x] * 256 + rt.r0.z, s1 = (size_t)pb[rt.r0.y] * 256 + rt.r0.w; R.w0 = __uint_as_float(rt.r1.x); R.w1 = __uint_as_float(rt.r1.y);
#pragma unroll
    for (int j = 0; j < 8; ++j) { const int c = 4 * (64 * j + lane);
        R.ya[j] = *(const u32x2*)(Y + s0 * D + c); R.yb[j] = *(const u32x2*)(Y + s1 * D + c); R.xi[j] = *(const u32x2*)(xin + (size_t)row * D + c); }
}
template <class TO> __device__ __forceinline__ void comb_finish(const CombRow& R, const float* gate, TO* xout, bool next_mod, const float* modn, bf16* HA, int row, int lane) {
    f32x4 v[8]; const float w0 = R.w0, w1 = R.w1;
#pragma unroll
    for (int j = 0; j < 8; ++j) { const int c = 4 * (64 * j + lane); const u32x2 ya = R.ya[j], yb = R.yb[j];
        f32x4 y; y[0] = w0 * __uint_as_float(ya.x << 16) + w1 * __uint_as_float(yb.x << 16); y[1] = w0 * __uint_as_float(ya.x & 0xffff0000u) + w1 * __uint_as_float(yb.x & 0xffff0000u);
        y[2] = w0 * __uint_as_float(ya.y << 16) + w1 * __uint_as_float(yb.y << 16); y[3] = w0 * __uint_as_float(ya.y & 0xffff0000u) + w1 * __uint_as_float(yb.y & 0xffff0000u);
        const f32x4 xi = bf4_to_f32(R.xi[j]), g = *(const f32x4*)(gate + c);
        v[j] = xi + g * y;
        if constexpr (sizeof(TO) == 4) *(f32x4*)((float*)xout + (size_t)row * D + c) = v[j]; else *(u32x2*)((bf16*)xout + (size_t)row * D + c) = f32_to_bf4(v[j]); }
    if (next_mod) modulate_store(v, modn, modn + 2048, HA + (size_t)row * D, lane);
}
template <class TO> __device__ __forceinline__ void phase_combine(Frame& F, int layer, const bf16* xin, TO* xout, bool next_mod) {
    const int gw = blockIdx.x * 8 + F.wave, NGW = F.G * 8, lane = F.lane;
    const float* MOD = WSP(float, WS_MOD) + (size_t)layer * 5 * 12288; const float* MODN = WSP(float, WS_MOD) + (size_t)(layer + 1) * 5 * 12288;
    const unsigned* route = WSP(unsigned, WS_ROUTE) + (size_t)layer * TL * 8; const bf16* Y = WSP(bf16, WS_Y); bf16* HA = WSP(bf16, WS_HA);
    const LAS int* pb = (const LAS int*)(F.lds + LDS_PB);
    if (gw >= TL) return;
    CombRoute ra = comb_route(route, gw), rb = comb_route(route, min(gw + NGW, TL - 1));
    for (int row = gw; row < TL; row += 2 * NGW) {
        const int rowA = row, rowB = row + NGW; const bool hasB = rowB < TL; const int rB = hasB ? rowB : rowA;
        CombRow A, B;
        comb_issue(A, ra, pb, Y, xin, rowA, lane);
        comb_issue(B, hasB ? rb : ra, pb, Y, xin, rB, lane);
        ra = comb_route(route, min(row + 2 * NGW, TL - 1)); rb = comb_route(route, min(row + 3 * NGW, TL - 1));
        const int bA = rowA / SEQ, bB = rB / SEQ;
        comb_finish<TO>(A, MOD + (size_t)bA * 12288 + 5 * 2048, xout, next_mod, MODN + (size_t)bA * 12288, HA, rowA, lane);
        if (hasB) comb_finish<TO>(B, MOD + (size_t)bB * 12288 + 5 * 2048, xout, next_mod, MODN + (size_t)bB * 12288, HA, rowB, lane);
    }
}
__device__ __forceinline__ void phase_conv(Frame& F) {
    const bf16* GB = WSP(bf16, WS_GB); const bf16* P = WSP(bf16, WS_PGU); bf16* Z = WSP(bf16, WS_Z); const float* cw = F.in[I_CW];
    const size_t total = (size_t)TL * D / 8;
    for (size_t i = (size_t)blockIdx.x * 512 + F.tid; i < total; i += (size_t)F.G * 512) {
        const int row = (int)(i >> 8), c = (int)(i & 255) * 8, t = row % SEQ;
        const u32x4 pc = *(const u32x4*)(P + (size_t)row * D + c), gb = *(const u32x4*)(GB + (size_t)row * D + c);
        u32x4 pm = (u32x4){0u, 0u, 0u, 0u}, pp = (u32x4){0u, 0u, 0u, 0u};
        if (t > 0) pm = *(const u32x4*)(P + (size_t)(row - 1) * D + c);
        if (t < SEQ - 1) pp = *(const u32x4*)(P + (size_t)(row + 1) * D + c);
        const unsigned am[4] = {pm.x, pm.y, pm.z, pm.w}, ac[4] = {pc.x, pc.y, pc.z, pc.w}, ap[4] = {pp.x, pp.y, pp.z, pp.w}, ag[4] = {gb.x, gb.y, gb.z, gb.w};
        unsigned ow[4];
#pragma unroll
        for (int q = 0; q < 4; ++q) { float r[2];
#pragma unroll
            for (int hh = 0; hh < 2; ++hh) { const int cc = c + 2 * q + hh;
                const float vm = hh ? __uint_as_float(am[q] & 0xffff0000u) : __uint_as_float(am[q] << 16), vc = hh ? __uint_as_float(ac[q] & 0xffff0000u) : __uint_as_float(ac[q] << 16);
                const float vp = hh ? __uint_as_float(ap[q] & 0xffff0000u) : __uint_as_float(ap[q] << 16), vg = hh ? __uint_as_float(ag[q] & 0xffff0000u) : __uint_as_float(ag[q] << 16);
                r[hh] = vg * (cw[cc] * vm + cw[2048 + cc] * vc + cw[4096 + cc] * vp); }
            ow[q] = cvt_pk_bf16(r[0], r[1]); }
        u32x4 o; o.x = ow[0]; o.y = ow[1]; o.z = ow[2]; o.w = ow[3];
        *(u32x4*)(Z + (size_t)row * D + c) = o;
    }
}

constexpr int NPHASE = 18;
__global__ void __launch_bounds__(512, 2) fwd_kernel(Args args) {
    extern __shared__ __attribute__((aligned(16))) unsigned char lds_raw[];
    Frame F;
    F.lds = (LAS unsigned char*)lds_raw; F.out = args.out; F.ws = args.ws;
#pragma unroll
    for (int i = 0; i < 22; ++i) F.in[i] = args.in[i];
    F.tid = threadIdx.x; F.lane = F.tid & 63; F.wave = __builtin_amdgcn_readfirstlane(F.tid >> 6); F.G = gridDim.x;
    { const int bx = blockIdx.x; F.vcu = (F.G % 8 == 0) ? (bx % 8) * (F.G / 8) + bx / 8 : bx; }
    volatile LAS unsigned* MISC = (volatile LAS unsigned*)(F.lds + LDS_MISC);
    if (F.tid < 64) MISC[F.tid] = 0u;
    __syncthreads();
    const int lo = args.ph_lo, hi = args.ph_hi;
    XcdBarrier bar; bar.bar = WSP(unsigned, WS_CTL) + CW_BAR; bar.x = 0; bar.st = nullptr;
    if (hi - lo > 1) bar = xcd_barrier_post(WSP(unsigned, WS_CTL) + CW_BAR, MISC + 8);
#ifndef PH_MASK
#define PH_MASK 0xFFFFFFFFu
#endif
#define IN(k) (((PH_MASK >> (k)) & 1u) && lo <= (k) && (k) < hi)
#define SEAM(k) do { if (IN(k) && IN((k) + 1)) xcd_barrier(bar); } while (0)
    const float* MOD = WSP(float, WS_MOD);

    if (IN(0)) { phase0(F); } SEAM(0);
    if (IN(1)) { phase_modulate0(F); } SEAM(1);
    if (IN(2)) {
        pg8::Gemm g{WSP(bf16, WS_HA), WSP(bf16, WS_WIN_T), D}; pg8::StaticOrder S; S.init(TA, NPROJ, F.G, (int)blockIdx.x);
        pg8::EpiBf16 E{WSP(bf16, WS_PROJ), NPROJ};
        const int grp = F.vcu & 3;
        pg8::StaticOrder Sa; Sa.init(TA, NPROJ, F.G, (int)blockIdx.x); Sa.ilo = 0; Sa.ihi = grp;
        pg8::StaticOrder Sb; Sb.init(TA, NPROJ, F.G, (int)blockIdx.x); Sb.ilo = grp; Sb.ihi = 1 << 30;
        pg8::gemm_phase<pg8::EpiBf16, pg8::StaticOrder, true>(F.lds, g, Sa, E);
        convert_claim(F, 30, 0);
        pg8::gemm_phase<pg8::EpiBf16, pg8::StaticOrder, true>(F.lds, g, Sb, E);
        if (2L * F.G + (long)blockIdx.x >= (long)(TA / 256) * (NPROJ / 256)) convert_claim(F, 18, 0);
    } SEAM(2);
    if (IN(3)) { phase_prep(F); gla_g1_all(F); } SEAM(3);
    if (IN(4)) {
        if (blockIdx.x < 128) { gla_g2(F, blockIdx.x); convert_claim(F, 6, 0); }
        else { const int st = F.G > 129 ? F.G - 128 : 1; for (int u = blockIdx.x - 128; u < 256; u += st) attn_unit(F, u); }
    } SEAM(4);
    if (IN(5)) { phase_gla_out(F); } SEAM(5);
    if (IN(6)) {
        pg8::Gemm g{WSP(bf16, WS_MIX), WSP(bf16, WS_WOUT_T), D}; pg8::StaticOrder S; S.init(TL, D, F.G, (int)blockIdx.x);
        pg8::EpiResGate<false> E{F.in[I_X], WSP(bf16, WS_X1), MOD + 2 * 2048, 12288};
        if ((F.vcu & 1) == 0) convert_claim(F, 12, 0);
        pg8::gemm_phase<pg8::EpiResGate<false>, pg8::StaticOrder, false>(F.lds, g, S, E);
        convert_claim(F, 0, CV_B0);
    } SEAM(6);
#define MOE_PHASES(layer, pbase, xin, xout, nextmod) \
    if (IN(pbase)) { phase_route(F, layer, xin); } SEAM(pbase); \
    if (IN((pbase) + 1)) { \
        moe_setup(F, layer, true, 8); \
        pg8::Gemm g{WSP(bf16, WS_HA), WSP(bf16, WS_W13_T) + (size_t)(layer) * 32 * 2048 * 2048, D}; \
        pg8::MoeOrder<true> S; S.pb = (const LAS int*)(F.lds + LDS_PB); S.tokt = (const LAS int*)(F.lds + LDS_TOK); S.G = F.G; S.c = F.vcu; S.nN = 8; S.estride = (size_t)2048 * 2048 * 2; \
        pg8::EpiPair<true> E{WSP(bf16, WS_HMID), DEXP, 0, nullptr, 0}; \
        pg8::gemm_phase<pg8::EpiPair<true>, pg8::MoeOrder<true>, true>(F.lds, g, S, E); \
        { const int tot = S.pb[32] * 8, mx = (tot + F.G - 1) / F.G, mine = tot > F.vcu ? (tot - F.vcu + F.G - 1) / F.G : 0; convert_claim(F, mine < mx ? 12 : 0, (layer) == 0 ? CV_B1 : CV_B3); } \
    } SEAM((pbase) + 1); \
    if (IN((pbase) + 2)) { \
        moe_setup(F, layer, false, 8); \
        pg8::Gemm g{WSP(bf16, WS_HMID), WSP(bf16, WS_W2_T) + (size_t)(layer) * 32 * 2048 * 1024, DEXP}; \
        pg8::MoeOrder<false> S; S.pb = (const LAS int*)(F.lds + LDS_PB); S.tokt = nullptr; S.G = F.G; S.c = F.vcu; S.nN = 8; S.estride = (size_t)2048 * 1024 * 2; \
        pg8::EpiBf16 E{WSP(bf16, WS_Y), D}; \
        pg8::gemm_phase<pg8::EpiBf16, pg8::MoeOrder<false>, true>(F.lds, g, S, E); \
        if ((layer) == 0) { const int tot = S.pb[32] * 8, mx = (tot + F.G - 1) / F.G, mine = tot > F.vcu ? (tot - F.vcu + F.G - 1) / F.G : 0; if (mine < mx) convert_claim(F, 6, 0); } \
    } SEAM((pbase) + 2); \
    if (IN((pbase) + 3)) { moe_setup(F, layer, false, 8); phase_combine(F, layer, xin, xout, nextmod); }

    MOE_PHASES(0, 7, WSP(bf16, WS_X1), WSP(bf16, WS_X2), true)
    SEAM(10);
    if (IN(11)) {
        pg8::Gemm g{WSP(bf16, WS_HA), WSP(bf16, WS_CIN_T), D}; pg8::StaticOrder S; S.init(TL, 6144, F.G, (int)blockIdx.x);
        pg8::EpiPair<false> E{WSP(bf16, WS_PGU), D, 8, WSP(bf16, WS_GB), D};
        const int grp = F.vcu & 3;
        pg8::StaticOrder Sa; Sa.init(TL, 6144, F.G, (int)blockIdx.x); Sa.ilo = 0; Sa.ihi = grp;
        pg8::StaticOrder Sb; Sb.init(TL, 6144, F.G, (int)blockIdx.x); Sb.ilo = grp; Sb.ihi = 1 << 30;
        pg8::gemm_phase<pg8::EpiPair<false>, pg8::StaticOrder, true>(F.lds, g, Sa, E);
        convert_claim(F, 30, 0);
        pg8::gemm_phase<pg8::EpiPair<false>, pg8::StaticOrder, true>(F.lds, g, Sb, E);
    } SEAM(11);
    if (IN(12)) { phase_conv(F); } SEAM(12);
    if (IN(13)) {
        pg8::Gemm g{WSP(bf16, WS_Z), WSP(bf16, WS_COUT_T), D}; pg8::StaticOrder S; S.init(TL, D, F.G, (int)blockIdx.x);
        pg8::EpiResGate<true> E{WSP(bf16, WS_X2), WSP(bf16, WS_X3), MOD + 5 * 12288 + 2 * 2048, 12288};
        if ((F.vcu & 1) == 0) convert_claim(F, 12, 0);
        pg8::gemm_phase<pg8::EpiResGate<true>, pg8::StaticOrder, false>(F.lds, g, S, E);
        convert_claim(F, 0, CV_B2);
    } SEAM(13);
    MOE_PHASES(1, 14, WSP(bf16, WS_X3), F.out, false)
#undef MOE_PHASES
#undef IN
#undef SEAM
}

extern "C" void kernel_launch(void* const* d_in, const int* in_sizes, int n_in, void* d_out, int out_size, void* d_ws, size_t ws_size, hipStream_t stream) {
    static int grid = 0;
    if (grid == 0) {
        if (n_in != 22 || out_size != TL * D || ws_size < WS_END) { fprintf(stderr, "kernel_launch: unexpected problem (n_in %d, out %d, ws %zu < %zu)\n", n_in, out_size, ws_size, (size_t)WS_END); grid = -1; return; }
        int dev = 0, cus = 0, per_cu = 0;
        if (hipGetDevice(&dev) != hipSuccess || hipDeviceGetAttribute(&cus, hipDeviceAttributeMultiprocessorCount, dev) != hipSuccess) { grid = -1; return; }
        if (hipFuncSetAttribute((const void*)fwd_kernel, hipFuncAttributeMaxDynamicSharedMemorySize, LDS_BYTES) != hipSuccess) { fprintf(stderr, "kernel_launch: hipFuncSetAttribute failed\n"); grid = -1; return; }
        if (hipOccupancyMaxActiveBlocksPerMultiprocessor(&per_cu, (const void*)fwd_kernel, 512, LDS_BYTES) != hipSuccess || per_cu < 1) { fprintf(stderr, "kernel_launch: occupancy query says %d\n", per_cu); }
        (void)hipGetLastError();
        grid = cus;
    }
    if (grid < 0) return;
    (void)hipMemsetAsync((char*)d_ws + WS_CTL, 0, CTL_ZERO_BYTES, stream);
    Args a{};
    for (int i = 0; i < 22; ++i) a.in[i] = (const float*)d_in[i];
    a.out = (float*)d_out; a.ws = (unsigned char*)d_ws;
#if MK_N_LAUNCHES == 1
    a.ph_lo = 0; a.ph_hi = NPHASE;
    hipLaunchKernelGGL(fwd_kernel, dim3(grid), dim3(512), LDS_BYTES, stream, a);
#else
    for (int p = 0; p < NPHASE; ++p) { a.ph_lo = p; a.ph_hi = p + 1; hipLaunchKernelGGL(fwd_kernel, dim3(grid), dim3(512), LDS_BYTES, stream, a); }
#endif
}
```

```cpp
#include <hip/hip_runtime.h>
#include <cstdio>
#include <cstdint>

#ifndef MK_N_LAUNCHES
#define MK_N_LAUNCHES 1
#endif

#define GAS __attribute__((address_space(1)))
#define LAS __attribute__((address_space(3)))
typedef unsigned short bf16;
typedef short bf16x8 __attribute__((ext_vector_type(8)));
typedef float f32x4 __attribute__((ext_vector_type(4)));
typedef float f32x2 __attribute__((ext_vector_type(2)));
typedef unsigned u32x4 __attribute__((ext_vector_type(4)));
typedef unsigned u32x2 __attribute__((ext_vector_type(2)));

constexpr int D = 2048, BATCH = 4, SEQ = 2048, CTXL = 256;
constexpr int TL = BATCH * SEQ;
constexpr int TC = BATCH * CTXL;
constexpr int TA = TL + TC;
constexpr int NPROJ = 4864;
constexpr int C_AQ = 0, C_AK = 1024, C_AV = 1280, C_GQ = 1536, C_GK = 2048, C_GV = 2560, C_GG = 3584, C_LR = 4608;
constexpr int NEXP = 32, DEXP = 1024;
constexpr float EPS = 1e-6f;

constexpr size_t MiB = 1u << 20;
constexpr size_t WS_CTL = 0, CTL_ZERO_BYTES = 128 * 1024;
constexpr size_t WS_MOD = 1 * MiB;
constexpr size_t WS_ROUTE = 2 * MiB;
constexpr size_t WS_LIST = 3 * MiB;
constexpr size_t WS_RWT_HI = 6 * MiB;
constexpr size_t WS_RWT_LO = 7 * MiB;
constexpr size_t WS_RBIAS = 1 * MiB + 512 * 1024;
constexpr size_t WS_WIN_T = 8 * MiB;
constexpr size_t WS_WOUT_T = 28 * MiB;
constexpr size_t WS_CIN_T = 36 * MiB;
constexpr size_t WS_COUT_T = 60 * MiB;
constexpr size_t WS_W13_T = 68 * MiB;
constexpr size_t WS_W2_T = 580 * MiB;
constexpr size_t WS_HA = 836 * MiB;
constexpr size_t WS_PROJ = 872 * MiB;
constexpr size_t WS_LA = 958 * MiB;
constexpr size_t WS_VTL = 994 * MiB;
constexpr size_t WS_VTC = 998 * MiB;
constexpr size_t WS_OG = 1000 * MiB;
constexpr size_t WS_MIX = 1064 * MiB;
constexpr size_t WS_X1 = 1096 * MiB;
constexpr size_t WS_HMID = 1160 * MiB;
constexpr size_t WS_Y = 1208 * MiB;
constexpr size_t WS_X2 = 1304 * MiB;
constexpr size_t WS_GB = 1368 * MiB;
constexpr size_t WS_PGU = 1400 * MiB;
constexpr size_t WS_Z = 1432 * MiB;
constexpr size_t WS_X3 = 1464 * MiB;
constexpr size_t WS_QF = 1528 * MiB;
constexpr size_t WS_KLT = 1546 * MiB;
constexpr size_t WS_ATT = 1564 * MiB;
constexpr size_t WS_VT = 1573 * MiB;
constexpr size_t WS_DEC = 1609 * MiB;
constexpr size_t WS_END = 1610 * MiB;
constexpr int CW_BAR = 4096;
constexpr int CW_CNT = 8192;
constexpr int CW_CVT = 16384;
constexpr int CW_P0 = 16384 + 512;

constexpr int RING_BYTES = 131072;
constexpr int LDS_MISC = RING_BYTES;
constexpr int LDS_PB = RING_BYTES + 256;
constexpr int LDS_TOK = RING_BYTES + 1024;
constexpr int LDS_BYTES = 147456;

__device__ __forceinline__ float bf2f(unsigned short b) { return __uint_as_float(((unsigned)b) << 16); }
__device__ __forceinline__ unsigned cvt_pk_bf16(float lo, float hi) { unsigned r; asm volatile("v_cvt_pk_bf16_f32 %0, %1, %2" : "=v"(r) : "v"(lo), "v"(hi)); return r; }
__device__ __forceinline__ float wave_sum(float v) {
#pragma unroll
    for (int o = 1; o < 64; o <<= 1) v += __shfl_xor(v, o);
    return v;
}
__device__ __forceinline__ float silu_f(float v) { return v / (1.0f + __expf(-v)); }
__device__ __forceinline__ f32x4 bf4_to_f32(u32x2 w) { f32x4 r; r[0] = __uint_as_float(w.x << 16); r[1] = __uint_as_float(w.x & 0xffff0000u); r[2] = __uint_as_float(w.y << 16); r[3] = __uint_as_float(w.y & 0xffff0000u); return r; }
__device__ __forceinline__ u32x2 f32_to_bf4(f32x4 v) { u32x2 w; w.x = cvt_pk_bf16(v[0], v[1]); w.y = cvt_pk_bf16(v[2], v[3]); return w; }
__device__ __forceinline__ void mfma_settle(f32x4& a) { asm volatile("s_nop 7\n\ts_nop 7" : "+v"(a)); }
__device__ __forceinline__ unsigned f2bf_sw(float f) { const unsigned u = __float_as_uint(f); return (u + 0x7fffu + ((u >> 16) & 1u)) >> 16; }
__device__ __forceinline__ u32x2 f32_to_bf4_sw(f32x4 v) { u32x2 w; w.x = f2bf_sw(v[0]) | (f2bf_sw(v[1]) << 16); w.y = f2bf_sw(v[2]) | (f2bf_sw(v[3]) << 16); return w; }

namespace pg8 {
constexpr int BM = 256, BK = 64, HALF = 128, HTB = HALF * BK * 2, STAGE_BYTES = 8 * HTB, NXCD = 8, WGM = 8;
__host__ __device__ __forceinline__ int lds_byte(int r, int c) { const int st = (r >> 4) * 2 + (c >> 5), rr = r & 15, cc = c & 31, ob = rr * 64 + cc * 2; return st * 1024 + (ob ^ (((ob >> 9) & 1) << 5)); }
__host__ __device__ __forceinline__ void stage_rc(int b, int& R, int& C) { const int st = b / 1024, sb = b % 1024, swz = sb ^ (((sb >> 9) & 1) << 5); R = (st >> 1) * 16 + swz / 64; C = (st & 1) * 32 + (swz % 64) / 2; }
__host__ __device__ __forceinline__ int perm32(int rho) { const int n = rho >> 4, i = rho & 15; return 8 * (i >> 2) + 4 * n + (i & 3); }

struct Unit { int pm, pn, e; };
struct Gemm { const bf16* A; const bf16* Bt; int K; };

struct StaticOrder {
    static constexpr bool GATHER = false;
    int nM, nN, nwg, G, c, ilo, ihi;
    __device__ void init(int M, int N, int G_, int c_) { nM = M / BM; nN = N / BM; nwg = nM * nN; G = G_; c = c_; ilo = 0; ihi = 1 << 30; }
    __device__ bool next(int i0, Unit& u) const {
        const int i = i0 + ilo; if (i >= ihi) return false;
        const long L = (long)i * G + c; if (L >= nwg) return false;
        int wgid = (int)L; { const int q = nwg / NXCD, r = nwg % NXCD, xcd = wgid % NXCD, off = wgid / NXCD; wgid = (xcd < r ? xcd * (q + 1) : r * (q + 1) + (xcd - r) * q) + off; }
        const int nig = WGM * nN, gid = wgid / nig, fm = gid * WGM, gsz = (nM - fm) < WGM ? (nM - fm) : WGM;
        u.pm = fm + ((wgid % nig) % gsz); u.pn = (wgid % nig) / gsz; u.e = 0; return true;
    }
    __device__ __forceinline__ const char* b_ptr(const Gemm& g, const Unit& u, size_t tstep) const { return (const char*)g.Bt + (size_t)u.pn * tstep; }
    __device__ __forceinline__ unsigned tok(int, int) const { return 0u; }
};
template <bool GATHER_> struct MoeOrder {
    static constexpr bool GATHER = GATHER_;
    const LAS int* pb; const LAS int* tokt; int G, c, nN; size_t estride;
    __device__ bool next(int i, Unit& u) const {
        const int L = i * G + c; const int total = pb[32] * nN; if (L >= total) return false;
        int e = 0;
#pragma unroll 1
        for (int j = 1; j < 32; ++j) if (pb[j] * nN <= L) e = j;
        const int r = L - pb[e] * nN, np = pb[e + 1] - pb[e];
        u.e = e; u.pn = r / np; u.pm = pb[e] + (r % np); return true;
    }
    __device__ __forceinline__ const char* b_ptr(const Gemm& g, const Unit& u, size_t tstep) const { return (const char*)g.Bt + (size_t)u.e * estride + (size_t)u.pn * tstep; }
    __device__ __forceinline__ unsigned tok(int ui, int r) const { return (unsigned)tokt[(ui & 3) * 256 + r]; }
};

struct EpiBf16 {
    static constexpr bool PERM = true;
    bf16* O; int ldc;
    __device__ __forceinline__ void operator()(const f32x4 (&acc)[2][2][4][2], const Unit& u, int wr, int wc, int fr, int fq) const {
        const int row0 = u.pm * BM + wr * 64 + fr, col0 = u.pn * BM + wc * 32 + 8 * fq;
        { f32x4 t = acc[1][1][3][1]; mfma_settle(t); }
#pragma unroll
        for (int ai = 0; ai < 2; ++ai)
#pragma unroll
            for (int m = 0; m < 4; ++m) { bf16* rowp = O + (size_t)(row0 + ai * HALF + m * 16) * ldc + col0;
#pragma unroll
                for (int bj = 0; bj < 2; ++bj) { const f32x4 v0 = acc[ai][bj][m][0], v1 = acc[ai][bj][m][1];
                    u32x4 w; w.x = cvt_pk_bf16(v0[0], v0[1]); w.y = cvt_pk_bf16(v0[2], v0[3]); w.z = cvt_pk_bf16(v1[0], v1[1]); w.w = cvt_pk_bf16(v1[2], v1[3]);
                    *(u32x4*)(rowp + bj * HALF) = w; } }
    }
};
template <bool SILU> struct EpiPair {
    static constexpr bool PERM = true;
    bf16* O; int ldo; int pn0; bf16* P; int ldp;
    __device__ __forceinline__ void operator()(const f32x4 (&acc)[2][2][4][2], const Unit& u, int wr, int wc, int fr, int fq) const {
        const int row0 = u.pm * BM + wr * 64 + fr;
        { f32x4 t = acc[1][1][3][1]; mfma_settle(t); }
        if (u.pn < pn0) {
            const int col0 = u.pn * BM + wc * 32 + 8 * fq;
#pragma unroll
            for (int ai = 0; ai < 2; ++ai)
#pragma unroll
                for (int m = 0; m < 4; ++m) { bf16* rowp = P + (size_t)(row0 + ai * HALF + m * 16) * ldp + col0;
#pragma unroll
                    for (int bj = 0; bj < 2; ++bj) { const f32x4 v0 = acc[ai][bj][m][0], v1 = acc[ai][bj][m][1];
                        u32x4 w; w.x = cvt_pk_bf16(v0[0], v0[1]); w.y = cvt_pk_bf16(v0[2], v0[3]); w.z = cvt_pk_bf16(v1[0], v1[1]); w.w = cvt_pk_bf16(v1[2], v1[3]);
                        *(u32x4*)(rowp + bj * HALF) = w; } }
        } else {
            const int col0 = (u.pn - pn0) * HALF + wc * 32 + 8 * fq;
#pragma unroll
            for (int ai = 0; ai < 2; ++ai)
#pragma unroll
                for (int m = 0; m < 4; ++m) { bf16* rowp = O + (size_t)(row0 + ai * HALF + m * 16) * ldo + col0;
                    f32x4 g0 = acc[ai][0][m][0], g1 = acc[ai][0][m][1]; const f32x4 u0 = acc[ai][1][m][0], u1 = acc[ai][1][m][1];
                    if (SILU) {
#pragma unroll
                        for (int j = 0; j < 4; ++j) { g0[j] = silu_f(g0[j]); g1[j] = silu_f(g1[j]); } }
                    g0 = g0 * u0; g1 = g1 * u1;
                    u32x4 w; w.x = cvt_pk_bf16(g0[0], g0[1]); w.y = cvt_pk_bf16(g0[2], g0[3]); w.z = cvt_pk_bf16(g1[0], g1[1]); w.w = cvt_pk_bf16(g1[2], g1[3]);
                    *(u32x4*)rowp = w; }
        }
    }
};
template <bool BASE_BF16> struct EpiResGate {
    static constexpr bool PERM = false;
    const void* base; bf16* out; const float* gate; int gstride;
    __device__ __forceinline__ void operator()(const f32x4 (&acc)[2][2][4][2], const Unit& u, int wr, int wc, int fr, int fq) const {
        const int row0 = u.pm * BM + wr * 64 + fr, col0 = u.pn * BM + wc * 32 + 4 * fq;
        const float* gp = gate + (size_t)((u.pm * BM) / SEQ) * gstride + col0;
        f32x4 gv[2][2];
#pragma unroll
        for (int bj = 0; bj < 2; ++bj)
#pragma unroll
            for (int n = 0; n < 2; ++n) gv[bj][n] = *(const f32x4*)(gp + bj * HALF + n * 16);
#pragma unroll
        for (int ai = 0; ai < 2; ++ai)
#pragma unroll
            for (int m = 0; m < 4; ++m) { const size_t off = (size_t)(row0 + ai * HALF + m * 16) * D + col0;
#pragma unroll
                for (int bj = 0; bj < 2; ++bj)
#pragma unroll
                    for (int n = 0; n < 2; ++n) { const size_t o = off + bj * HALF + n * 16;
                        const f32x4 bs = BASE_BF16 ? bf4_to_f32(*(const u32x2*)((const bf16*)base + o)) : *(const f32x4*)((const float*)base + o);
                        *(u32x2*)(out + o) = f32_to_bf4(bs + gv[bj][n] * acc[ai][bj][m][n]); } }
    }
};

template <class Epi, class Sched, bool ALIGN_EPI>
__device__ __forceinline__ void gemm_phase(LAS unsigned char* lds, const Gemm g, const Sched& S, const Epi& E) {
    const int tid = threadIdx.x, wid = __builtin_amdgcn_readfirstlane(tid >> 6), lane = tid & 63, wr = wid >> 2, wc = wid & 3, fr = lane & 15, fq = lane >> 4;
    const int K = g.K, nt = K / BK;
    unsigned voffA[2], voffB[2]; int stR[2], stC[2];
#pragma unroll
    for (int i = 0; i < 2; ++i) { int R, C; stage_rc(tid * 16 + i * 8192, R, C); const int Rb = Epi::PERM ? ((R & ~31) + perm32(R & 31)) : R;
        stR[i] = R; stC[i] = C; voffA[i] = (unsigned)(R * K + C) * 2u; voffB[i] = (unsigned)(Rb * K + C) * 2u; }
    const size_t kstep = (size_t)(BK * 2);
    const size_t hstep = (size_t)HALF * K * 2;
    const size_t tstep = 2 * hstep;
    const unsigned ldsw = (unsigned)wid * 1024u;
    const int aoff = lds_byte(wr * 64 + fr, fq * 8), boff = lds_byte(wc * 32 + fr, fq * 8);
#define PG8_SA(b, h) (((b) * 2 + (h)) * HTB)
#define PG8_SB(b, h) ((4 + (b) * 2 + (h)) * HTB)
#define PG8_STAGE(bufoff, gbase, voff) do { _Pragma("unroll") for (int _i = 0; _i < 2; ++_i) \
        __builtin_amdgcn_global_load_lds((const unsigned*)((const char*)(gbase) + (voff)[_i]), (LAS unsigned*)(lds + (bufoff) + ldsw + _i * 8192), 16, 0, 0); } while (0)
#define PG8_STAGE_A(bufoff, h, ubase, kb, vo) do { if constexpr (Sched::GATHER) { PG8_STAGE(bufoff, (const char*)g.A + (kb), (vo)[h]); } else { PG8_STAGE(bufoff, (ubase) + (h) * hstep + (kb), voffA); } } while (0)
#define PG8_LDA(dst, b, h) do { _Pragma("unroll") for (int m = 0; m < 4; ++m) _Pragma("unroll") for (int k = 0; k < 2; ++k) dst[m][k] = *(const LAS bf16x8*)(lds + PG8_SA(b, h) + aoff + m * 2048 + k * 1024); } while (0)
#define PG8_LDB(dst, b, h) do { _Pragma("unroll") for (int n = 0; n < 2; ++n) _Pragma("unroll") for (int k = 0; k < 2; ++k) dst[n][k] = *(const LAS bf16x8*)(lds + PG8_SB(b, h) + boff + n * 2048 + k * 1024); } while (0)
#define PG8_MMA(ai, bj, At, Bt) do { __builtin_amdgcn_s_setprio(1); _Pragma("unroll") for (int m = 0; m < 4; ++m) _Pragma("unroll") for (int n = 0; n < 2; ++n) _Pragma("unroll") for (int k = 0; k < 2; ++k) \
        acc[ai][bj][m][n] = __builtin_amdgcn_mfma_f32_16x16x32_bf16(Bt[n][k], At[m][k], acc[ai][bj][m][n], 0, 0, 0); __builtin_amdgcn_s_setprio(0); } while (0)
#define PG8_WAIT_V(n) asm volatile("s_waitcnt vmcnt(" #n ")" ::: "memory")
#define PG8_WAIT_L(n) asm volatile("s_waitcnt lgkmcnt(" #n ")" ::: "memory")
#define PG8_BAR __builtin_amdgcn_s_barrier()
#define PG8_SCHED __builtin_amdgcn_sched_barrier(0)
    Unit cur, nxt; int ui = 0;
    if (!S.next(0, cur)) return;
    f32x4 acc[2][2][4][2];
#pragma unroll
    for (int a = 0; a < 2; ++a)
#pragma unroll
        for (int b = 0; b < 2; ++b)
#pragma unroll
            for (int m = 0; m < 4; ++m)
#pragma unroll
                for (int n = 0; n < 2; ++n) acc[a][b][m][n] = (f32x4){0.f, 0.f, 0.f, 0.f};
    bf16x8 At[4][2], B0[2][2], B1[2][2];
    const char* cA = (const char*)g.A + (size_t)cur.pm * tstep; const char* cB = S.b_ptr(g, cur, tstep);
    unsigned voC[2][2] = {{0u, 0u}, {0u, 0u}};
    if constexpr (Sched::GATHER) {
#pragma unroll
        for (int h = 0; h < 2; ++h)
#pragma unroll
            for (int i = 0; i < 2; ++i) voC[h][i] = (S.tok(0, h * HALF + stR[i]) * (unsigned)K + (unsigned)stC[i]) * 2u;
    }
    PG8_STAGE(PG8_SB(0, 0), cB, voffB); PG8_STAGE(PG8_SB(0, 1), cB + hstep, voffB); PG8_STAGE_A(PG8_SA(0, 0), 0, cA, 0, voC); PG8_STAGE_A(PG8_SA(0, 1), 1, cA, 0, voC);
    if (wr == 1) PG8_BAR;
    PG8_WAIT_V(2); PG8_BAR;
    PG8_STAGE(PG8_SB(1, 0), cB + kstep, voffB); PG8_STAGE_A(PG8_SA(1, 0), 0, cA, kstep, voC); PG8_STAGE(PG8_SB(1, 1), cB + hstep + kstep, voffB);
    PG8_WAIT_V(6); PG8_BAR;
    for (;;) {
        const bool has_next = S.next(ui + 1, nxt);
        const char* nA = has_next ? (const char*)g.A + (size_t)nxt.pm * tstep : cA; const char* nB = has_next ? S.b_ptr(g, nxt, tstep) : cB;
        for (int t = 0; t < nt; t += 2) {
            const bool last = (t == nt - 2);
            const char* a1 = cA; const size_t k1 = (size_t)(t + 1) * kstep;
            const char* a2 = last ? nA : cA; const size_t k2 = last ? 0 : (size_t)(t + 2) * kstep; const char* b2 = last ? nB : cB + (size_t)(t + 2) * kstep;
            const size_t k3 = k2 + kstep; const char* b3 = b2 + kstep;
            unsigned vo2[2][2] = {{0u, 0u}, {0u, 0u}};
            if constexpr (Sched::GATHER) {
                if (last && has_next) {
#pragma unroll
                    for (int h = 0; h < 2; ++h)
#pragma unroll
                        for (int i = 0; i < 2; ++i) vo2[h][i] = (S.tok(ui + 1, h * HALF + stR[i]) * (unsigned)K + (unsigned)stC[i]) * 2u;
                } else {
#pragma unroll
                    for (int h = 0; h < 2; ++h)
#pragma unroll
                        for (int i = 0; i < 2; ++i) vo2[h][i] = voC[h][i];
                }
            }
            PG8_LDB(B0, 0, 0); PG8_LDB(B1, 0, 1); PG8_SCHED; PG8_LDA(At, 0, 0); PG8_STAGE_A(PG8_SA(1, 1), 1, a1, k1, voC);
            PG8_WAIT_V(8); PG8_WAIT_L(0); PG8_BAR; PG8_MMA(0, 0, At, B0); PG8_MMA(0, 1, At, B1); PG8_BAR; PG8_SCHED;
            PG8_LDA(At, 0, 1); PG8_STAGE(PG8_SB(0, 0), b2, voffB); PG8_STAGE(PG8_SB(0, 1), b2 + hstep, voffB); PG8_STAGE_A(PG8_SA(0, 0), 0, a2, k2, vo2);
            PG8_WAIT_V(8); PG8_WAIT_L(0); PG8_BAR; PG8_MMA(1, 0, At, B0); PG8_MMA(1, 1, At, B1); PG8_BAR; PG8_SCHED;
            PG8_LDB(B0, 1, 0); PG8_LDB(B1, 1, 1); PG8_SCHED; PG8_LDA(At, 1, 0); PG8_STAGE_A(PG8_SA(0, 1), 1, a2, k2, vo2);
            PG8_WAIT_V(8); PG8_WAIT_L(0); PG8_BAR; PG8_MMA(0, 0, At, B0); PG8_MMA(0, 1, At, B1); PG8_BAR; PG8_SCHED;
            PG8_LDA(At, 1, 1); PG8_STAGE(PG8_SB(1, 0), b3, voffB); PG8_STAGE(PG8_SB(1, 1), b3 + hstep, voffB); PG8_STAGE_A(PG8_SA(1, 0), 0, a2, k3, vo2);
            PG8_WAIT_V(8); PG8_WAIT_L(0); PG8_BAR; PG8_MMA(1, 0, At, B0); PG8_MMA(1, 1, At, B1); PG8_BAR; PG8_SCHED;
            if constexpr (Sched::GATHER) { if (last) {
#pragma unroll
                for (int h = 0; h < 2; ++h)
#pragma unroll
                    for (int i = 0; i < 2; ++i) voC[h][i] = vo2[h][i]; } }
        }
        if constexpr (ALIGN_EPI) { if (wr == 0) PG8_BAR; }
        E(acc, cur, wr, wc, fr, fq);
        if (!has_next) break;
#pragma unroll
        for (int a = 0; a < 2; ++a)
#pragma unroll
            for (int b = 0; b < 2; ++b)
#pragma unroll
                for (int m = 0; m < 4; ++m)
#pragma unroll
                    for (int n = 0; n < 2; ++n) acc[a][b][m][n] = (f32x4){0.f, 0.f, 0.f, 0.f};
        cur = nxt; cA = nA; cB = nB; ++ui;
        if constexpr (ALIGN_EPI) { if (wr == 1) PG8_BAR; }
    }
    PG8_WAIT_V(0);
    if constexpr (!ALIGN_EPI) { if (wr == 0) PG8_BAR; }
    PG8_BAR;
#undef PG8_SA
#undef PG8_SB
#undef PG8_STAGE
#undef PG8_STAGE_A
#undef PG8_LDA
#undef PG8_LDB
#undef PG8_MMA
#undef PG8_WAIT_V
#undef PG8_WAIT_L
#undef PG8_BAR
#undef PG8_SCHED
}
}

#define XB_TMO      128
#define XB_XCNT(j)  (256  + 64 * (j))
#define XB_XSUB(j)  (1280 + 64 * (j))
#define XB_XGEN(j)  (2304 + 64 * (j))
#define XB_TOP      3328
#define XB_TOPGEN   3392
#define XCD_BAR_WORDS 3456
#define XB_SPIN_CAP (1u << 18)
__device__ __forceinline__ unsigned xb_ld(unsigned* p)              { return __hip_atomic_load(p, __ATOMIC_RELAXED, __HIP_MEMORY_SCOPE_AGENT); }
__device__ __forceinline__ unsigned xb_add(unsigned* p, unsigned v) { return __hip_atomic_fetch_add(p, v, __ATOMIC_RELAXED, __HIP_MEMORY_SCOPE_AGENT); }
__device__ __forceinline__ unsigned xb_xcc_id() { return (unsigned)__builtin_amdgcn_s_getreg((3 << 11) | 20) & 0xFu; }
#define XB_SPIN(cond, bar) do { unsigned _sp = 0; while (cond) { __builtin_amdgcn_s_sleep(1); \
    if ((++_sp & 255u) == 0u) { if (xb_ld(&(bar)[XB_TMO])) break; if (_sp > XB_SPIN_CAP) { atomicAdd(&(bar)[XB_TMO], 1u); break; } } } } while (0)
struct XcdBarrier { unsigned* bar; unsigned x; volatile LAS unsigned* st; };
__device__ __forceinline__ XcdBarrier xcd_barrier_post(unsigned* bar, volatile LAS unsigned* st) {
    XcdBarrier b; b.bar = bar; b.x = xb_xcc_id(); b.st = st;
    if (threadIdx.x == 0) (void)xb_add(&bar[XB_XCNT(b.x)], 1u);
    return b;
}
__device__ __forceinline__ void xcd_barrier_complete(unsigned* bar, unsigned x, unsigned& nloc, unsigned& nx) {
    const unsigned G = gridDim.x * gridDim.y * gridDim.z;
    unsigned sum, cnt, mine, sp = 0u;
    for (;;) {
        sum = 0u; cnt = 0u; mine = 0u;
#pragma unroll
        for (unsigned j = 0; j < 16; ++j) { const unsigned c = xb_ld(&bar[XB_XCNT(j)]); sum += c; cnt += (c > 0u) ? 1u : 0u; mine = (j == x) ? c : mine; }
        if (sum == G) break;
        __builtin_amdgcn_s_sleep(1);
        if ((++sp & 255u) == 0u) { if (xb_ld(&bar[XB_TMO])) break; if (sp > XB_SPIN_CAP) { atomicAdd(&bar[XB_TMO], 1u); break; } }
    }
    nloc = mine > 0u ? mine : 1u; nx = cnt > 0u ? cnt : 1u;
}
__device__ __forceinline__ void xcd_barrier(const XcdBarrier& b) {
    asm volatile("s_waitcnt vmcnt(0)" ::: "memory");
    __syncthreads();
    if (threadIdx.x == 0) {
        unsigned* bar = b.bar;
        __builtin_amdgcn_s_waitcnt(0);
        unsigned nloc = b.st[0], nx = b.st[1];
        if (nloc == 0u) { xcd_barrier_complete(bar, b.x, nloc, nx); b.st[0] = nloc; b.st[1] = nx; }
        const unsigned old = xb_add(&bar[XB_XSUB(b.x)], 1u);
        const unsigned gen = old / nloc;
        if (old + 1u == (gen + 1u) * nloc) {
            __builtin_amdgcn_fence(__ATOMIC_RELEASE, "agent");
            asm volatile("s_waitcnt vmcnt(0)" ::: "memory");
            const unsigned og = xb_add(&bar[XB_TOP], 1u);
            const unsigned tg = og / nx;
            if (og + 1u == (tg + 1u) * nx) xb_add(&bar[XB_TOPGEN], 1u);
            else XB_SPIN(xb_ld(&bar[XB_TOPGEN]) == tg, bar);
            __builtin_amdgcn_fence(__ATOMIC_ACQUIRE, "agent");
            xb_add(&bar[XB_XGEN(b.x)], 1u);
            asm volatile("s_waitcnt vmcnt(0)" ::: "memory");
        } else {
            XB_SPIN(xb_ld(&bar[XB_XGEN(b.x)]) == gen, bar);
            __builtin_amdgcn_fence(__ATOMIC_ACQUIRE, "agent");
            asm volatile("s_waitcnt vmcnt(0)" ::: "memory");
        }
    }
    __syncthreads();
}

struct Args { const float* in[22]; float* out; unsigned char* ws; int ph_lo, ph_hi; };
enum { I_X = 0, I_C, I_CTX, I_CCTX, I_MODW, I_MODB, I_AWIN, I_QN, I_KN, I_SINK, I_WA2, I_BA, I_GN, I_AWOUT, I_CWIN, I_CW, I_CWOUT, I_RW, I_RB, I_W1, I_W3, I_W2 };

struct Frame {
    LAS unsigned char* lds;
    const float* in[22]; float* out; unsigned char* ws;
    int tid, lane, wave, G, vcu;
};
#define WSP(T, off) ((T*)(F.ws + (off)))

__device__ __forceinline__ int rowmap(int kind, int n) {
    if (kind == 1) { return n < 2048 ? n : (n < 4096 ? 2048 + 256 * ((n - 2048) >> 7) + ((n - 2048) & 127) : 2048 + 256 * ((n - 4096) >> 7) + 128 + ((n - 4096) & 127)); }
    if (kind == 2) return 256 * (n >> 7) + (n & 127);
    if (kind == 3) return 256 * (n >> 7) + 128 + (n & 127);
    return n;
}
constexpr int CV_B0 = 8192, CV_B1 = 12288, CV_B2 = 20480, CV_B3 = 24576;
struct TileDesc { const float* src; bf16* dst; int K, N, kind, k0, n0; };
__device__ __forceinline__ TileDesc expert_tile(Frame& F, int layer_unused, int g) {
    const int layer = g >= CV_B1 ? 1 : 0, gl = g - layer * CV_B1; TileDesc d; int t;
    if (gl < CV_B0) { const int le = layer * 32 + (gl >> 8), r = gl & 255; t = r & 127;
        if ((r >> 7) == 0) { d.src = F.in[I_W1] + (size_t)le * 2048 * 1024; d.kind = 2; } else { d.src = F.in[I_W3] + (size_t)le * 2048 * 1024; d.kind = 3; }
        d.dst = WSP(bf16, WS_W13_T) + (size_t)le * 2048 * 2048; d.K = 2048; d.N = 1024; }
    else { const int dd = gl - CV_B0, le = layer * 32 + (dd >> 7); t = dd & 127;
        d.src = F.in[I_W2] + (size_t)le * 1024 * 2048; d.dst = WSP(bf16, WS_W2_T) + (size_t)le * 2048 * 1024; d.K = 1024; d.N = 2048; d.kind = 0; }
    const int nnt = d.N / 64; d.n0 = (t % nnt) * 64; d.k0 = (t / nnt) * 256; return d;
}
struct TileSrc { const float* p; bf16* dst; int K, kind, n0; bool ok; };
constexpr int DT0 = 8 * 76, DT1 = 8 * 32, DT2 = 8 * 96, DT3 = 8 * 32, DENSE_TILES = DT0 + DT1 + DT2 + DT3;
__device__ __forceinline__ TileDesc dense_tile(Frame& F, int g) {
    TileDesc d; int t = g < DENSE_TILES ? g : DENSE_TILES - 1, nnt; d.K = 2048;
    if (t < DT0) { d.src = F.in[I_AWIN]; d.N = 4640; d.dst = WSP(bf16, WS_WIN_T); d.kind = 0; nnt = 76; }
    else if ((t -= DT0) < DT1) { d.src = F.in[I_AWOUT]; d.N = 2048; d.dst = WSP(bf16, WS_WOUT_T); d.kind = 0; nnt = 32; }
    else if ((t -= DT1) < DT2) { d.src = F.in[I_CWIN]; d.N = 6144; d.dst = WSP(bf16, WS_CIN_T); d.kind = 1; nnt = 96; }
    else { t -= DT2; d.src = F.in[I_CWOUT]; d.N = 2048; d.dst = WSP(bf16, WS_COUT_T); d.kind = 0; nnt = 32; }
    d.n0 = (t % nnt) * 64; d.k0 = (t / nnt) * 256; return d;
}
template <bool DENSE> __device__ __forceinline__ void convert_tiles6(Frame& F, int tau0, unsigned* ctr, bool claim, volatile LAS unsigned* W) {
    constexpr int TP = 264, TB = 64 * TP * 2;
    const int ng = F.tid & 15, kqb = F.tid >> 4;
    tau0 = __builtin_amdgcn_readfirstlane(tau0);
    f32x4 va[3][2][4], vb[3][2][4]; TileSrc ta[3], tb[3];
#define CV_LOADA(V, T, t0) do { _Pragma("unroll") for (int q = 0; q < 3; ++q) { const TileDesc d = DENSE ? dense_tile(F, (t0) + q) : expert_tile(F, 0, (t0) + q); \
        T[q].ok = !DENSE || d.n0 + 4 * ng < d.N; \
        T[q].p = d.src + (size_t)d.k0 * d.N + (T[q].ok ? d.n0 + 4 * ng : 0); T[q].dst = d.dst + d.k0; T[q].K = d.K; T[q].kind = d.kind; T[q].n0 = d.n0; const int N = d.N; \
        _Pragma("unroll") for (int h = 0; h < 2; ++h) _Pragma("unroll") for (int r = 0; r < 4; ++r) { const float* p_ = T[q].p + (size_t)(4 * (kqb + 32 * h) + r) * N; \
            asm volatile("global_load_dwordx4 %0, %1, off nt" : "=v"(V[q][h][r]) : "v"(p_) : "memory"); } } } while (0)
#define CV_PIN(V) do { _Pragma("unroll") for (int q = 0; q < 3; ++q) asm volatile("" : "+v"(V[q][0][0]), "+v"(V[q][0][1]), "+v"(V[q][0][2]), "+v"(V[q][0][3]), "+v"(V[q][1][0]), "+v"(V[q][1][1]), "+v"(V[q][1][2]), "+v"(V[q][1][3])); } while (0)
#define CV_BAR() do { asm volatile("s_waitcnt lgkmcnt(0)" ::: "memory"); __builtin_amdgcn_s_barrier(); asm volatile("" ::: "memory"); } while (0)
#define CV_WRITE(V, T) do { _Pragma("unroll") for (int q = 0; q < 3; ++q) { LAS bf16* T_ = (LAS bf16*)(F.lds + q * TB); const float m_ = (DENSE && !T[q].ok) ? 0.f : 1.f; \
        _Pragma("unroll") for (int h = 0; h < 2; ++h) { const int kq = kqb + 32 * h; \
            _Pragma("unroll") for (int i = 0; i < 4; ++i) { const int n = 4 * ng + i; u32x2 w; \
                if (DENSE) { w.x = cvt_pk_bf16(V[q][h][0][i] * m_, V[q][h][1][i] * m_); w.y = cvt_pk_bf16(V[q][h][2][i] * m_, V[q][h][3][i] * m_); } \
                else { w.x = cvt_pk_bf16(V[q][h][0][i], V[q][h][1][i]); w.y = cvt_pk_bf16(V[q][h][2][i], V[q][h][3][i]); } \
                *(LAS u32x2*)(T_ + n * TP + 8 * ((kq >> 1) ^ ((n >> 4) & 3)) + 4 * (kq & 1)) = w; } } } } while (0)
#define CV_OUT(T) do { _Pragma("unroll") for (int q = 0; q < 3; ++q) { const LAS bf16* T_ = (const LAS bf16*)(F.lds + q * TB); \
        _Pragma("unroll") for (int qq = 0; qq < 4; ++qq) { const int piece = F.tid + 512 * qq, c = piece & 31, n = piece >> 5; \
            const u32x4 o = *(const LAS u32x4*)(T_ + n * TP + 8 * (c ^ ((n >> 4) & 3))); \
            __builtin_nontemporal_store(o, (u32x4*)(T[q].dst + (size_t)rowmap(T[q].kind, T[q].n0 + n) * T[q].K + 8 * c)); } } } while (0)
    CV_LOADA(va, ta, tau0);
    CV_LOADA(vb, tb, tau0 + 3);
    CV_BAR();
    asm volatile("s_waitcnt vmcnt(24)" ::: "memory"); CV_PIN(va);
    CV_WRITE(va, ta);
    CV_BAR();
    CV_OUT(ta);
    CV_BAR();
    asm volatile("s_waitcnt vmcnt(12)" ::: "memory"); CV_PIN(vb);
    CV_WRITE(vb, tb);
    CV_BAR();
    unsigned nxt = 0x40000000u; { const unsigned long long cm = __ballot(claim); unsigned long long sv; const unsigned six = 6u;
        asm volatile("s_mov_b64 %1, exec\n\ts_and_b64 exec, exec, %4\n\tglobal_atomic_add %0, %2, %3, off sc0\n\ts_mov_b64 exec, %1"
                     : "+v"(nxt), "=&s"(sv) : "v"(ctr), "v"(six), "s"(cm) : "memory", "scc"); }
    CV_OUT(tb);
    asm volatile("s_waitcnt vmcnt(12)" : "+v"(nxt) :: "memory");
    if (F.tid == 0) W[0] = nxt;
    CV_BAR();
#undef CV_LOADA
#undef CV_PIN
#undef CV_BAR
#undef CV_WRITE
#undef CV_OUT
}
__device__ __forceinline__ void convert_claim(Frame& F, int quota, int drain_to) {
    volatile LAS unsigned* W = (volatile LAS unsigned*)(F.lds + LDS_MISC) + 16;
    unsigned* ctr = WSP(unsigned, WS_CTL) + CW_CVT;
    __syncthreads();
    if (F.tid == 0) { bool want = quota > 0;
        if (!want && drain_to > 0) want = (int)__hip_atomic_load(ctr, __ATOMIC_RELAXED, __HIP_MEMORY_SCOPE_AGENT) < drain_to;
        W[0] = want ? atomicAdd(ctr, 6u) : 0x40000000u; }
    __syncthreads();
    int taken = 0;
    for (;;) {
        const int base = (int)W[0];
        if (base >= CV_B3) break;
        taken += 6;
        convert_tiles6<false>(F, base, ctr, F.tid == 0 && (taken < quota || base + 6 < drain_to), W);
    }
}
__device__ __forceinline__ void phase0(Frame& F) {
    if ((int)blockIdx.x < 192) {
        LAS float* sc = (LAS float*)F.lds;
        LAS float* red = sc + 5 * 2048;
        const float* c = F.in[I_C]; const float* cc = F.in[I_CCTX];
        for (int i = F.tid; i < 5 * 2048; i += 512) { const int r = i >> 11, k = i & 2047; const float v = r < 4 ? c[r * 2048 + k] : cc[k]; sc[i] = v / (1.0f + expf(-v)); }
        __syncthreads();
        float* MOD = WSP(float, WS_MOD);
        const int kh = F.lane >> 5, c4 = F.lane & 31;
        for (int unit = blockIdx.x; unit < 192; unit += F.G) {
            const int l = unit / 96, cg = unit % 96;
            const float* W = F.in[I_MODW] + (size_t)l * 2048 * 12288 + cg * 128 + 4 * c4 + (size_t)(F.wave * 256 + kh) * 12288;
            f32x4 acc[5];
#pragma unroll
            for (int r = 0; r < 5; ++r) acc[r] = (f32x4){0.f, 0.f, 0.f, 0.f};
#pragma unroll 1
            for (int blk = 0; blk < 8; ++blk) {
                f32x4 w[16];
#pragma unroll
                for (int u = 0; u < 16; ++u) w[u] = __builtin_nontemporal_load((const f32x4*)(W + (size_t)(2 * (16 * blk + u)) * 12288));
#pragma unroll
                for (int u = 0; u < 16; ++u) { const int k = F.wave * 256 + 2 * (16 * blk + u) + kh;
#pragma unroll
                    for (int r = 0; r < 5; ++r) { const float sv = sc[r * 2048 + k]; acc[r] += w[u] * sv; }
                    __builtin_amdgcn_sched_barrier(0); }
            }
#pragma unroll
            for (int r = 0; r < 5; ++r) *(LAS f32x4*)(red + ((F.wave * 2 + kh) * 5 + r) * 128 + 4 * c4) = acc[r];
            __syncthreads();
            for (int o = F.tid; o < 640; o += 512) { const int r = o >> 7, ccn = o & 127; float sum = 0.f;
#pragma unroll
                for (int g = 0; g < 16; ++g) sum += red[(g * 5 + r) * 128 + ccn];
                MOD[(size_t)(l * 5 + r) * 12288 + cg * 128 + ccn] = sum + F.in[I_MODB][l * 12288 + cg * 128 + ccn]; }
            __syncthreads();
        }
    }
    volatile LAS unsigned* Wq = (volatile LAS unsigned*)(F.lds + LDS_MISC) + 24; unsigned* head = WSP(unsigned, WS_CTL) + CW_P0;
    __syncthreads();
    if (F.tid == 0) Wq[0] = atomicAdd(head, 6u);
    __syncthreads();
    for (;;) {
        const int base = (int)Wq[0];
        if (base >= DENSE_TILES) break;
        convert_tiles6<true>(F, base, head, F.tid == 0, Wq);
    }
}

__device__ __forceinline__ void modulate_store(const f32x4 (&v)[8], const float* shift, const float* scale, bf16* orow, int lane) {
    float ss = 0.f;
#pragma unroll
    for (int j = 0; j < 8; ++j) ss += (v[j][0] * v[j][0] + v[j][1] * v[j][1]) + (v[j][2] * v[j][2] + v[j][3] * v[j][3]);
    const float rstd = 1.0f / sqrtf(wave_sum(ss) * (1.0f / D) + EPS);
#pragma unroll
    for (int j = 0; j < 8; ++j) { const int c = 4 * (64 * j + lane); const f32x4 sh = *(const f32x4*)(shift + c), sc = *(const f32x4*)(scale + c);
        const f32x4 y = v[j] * rstd * (sc + 1.0f) + sh;
        u32x2 w; w.x = cvt_pk_bf16(y[0], y[1]); w.y = cvt_pk_bf16(y[2], y[3]); *(u32x2*)(orow + c) = w; }
}
__device__ __forceinline__ void phase_modulate0(Frame& F) {
    const int gw = blockIdx.x * 8 + F.wave, NGW = F.G * 8; const float* MOD = WSP(float, WS_MOD); bf16* HA = WSP(bf16, WS_HA);
    for (int row = gw; row < TA; row += NGW) {
        const float* src = row < TL ? F.in[I_X] + (size_t)row * D : F.in[I_CTX] + (size_t)(row - TL) * D;
        const int mr = row < TL ? row / SEQ : 4;
        f32x4 v[8];
#pragma unroll
        for (int j = 0; j < 8; ++j) v[j] = *(const f32x4*)(src + 4 * (64 * j + F.lane));
        modulate_store(v, MOD + (size_t)mr * 12288, MOD + (size_t)mr * 12288 + 2048, HA + (size_t)row * D, F.lane);
    }
    { bf16* RH = WSP(bf16, WS_RWT_HI); bf16* RL = WSP(bf16, WS_RWT_LO); const float* rw = F.in[I_RW];
      for (int piece = blockIdx.x * 512 + F.tid; piece < 2 * 4 * 32 * 256; piece += F.G * 512) { const int e = piece & 31, k0 = ((piece >> 5) & 255) * 8, lb = piece >> 13; unsigned hi[4], lo[4];
          const float* sc = MOD + (size_t)((lb >> 2) * 5 + (lb & 3)) * 12288 + 4 * 2048 + k0; const f32x4 s0 = *(const f32x4*)sc + 1.0f, s1 = *(const f32x4*)(sc + 4) + 1.0f;
#pragma unroll
          for (int i = 0; i < 4; ++i) { const float sa = i < 2 ? s0[2 * i] : s1[2 * i - 4], sb = i < 2 ? s0[2 * i + 1] : s1[2 * i - 3];
              const float a = rw[(size_t)(k0 + 2 * i) * 32 + e] * sa, b = rw[(size_t)(k0 + 2 * i + 1) * 32 + e] * sb;
              hi[i] = cvt_pk_bf16(a, b); lo[i] = cvt_pk_bf16(a - __uint_as_float(hi[i] << 16), b - __uint_as_float(hi[i] & 0xffff0000u)); }
          u32x4 h4, l4; h4.x = hi[0]; h4.y = hi[1]; h4.z = hi[2]; h4.w = hi[3]; l4.x = lo[0]; l4.y = lo[1]; l4.z = lo[2]; l4.w = lo[3];
          const size_t fi = ((((size_t)lb * 8 + (k0 >> 8)) * 8 + ((k0 >> 5) & 7)) * 2 + (e >> 4)) * 64 + ((k0 >> 3) & 3) * 16 + (e & 15);
          *(u32x4*)(RH + fi * 8) = h4; *(u32x4*)(RL + fi * 8) = l4; }
      for (int u = blockIdx.x; u < 128; u += F.G) { const int lb = u & 7, seg = u >> 3, e = F.tid & 31, part = F.tid >> 5; LAS float* red = (LAS float*)F.lds;
          const float* sh = MOD + (size_t)((lb >> 2) * 5 + (lb & 3)) * 12288 + 3 * 2048; const int kb = seg * 128 + part * 8; float sum = 0.f;
#pragma unroll
          for (int i = 0; i < 8; ++i) sum += sh[kb + i] * rw[(size_t)(kb + i) * 32 + e];
          __syncthreads(); red[part * 32 + e] = sum; __syncthreads();
          if (F.tid < 32) { float t = 0.f;
#pragma unroll
              for (int p = 0; p < 16; ++p) t += red[p * 32 + F.tid];
              WSP(float, WS_RBIAS)[(lb * 16 + seg) * 32 + F.tid] = t; } } }
}

__device__ __forceinline__ void phase_prep(Frame& F) {
    bf16* PROJ = WSP(bf16, WS_PROJ);
    const int gw = blockIdx.x * 8 + F.wave, NGW = F.G * 8, lane = F.lane;
    const int hs = lane >> 4, sub = lane & 15, fb = 8 * (sub & 3); const bool second = (sub & 4) != 0, axis1 = (sub & 8) != 0;
    float qg[8], kg[8], invf[8];
#pragma unroll
    for (int j = 0; j < 8; ++j) { qg[j] = F.in[I_QN][8 * sub + j]; kg[j] = F.in[I_KN][8 * sub + j]; invf[j] = __expf(-(float)(fb + j) * (9.210340371976184f / 32.0f)); }
    for (int row = gw; row < TA; row += NGW) {
        bf16* pr = PROJ + (size_t)row * NPROJ;
        const bool lat = row < TL;
        float cs[8], sn[8];
        if (lat) { const int t = row % SEQ; const float pos = (float)(axis1 ? (t % 64) : (t / 64));
#pragma unroll
            for (int j = 0; j < 8; ++j) { const float a = pos * invf[j]; cs[j] = __cosf(a); sn[j] = __sinf(a); } }
        else {
#pragma unroll
            for (int j = 0; j < 8; ++j) { cs[j] = 1.f; sn[j] = 0.f; } }
        u32x4 raw[3]; bool act[3];
#pragma unroll
        for (int p = 0; p < 3; ++p) { const int h = 4 * p + hs; act[p] = (h < 10) && (lat || h >= 8);
            raw[p] = (u32x4){0u, 0u, 0u, 0u};
            if (act[p]) raw[p] = *(const u32x4*)(pr + (h < 8 ? C_AQ + h * 128 : C_AK + (h - 8) * 128) + 8 * sub); }
#pragma unroll
        for (int p = 0; p < 3; ++p) { const int h = 4 * p + hs;
            const unsigned ww[4] = {raw[p].x, raw[p].y, raw[p].z, raw[p].w}; float x[8]; float ss = 0.f;
#pragma unroll
            for (int j = 0; j < 8; ++j) { x[j] = (j & 1) ? __uint_as_float(ww[j >> 1] & 0xffff0000u) : __uint_as_float(ww[j >> 1] << 16); ss += x[j] * x[j]; }
            ss += __shfl_xor(ss, 1); ss += __shfl_xor(ss, 2); ss += __shfl_xor(ss, 4); ss += __shfl_xor(ss, 8);
            const float rstd = 1.0f / sqrtf(ss * (1.0f / 128.0f) + EPS);
            float y[8];
#pragma unroll
            for (int j = 0; j < 8; ++j) { const float yv = x[j] * rstd * (p < 2 ? qg[j] : kg[j]); const float pv = __shfl_xor(yv, 4);
                y[j] = second ? yv * cs[j] + pv * sn[j] : yv * cs[j] - pv * sn[j]; }
            u32x4 o; o.x = cvt_pk_bf16(y[0], y[1]); o.y = cvt_pk_bf16(y[2], y[3]); o.z = cvt_pk_bf16(y[4], y[5]); o.w = cvt_pk_bf16(y[6], y[7]);
            if (act[p]) *(u32x4*)(pr + (h < 8 ? C_AQ + h * 128 : C_AK + (h - 8) * 128) + 8 * sub) = o; }
    }
    LAS bf16* T = (LAS bf16*)F.lds;
    bf16* VTL = WSP(bf16, WS_VTL); bf16* VTC = WSP(bf16, WS_VTC);
    for (int u = blockIdx.x; u < 288; u += F.G) {
        const bool isl = u < 256; const int uu = isl ? u : u - 256; const int ntile = isl ? 32 : 4;
        const int b = uu / (2 * ntile), kvh = (uu / ntile) & 1, tt = uu % ntile;
        const int row0 = isl ? b * SEQ + tt * 64 : TL + b * CTXL + tt * 64;
#pragma unroll
        for (int q = 0; q < 2; ++q) { const int j = F.lane, seg = F.wave + 8 * q;
            const u32x4 w = *(const u32x4*)(PROJ + (size_t)(row0 + j) * NPROJ + C_AV + kvh * 128 + seg * 8);
            const unsigned ww[4] = {w.x, w.y, w.z, w.w};
#pragma unroll
            for (int i = 0; i < 8; ++i) T[(seg * 8 + i) * 72 + j] = (bf16)((ww[i >> 1] >> ((i & 1) * 16)) & 0xffffu); }
        __syncthreads();
#pragma unroll
        for (int q = 0; q < 2; ++q) { const int piece = F.tid + 512 * q, d = piece >> 3, seg = piece & 7;
            const u32x4 w = *(const LAS u32x4*)(T + d * 72 + seg * 8);
            bf16* dst = isl ? VTL + ((size_t)(b * 2 + kvh) * 128 + d) * SEQ + tt * 64 + seg * 8 : VTC + ((size_t)(b * 2 + kvh) * 128 + d) * CTXL + tt * 64 + seg * 8;
            *(u32x4*)dst = w; }
        __syncthreads();
    }
}

__device__ __forceinline__ void attn_unit(Frame& F, int unit) {
    const bf16* PROJ = WSP(bf16, WS_PROJ); const bf16* VTL = WSP(bf16, WS_VTL); const bf16* VTC = WSP(bf16, WS_VTC); bf16* MIX = WSP(bf16, WS_MIX);
    const int b = unit >> 6, qb = (unit >> 2) & 15, kvh = (unit >> 1) & 1, gp = unit & 1;
    const int w = F.wave, lane = F.lane, fr = lane & 15, fq = lane >> 4;
    const int hq = kvh * 4 + gp * 2 + (w >> 2), qr0 = qb * 128 + 32 * (w & 3);
    LAS bf16* Ks = (LAS bf16*)F.lds;
    LAS bf16* Vs = Ks + 64 * 136;
    LAS bf16* Ps = Vs + 128 * 72 + w * (32 * 72);
    bf16x8 Q[2][4];
#pragma unroll
    for (int mt = 0; mt < 2; ++mt)
#pragma unroll
        for (int ks = 0; ks < 4; ++ks) Q[mt][ks] = *(const bf16x8*)(PROJ + (size_t)(b * SEQ + qr0 + 16 * mt + fr) * NPROJ + C_AQ + hq * 128 + 32 * ks + 8 * fq);
    const float sinkv = F.in[I_SINK][hq];
    float mrun[2] = {sinkv, sinkv}, lrun[2] = {1.f, 1.f};
    f32x4 o[2][8];
#pragma unroll
    for (int mt = 0; mt < 2; ++mt)
#pragma unroll
        for (int dt = 0; dt < 8; ++dt) o[mt][dt] = (f32x4){0.f, 0.f, 0.f, 0.f};
    const int kt_lo = (2 * qb - 2) < 0 ? 0 : 2 * qb - 2, kt_hi = (2 * qb + 3) > 31 ? 31 : 2 * qb + 3;
    const int ntiles = 4 + (kt_hi - kt_lo + 1);
    u32x4 rk[2], rv[2];
#define ATT_LOAD(ti_) do { const bool isc_ = (ti_) < 4; const int kt_ = isc_ ? (ti_) : kt_lo + ((ti_) - 4); \
        const size_t krow0_ = isc_ ? (size_t)(TL + b * CTXL + kt_ * 64) : (size_t)(b * SEQ + kt_ * 64); \
        const bf16* vt_ = isc_ ? VTC + (size_t)(b * 2 + kvh) * 128 * CTXL + kt_ * 64 : VTL + (size_t)(b * 2 + kvh) * 128 * SEQ + kt_ * 64; const int vld_ = isc_ ? CTXL : SEQ; \
        _Pragma("unroll") for (int q = 0; q < 2; ++q) { const int piece = F.tid + 512 * q; \
            rk[q] = *(const u32x4*)(PROJ + (krow0_ + (piece >> 4)) * NPROJ + C_AK + kvh * 128 + (piece & 15) * 8); \
            rv[q] = *(const u32x4*)(vt_ + (size_t)(piece >> 3) * vld_ + (piece & 7) * 8); } } while (0)
    ATT_LOAD(0);
    for (int ti = 0; ti < ntiles; ++ti) {
        const bool isc = ti < 4; const int kt = isc ? ti : kt_lo + (ti - 4);
        __syncthreads();
#pragma unroll
        for (int q = 0; q < 2; ++q) { const int piece = F.tid + 512 * q;
            *(LAS u32x4*)(Ks + (piece >> 4) * 136 + (piece & 15) * 8) = rk[q];
            *(LAS u32x4*)(Vs + (piece >> 3) * 72 + (piece & 7) * 8) = rv[q]; }
        __syncthreads();
        if (ti + 1 < ntiles) ATT_LOAD(ti + 1);
        f32x4 s[2][4];
#pragma unroll
        for (int mt = 0; mt < 2; ++mt)
#pragma unroll
            for (int nt = 0; nt < 4; ++nt) s[mt][nt] = (f32x4){0.f, 0.f, 0.f, 0.f};
#pragma unroll
        for (int nt = 0; nt < 4; ++nt)
#pragma unroll
            for (int ks = 0; ks < 4; ++ks) { const bf16x8 kf = *(const LAS bf16x8*)(Ks + (16 * nt + fr) * 136 + 32 * ks + 8 * fq);
#pragma unroll
                for (int mt = 0; mt < 2; ++mt) s[mt][nt] = __builtin_amdgcn_mfma_f32_16x16x32_bf16(kf, Q[mt][ks], s[mt][nt], 0, 0, 0); }
#pragma unroll
        for (int mt = 0; mt < 2; ++mt) {
            const int qpos = qr0 + 16 * mt + fr;
            float mx = -3.0e38f;
#pragma unroll
            for (int nt = 0; nt < 4; ++nt)
#pragma unroll
                for (int i = 0; i < 4; ++i) { float v = s[mt][nt][i] * 0.08838834764831845f;
                    if (!isc) { const int kpos = kt * 64 + 16 * nt + 4 * fq + i; const int dd = kpos - qpos; if (dd > 128 || dd < -128) v = -3.0e38f; }
                    s[mt][nt][i] = v; mx = fmaxf(mx, v); }
            mx = fmaxf(mx, __shfl_xor(mx, 16)); mx = fmaxf(mx, __shfl_xor(mx, 32));
            const float mnew = fmaxf(mrun[mt], mx), alpha = __expf(mrun[mt] - mnew);
            float rs = 0.f;
#pragma unroll
            for (int nt = 0; nt < 4; ++nt) { f32x4 p;
#pragma unroll
                for (int i = 0; i < 4; ++i) { const float v = s[mt][nt][i]; p[i] = v < -1.0e37f ? 0.f : __expf(v - mnew); rs += p[i]; }
                u32x2 pw; pw.x = cvt_pk_bf16(p[0], p[1]); pw.y = cvt_pk_bf16(p[2], p[3]);
                *(LAS u32x2*)(Ps + (16 * mt + fr) * 72 + 16 * nt + 4 * fq) = pw; }
            rs += __shfl_xor(rs, 16); rs += __shfl_xor(rs, 32);
            lrun[mt] = lrun[mt] * alpha + rs; mrun[mt] = mnew;
#pragma unroll
            for (int dt = 0; dt < 8; ++dt) o[mt][dt] = o[mt][dt] * alpha;
        }
        asm volatile("s_waitcnt lgkmcnt(0)" ::: "memory");
#pragma unroll
        for (int ks = 0; ks < 2; ++ks) { bf16x8 pf[2];
#pragma unroll
            for (int mt = 0; mt < 2; ++mt) pf[mt] = *(const LAS bf16x8*)(Ps + (16 * mt + fr) * 72 + 32 * ks + 8 * fq);
#pragma unroll
            for (int dt = 0; dt < 8; ++dt) { const bf16x8 vf = *(const LAS bf16x8*)(Vs + (16 * dt + fr) * 72 + 32 * ks + 8 * fq);
#pragma unroll
                for (int mt = 0; mt < 2; ++mt) o[mt][dt] = __builtin_amdgcn_mfma_f32_16x16x32_bf16(vf, pf[mt], o[mt][dt], 0, 0, 0); } }
    }
#pragma unroll
    for (int mt = 0; mt < 2; ++mt) { const float inv = 1.0f / lrun[mt]; bf16* orow = MIX + (size_t)(b * SEQ + qr0 + 16 * mt + fr) * D + hq * 128 + 4 * fq;
#pragma unroll
        for (int dt = 0; dt < 8; ++dt) { const f32x4 v = o[mt][dt] * inv; u32x2 wv; wv.x = cvt_pk_bf16(v[0], v[1]); wv.y = cvt_pk_bf16(v[2], v[3]); *(u32x2*)(orow + 16 * dt) = wv; } }
#undef ATT_LOAD
}

__device__ __forceinline__ int gla_row(int b, int dir, int tp) { return tp < CTXL ? TL + b * CTXL + (dir ? CTXL - 1 - tp : tp) : b * SEQ + (dir ? SEQ - 1 - (tp - CTXL) : tp - CTXL); }
__device__ __forceinline__ void gla_g1_all(Frame& F) {
    const bf16* PROJ = WSP(bf16, WS_PROJ);
    const int tid = F.tid, lane = F.lane, fr = lane & 15, fq = lane >> 4;
    LAS bf16* VTs = (LAS bf16*)F.lds;
    LAS float* LAs = (LAS float*)F.lds;
    LAS float* LRs = (LAS float*)(F.lds + 36864);
    LAS float* WAs = (LAS float*)(F.lds + 40960);
    LAS bf16* QFs = (LAS bf16*)(F.lds + 49152);
    LAS bf16* KFs = (LAS bf16*)(F.lds + 66560);
    LAS bf16* KLTs = (LAS bf16*)(F.lds + 83968);
    u32x4 pv[4], pq[2], pk[2]; unsigned short pl[2]; float pw[4], pba;
#define G1_LOAD(un) do { const int sidx_ = (un) / 36, c_ = (un) % 36, b_ = sidx_ >> 3, h_ = (sidx_ >> 1) & 3, dir_ = sidx_ & 1, tp0_ = c_ * 64; \
        const size_t rowl_ = (size_t)gla_row(b_, dir_, tp0_ + lane) * NPROJ; \
        _Pragma("unroll") for (int q = 0; q < 4; ++q) pv[q] = *(const u32x4*)(PROJ + rowl_ + C_GV + h_ * 256 + (F.wave + 8 * q) * 8); \
        _Pragma("unroll") for (int q = 0; q < 2; ++q) { pq[q] = *(const u32x4*)(PROJ + rowl_ + C_GQ + h_ * 128 + (F.wave + 8 * q) * 8); pk[q] = *(const u32x4*)(PROJ + rowl_ + C_GK + h_ * 128 + (F.wave + 8 * q) * 8); \
            const int i_ = tid + 512 * q; pl[q] = PROJ[(size_t)gla_row(b_, dir_, tp0_ + (i_ >> 4)) * NPROJ + C_LR + dir_ * 16 + (i_ & 15)]; } \
        _Pragma("unroll") for (int q = 0; q < 4; ++q) { const int i_ = tid + 512 * q; pw[q] = F.in[I_WA2][(dir_ * 16 + (i_ >> 7)) * 512 + h_ * 128 + (i_ & 127)]; } \
        pba = F.in[I_BA][dir_ * 512 + h_ * 128 + (tid & 127)]; } while (0)
    if ((int)blockIdx.x < 1152) G1_LOAD(blockIdx.x);
    for (int unit = blockIdx.x; unit < 1152; unit += F.G) {
        const int sidx = unit / 36, c = unit % 36, h = (sidx >> 1) & 3, dir = sidx & 1;
        bf16* QFg = WSP(bf16, WS_QF) + (size_t)unit * 64 * 128; bf16* KLTg = WSP(bf16, WS_KLT) + (size_t)unit * 128 * 64; bf16* ATTg = WSP(bf16, WS_ATT) + (size_t)unit * 64 * 64;
        bf16* VTg = WSP(bf16, WS_VT) + (size_t)unit * 256 * 64; float* DECg = WSP(float, WS_DEC) + (size_t)unit * 128;
#pragma unroll
        for (int q = 0; q < 4; ++q) { const int j = lane, sg = F.wave + 8 * q; const unsigned ww[4] = {pv[q].x, pv[q].y, pv[q].z, pv[q].w};
#pragma unroll
            for (int i = 0; i < 8; ++i) VTs[(sg * 8 + i) * 72 + j] = (bf16)((ww[i >> 1] >> ((i & 1) * 16)) & 0xffffu); }
#pragma unroll
        for (int q = 0; q < 2; ++q) LRs[tid + 512 * q] = bf2f(pl[q]);
#pragma unroll
        for (int q = 0; q < 4; ++q) WAs[tid + 512 * q] = pw[q];
        const float bav = pba;
        __syncthreads();
#pragma unroll
        for (int q = 0; q < 4; ++q) { const int piece = tid + 512 * q, e = piece >> 3, sg = piece & 7;
            *(u32x4*)(VTg + (size_t)e * 64 + sg * 8) = *(const LAS u32x4*)(VTs + e * 72 + sg * 8); }
        __syncthreads();
        { const int d = tid & 127, ig = tid >> 7; float wv[16];
#pragma unroll
          for (int r = 0; r < 16; ++r) wv[r] = WAs[r * 128 + d];
          float run = 0.f;
#pragma unroll 4
          for (int ii = 0; ii < 16; ++ii) { const int i = ig * 16 + ii; float z = bav;
#pragma unroll
              for (int r = 0; r < 16; ++r) z += LRs[i * 16 + r] * wv[r];
              const float ls = (fminf(z, 0.f) - __logf(1.0f + __expf(-fabsf(z)))) * (1.0f / 16.0f);
              run += ls; LAs[i * 132 + d] = run; }
          __syncthreads();
          float off = 0.f;
#pragma unroll
          for (int sgm = 0; sgm < 3; ++sgm) if (sgm < ig) off += LAs[(sgm * 16 + 15) * 132 + d];
          __syncthreads();
          if (ig > 0) {
#pragma unroll 4
              for (int ii = 0; ii < 16; ++ii) LAs[(ig * 16 + ii) * 132 + d] += off; }
          __syncthreads();
        }
#pragma unroll
        for (int q = 0; q < 2; ++q) { const int i = lane, sg = F.wave + 8 * q, d0 = sg * 8;
            const unsigned qa[4] = {pq[q].x, pq[q].y, pq[q].z, pq[q].w}, ka[4] = {pk[q].x, pk[q].y, pk[q].z, pk[q].w};
            float qf[8], kf[8], kl[8];
#pragma unroll
            for (int ii = 0; ii < 8; ++ii) { const float bc = LAs[i * 132 + d0 + ii], bl = LAs[63 * 132 + d0 + ii];
                const float qv = (ii & 1) ? __uint_as_float(qa[ii >> 1] & 0xffff0000u) : __uint_as_float(qa[ii >> 1] << 16);
                const float kv = (ii & 1) ? __uint_as_float(ka[ii >> 1] & 0xffff0000u) : __uint_as_float(ka[ii >> 1] << 16);
                const float e1 = __expf(bc);
                qf[ii] = qv * 0.08838834764831845f * e1; kf[ii] = kv * __builtin_amdgcn_rcpf(e1); kl[ii] = kv * __expf(bl - bc); }
            u32x4 qo, ko; qo.x = cvt_pk_bf16(qf[0], qf[1]); qo.y = cvt_pk_bf16(qf[2], qf[3]); qo.z = cvt_pk_bf16(qf[4], qf[5]); qo.w = cvt_pk_bf16(qf[6], qf[7]);
            ko.x = cvt_pk_bf16(kf[0], kf[1]); ko.y = cvt_pk_bf16(kf[2], kf[3]); ko.z = cvt_pk_bf16(kf[4], kf[5]); ko.w = cvt_pk_bf16(kf[6], kf[7]);
            *(LAS u32x4*)(QFs + i * 136 + d0) = qo; *(LAS u32x4*)(KFs + i * 136 + d0) = ko;
            if (c >= 4) *(u32x4*)(QFg + (size_t)i * 128 + d0) = qo;
#pragma unroll
            for (int ii = 0; ii < 8; ++ii) KLTs[(d0 + ii) * 72 + i] = (bf16)(cvt_pk_bf16(kl[ii], 0.f) & 0xffffu); }
        if (tid < 128) DECg[tid] = __expf(LAs[63 * 132 + tid]);
        if (unit + F.G < 1152) G1_LOAD(unit + F.G);
        __syncthreads();
        if (c >= 4) {
            const int it = F.wave >> 1;
#pragma unroll
            for (int jj = 0; jj < 2; ++jj) { const int jt = 2 * (F.wave & 1) + jj; f32x4 acc = (f32x4){0.f, 0.f, 0.f, 0.f};
#pragma unroll
                for (int ks = 0; ks < 4; ++ks) { const bf16x8 kfr = *(const LAS bf16x8*)(KFs + (16 * jt + fr) * 136 + 32 * ks + 8 * fq), qfr = *(const LAS bf16x8*)(QFs + (16 * it + fr) * 136 + 32 * ks + 8 * fq);
                    acc = __builtin_amdgcn_mfma_f32_16x16x32_bf16(kfr, qfr, acc, 0, 0, 0); }
                const int i = 16 * it + fr, j0 = 16 * jt + 4 * fq;
#pragma unroll
                for (int ii = 0; ii < 4; ++ii) if (j0 + ii > i) acc[ii] = 0.f;
                u32x2 w; w.x = cvt_pk_bf16(acc[0], acc[1]); w.y = cvt_pk_bf16(acc[2], acc[3]);
                *(u32x2*)(ATTg + (size_t)i * 64 + j0) = w; }
        }
#pragma unroll
        for (int q = 0; q < 2; ++q) { const int piece = tid + 512 * q, d = piece >> 3, sg = piece & 7;
            *(u32x4*)(KLTg + (size_t)d * 64 + sg * 8) = *(const LAS u32x4*)(KLTs + d * 72 + sg * 8); }
        __syncthreads();
    }
#undef G1_LOAD
}
__device__ __forceinline__ void gla_g2(Frame& F, int blk) {
    const int sidx = blk >> 2, sl = blk & 3, b = sidx >> 3, h = (sidx >> 1) & 3, dir = sidx & 1, tid = F.tid, lane = F.lane, fr = lane & 15, fq = lane >> 4, w = F.wave;
    bf16* OG = WSP(bf16, WS_OG);
    LAS bf16* QFs = (LAS bf16*)F.lds;
    LAS bf16* ATs = (LAS bf16*)(F.lds + 17408);
    LAS bf16* VTs = (LAS bf16*)(F.lds + 26624);
    LAS bf16* KLTs = (LAS bf16*)(F.lds + 35840);
    LAS float* DECs = (LAS float*)(F.lds + 54272);
    LAS bf16* STs = (LAS bf16*)(F.lds + 54784);
    const int et_s = w >> 1, dt0 = 4 * (w & 1);
    const int it_o = w >> 1, et0 = 2 * (w & 1);
    f32x4 Sacc[4];
#pragma unroll
    for (int i = 0; i < 4; ++i) Sacc[i] = (f32x4){0.f, 0.f, 0.f, 0.f};
    u32x4 rq[2], rk[2], ra, rv; f32x4 rd;
    rq[0] = rq[1] = ra = (u32x4){0u, 0u, 0u, 0u}; rd = (f32x4){0.f, 0.f, 0.f, 0.f};
#define G2_LOAD(cc) do { const size_t un = (size_t)sidx * 36 + (cc); \
        const bf16* kg = WSP(bf16, WS_KLT) + un * 128 * 64; const bf16* vg = WSP(bf16, WS_VT) + un * 256 * 64 + (size_t)sl * 64 * 64; \
        rk[0] = *(const u32x4*)(kg + (size_t)tid * 8); rk[1] = *(const u32x4*)(kg + (size_t)(tid + 512) * 8); rv = *(const u32x4*)(vg + (size_t)tid * 8); \
        if (tid < 32) rd = *(const f32x4*)(WSP(float, WS_DEC) + un * 128 + tid * 4); \
        if ((cc) >= 4) { const bf16* qg = WSP(bf16, WS_QF) + un * 64 * 128; const bf16* ag = WSP(bf16, WS_ATT) + un * 64 * 64; \
            rq[0] = *(const u32x4*)(qg + (size_t)tid * 8); rq[1] = *(const u32x4*)(qg + (size_t)(tid + 512) * 8); ra = *(const u32x4*)(ag + (size_t)tid * 8); } } while (0)
#define G2_STORE() do { \
        { const int d = tid >> 3, sg = tid & 7; *(LAS u32x4*)(KLTs + d * 72 + sg * 8) = rk[0]; *(LAS u32x4*)(KLTs + (d + 64) * 72 + sg * 8) = rk[1]; \
          *(LAS u32x4*)(VTs + d * 72 + sg * 8) = rv; *(LAS u32x4*)(ATs + d * 72 + sg * 8) = ra; } \
        { const int i = tid >> 4, sg = tid & 15; *(LAS u32x4*)(QFs + i * 136 + sg * 8) = rq[0]; *(LAS u32x4*)(QFs + (i + 32) * 136 + sg * 8) = rq[1]; } \
        if (tid < 32) *(LAS f32x4*)(DECs + tid * 4) = rd; } while (0)
    __syncthreads();
    G2_LOAD(0); G2_STORE();
    for (int i = tid; i < 64 * 136 / 2; i += 512) ((LAS unsigned*)STs)[i] = 0u;
    __syncthreads();
    for (int c = 0; c < 36; ++c) {
        if (c + 1 < 36) G2_LOAD(c + 1);
        if (c >= 4) {
#pragma unroll
            for (int ee = 0; ee < 2; ++ee) { const int et = et0 + ee; f32x4 acc = (f32x4){0.f, 0.f, 0.f, 0.f};
#pragma unroll
                for (int ks = 0; ks < 2; ++ks) acc = __builtin_amdgcn_mfma_f32_16x16x32_bf16(*(const LAS bf16x8*)(VTs + (16 * et + fr) * 72 + 32 * ks + 8 * fq), *(const LAS bf16x8*)(ATs + (16 * it_o + fr) * 72 + 32 * ks + 8 * fq), acc, 0, 0, 0);
#pragma unroll
                for (int ks = 0; ks < 4; ++ks) acc = __builtin_amdgcn_mfma_f32_16x16x32_bf16(*(const LAS bf16x8*)(STs + (16 * et + fr) * 136 + 32 * ks + 8 * fq), *(const LAS bf16x8*)(QFs + (16 * it_o + fr) * 136 + 32 * ks + 8 * fq), acc, 0, 0, 0);
                const int tp = c * 64 + 16 * it_o + fr, lrow = b * SEQ + (dir ? SEQ - 1 - (tp - CTXL) : tp - CTXL);
                *(u32x2*)(OG + ((size_t)dir * TL + lrow) * 1024 + h * 256 + sl * 64 + 16 * et + 4 * fq) = (mfma_settle(acc), f32_to_bf4(acc)); }
        }
#pragma unroll
        for (int dd = 0; dd < 4; ++dd) { const int dt = dt0 + dd; const f32x4 dec = *(const LAS f32x4*)(DECs + 16 * dt + 4 * fq);
            f32x4 acc = Sacc[dd] * dec;
#pragma unroll
            for (int ks = 0; ks < 2; ++ks) acc = __builtin_amdgcn_mfma_f32_16x16x32_bf16(*(const LAS bf16x8*)(KLTs + (16 * dt + fr) * 72 + 32 * ks + 8 * fq), *(const LAS bf16x8*)(VTs + (16 * et_s + fr) * 72 + 32 * ks + 8 * fq), acc, 0, 0, 0);
            Sacc[dd] = acc; }
        __syncthreads();
#pragma unroll
        for (int dd = 0; dd < 4; ++dd) { mfma_settle(Sacc[dd]); u32x2 wv; wv.x = cvt_pk_bf16(Sacc[dd][0], Sacc[dd][1]); wv.y = cvt_pk_bf16(Sacc[dd][2], Sacc[dd][3]);
            *(LAS u32x2*)(STs + (16 * et_s + fr) * 136 + 16 * (dt0 + dd) + 4 * fq) = wv; }
        if (c + 1 < 36) G2_STORE();
        __syncthreads();
    }
#undef G2_LOAD
#undef G2_STORE
}

__device__ __forceinline__ void phase_gla_out(Frame& F) {
    const int gw = blockIdx.x * 8 + F.wave, NGW = F.G * 8, lane = F.lane;
    const bf16* OG = WSP(bf16, WS_OG); const bf16* PROJ = WSP(bf16, WS_PROJ); bf16* MIX = WSP(bf16, WS_MIX);
    const f32x4 gn = *(const f32x4*)(F.in[I_GN] + 4 * lane);
    for (int row = gw; row < TL; row += NGW) {
#pragma unroll
        for (int h = 0; h < 4; ++h) {
            const f32x4 of = bf4_to_f32(*(const u32x2*)(OG + (size_t)row * 1024 + h * 256 + 4 * lane)), ob = bf4_to_f32(*(const u32x2*)(OG + ((size_t)TL + row) * 1024 + h * 256 + 4 * lane));
            const f32x4 ov = of + ob;
            const float rstd = 1.0f / sqrtf(wave_sum((ov[0] * ov[0] + ov[1] * ov[1]) + (ov[2] * ov[2] + ov[3] * ov[3])) * (1.0f / 256.0f) + EPS);
            const u32x2 gw2 = *(const u32x2*)(PROJ + (size_t)row * NPROJ + C_GG + h * 256 + 4 * lane);
            const float g0 = __uint_as_float(gw2.x << 16), g1 = __uint_as_float(gw2.x & 0xffff0000u), g2 = __uint_as_float(gw2.y << 16), g3 = __uint_as_float(gw2.y & 0xffff0000u);
            const float y0 = ov[0] * rstd * gn[0] * silu_f(g0), y1 = ov[1] * rstd * gn[1] * silu_f(g1), y2 = ov[2] * rstd * gn[2] * silu_f(g2), y3 = ov[3] * rstd * gn[3] * silu_f(g3);
            u32x2 wv; wv.x = cvt_pk_bf16(y0, y1); wv.y = cvt_pk_bf16(y2, y3);
            *(u32x2*)(MIX + (size_t)row * D + 1024 + h * 256 + 4 * lane) = wv;
        }
    }
}

__device__ __forceinline__ void phase_route(Frame& F, int layer, const bf16* xin) {
    const int lane = F.lane, w = F.wave, fr = lane & 15, fq = lane >> 4;
    const float* MOD = WSP(float, WS_MOD) + (size_t)layer * 5 * 12288; bf16* HA = WSP(bf16, WS_HA);
    unsigned* route = WSP(unsigned, WS_ROUTE) + (size_t)layer * TL * 8; int* list = WSP(int, WS_LIST) + (size_t)layer * 32 * 8192;
    unsigned* cnt = WSP(unsigned, WS_CTL) + CW_CNT + layer * 32 * 64;
    const float* rb = F.in[I_RB];
    LAS unsigned char* XS = F.lds; LAS unsigned char* HI0 = F.lds + LDS_TOK + 4096;
    LAS float* RS = (LAS float*)HI0;
    LAS unsigned* LCNT = (LAS unsigned*)(HI0 + 128); LAS unsigned* LBASE = (LAS unsigned*)(HI0 + 256); LAS float* RBL = (LAS float*)(HI0 + 384);
    LAS float* LOG = (LAS float*)(HI0 + 512);
    LAS float* PART = (LAS float*)F.lds;
    for (int it = 0; it * F.G * 32 < TL; ++it) {
        const int row0b = (it * F.G + (int)blockIdx.x) * 32;
        if (row0b >= TL) break;
        const int b = row0b / SEQ; const float* shift = MOD + (size_t)b * 12288 + 3 * 2048; const float* scale = MOD + (size_t)b * 12288 + 4 * 2048;
        const bf16* RH = WSP(bf16, WS_RWT_HI) + ((size_t)((layer * 4 + b) * 8 + w) * 1024 + lane) * 8; const bf16* RL = WSP(bf16, WS_RWT_LO) + ((size_t)((layer * 4 + b) * 8 + w) * 1024 + lane) * 8;
        __syncthreads();
        if (F.tid < 32) { LCNT[F.tid] = 0u; const float* bp = WSP(float, WS_RBIAS) + (size_t)(layer * 4 + b) * 16 * 32 + F.tid; float t = 0.f;
#pragma unroll
            for (int p = 0; p < 16; ++p) t += bp[p * 32];
            RBL[F.tid] = t; }
        bf16x8 bh[8][2], bl[8][2];
        { u32x4 v[4][4];
#pragma unroll
          for (int k = 0; k < 4; ++k)
#pragma unroll
              for (int j = 0; j < 4; ++j) v[k][j] = *(const u32x4*)(xin + (size_t)(row0b + 4 * w + k) * D + 8 * (64 * j + lane));
#pragma unroll
          for (int ks = 0; ks < 4; ++ks)
#pragma unroll
              for (int nt = 0; nt < 2; ++nt) { bh[ks][nt] = *(const bf16x8*)(RH + (size_t)(ks * 2 + nt) * 512); bl[ks][nt] = *(const bf16x8*)(RL + (size_t)(ks * 2 + nt) * 512); }
#pragma unroll
          for (int k = 0; k < 4; ++k)
#pragma unroll
              for (int j = 0; j < 4; ++j) { const int rr = 4 * w + k; *(LAS u32x4*)(XS + rr * 4096 + 16 * ((64 * j + lane) ^ (rr & 15))) = v[k][j]; }
#pragma unroll
          for (int k = 0; k < 4; ++k) { float ss = 0.f; f32x4 xa[4][2];
#pragma unroll
              for (int j = 0; j < 4; ++j) { u32x2 lo2, hi2; lo2.x = v[k][j].x; lo2.y = v[k][j].y; hi2.x = v[k][j].z; hi2.y = v[k][j].w; xa[j][0] = bf4_to_f32(lo2); xa[j][1] = bf4_to_f32(hi2);
#pragma unroll
                  for (int q = 0; q < 2; ++q) ss += (xa[j][q][0] * xa[j][q][0] + xa[j][q][1] * xa[j][q][1]) + (xa[j][q][2] * xa[j][q][2] + xa[j][q][3] * xa[j][q][3]); }
              const float rsk = 1.0f / sqrtf(wave_sum(ss) * (1.0f / D) + EPS);
              if (lane == 0) RS[4 * w + k] = rsk;
#pragma unroll
              for (int j = 0; j < 4; ++j) { const int c = 8 * (64 * j + lane); u32x4 o;
#pragma unroll
                  for (int q = 0; q < 2; ++q) { const f32x4 sh = *(const f32x4*)(shift + c + 4 * q), sc = *(const f32x4*)(scale + c + 4 * q);
                      const f32x4 y = xa[j][q] * rsk * (sc + 1.0f) + sh; const u32x2 p = f32_to_bf4(y); if (q == 0) { o.x = p.x; o.y = p.y; } else { o.z = p.x; o.w = p.y; } }
                  *(u32x4*)(HA + (size_t)(row0b + 4 * w + k) * D + c) = o; } } }
#pragma unroll
        for (int ks = 4; ks < 8; ++ks)
#pragma unroll
            for (int nt = 0; nt < 2; ++nt) { bh[ks][nt] = *(const bf16x8*)(RH + (size_t)(ks * 2 + nt) * 512); bl[ks][nt] = *(const bf16x8*)(RL + (size_t)(ks * 2 + nt) * 512); }
        asm volatile("s_waitcnt lgkmcnt(0)" ::: "memory"); __builtin_amdgcn_s_barrier(); asm volatile("" ::: "memory");
        { f32x4 acc[2][2];
#pragma unroll
          for (int mt = 0; mt < 2; ++mt)
#pragma unroll
              for (int nt = 0; nt < 2; ++nt) acc[mt][nt] = (f32x4){0.f, 0.f, 0.f, 0.f};
#pragma unroll
          for (int ks = 0; ks < 8; ++ks) {
              bf16x8 ax[2];
#pragma unroll
              for (int mt = 0; mt < 2; ++mt) ax[mt] = *(const LAS bf16x8*)(XS + (16 * mt + fr) * 4096 + 16 * ((32 * w + 4 * ks + fq) ^ fr));
#pragma unroll
              for (int nt = 0; nt < 2; ++nt)
#pragma unroll
                  for (int mt = 0; mt < 2; ++mt) { acc[mt][nt] = __builtin_amdgcn_mfma_f32_16x16x32_bf16(bh[ks][nt], ax[mt], acc[mt][nt], 0, 0, 0);
                      acc[mt][nt] = __builtin_amdgcn_mfma_f32_16x16x32_bf16(bl[ks][nt], ax[mt], acc[mt][nt], 0, 0, 0); } }
          asm volatile("s_waitcnt lgkmcnt(0)" ::: "memory"); __builtin_amdgcn_s_barrier(); asm volatile("" ::: "memory");
#pragma unroll
          for (int mt = 0; mt < 2; ++mt)
#pragma unroll
              for (int nt = 0; nt < 2; ++nt) *(LAS f32x4*)(PART + (w * 32 + 16 * mt + fr) * 32 + 16 * nt + 4 * fq) = acc[mt][nt]; }
        __syncthreads();
#pragma unroll
        for (int q = 0; q < 2; ++q) { const int o = F.tid + 512 * q; float sum = 0.f;
#pragma unroll
            for (int ww = 0; ww < 8; ++ww) sum += PART[ww * 1024 + o];
            LOG[o] = RS[o >> 5] * sum + RBL[o & 31]; }
        __syncthreads();
        int i1s[4], i2s[4]; float a1s[4], a2s[4];
#pragma unroll
        for (int k = 0; k < 4; ++k) {
            const float mylg = LOG[(4 * w + k) * 32 + (lane & 31)];
            const float myscore = 1.0f / (1.0f + expf(-mylg)), mybias = myscore + rb[lane & 31];
            float m1 = -3.0e38f, m2 = -3.0e38f, w1 = 0.f, w2 = 0.f; int i1 = 0, i2 = 0;
            const int gbase = lane & 24;
#pragma unroll
            for (int i = 0; i < 8; ++i) { const float x = __shfl(mybias, gbase + i), sx = __shfl(myscore, gbase + i);
                if (x > m1) { m2 = m1; i2 = i1; w2 = w1; m1 = x; i1 = i; w1 = sx; } else if (x > m2) { m2 = x; i2 = i; w2 = sx; } }
            const float gs = m1 + m2;
            int gsel = 0; float gbest = __shfl(gs, 0);
#pragma unroll
            for (int g = 1; g < 4; ++g) { const float x = __shfl(gs, 8 * g); if (x > gbest) { gbest = x; gsel = g; } }
            i1 = __shfl(i1, 8 * gsel) + 8 * gsel; i2 = __shfl(i2, 8 * gsel) + 8 * gsel; w1 = __shfl(w1, 8 * gsel); w2 = __shfl(w2, 8 * gsel);
            const float wsum = w1 + w2; i1s[k] = i1; i2s[k] = i2; a1s[k] = w1 / wsum; a2s[k] = w2 / wsum;
        }
        { const int tk = (lane >> 1) & 3, ch = lane & 1;
          int e1 = i1s[0], e2 = i2s[0]; float q1 = a1s[0], q2 = a2s[0];
#pragma unroll
          for (int k = 1; k < 4; ++k) { e1 = (tk == k) ? i1s[k] : e1; e2 = (tk == k) ? i2s[k] : e2; q1 = (tk == k) ? a1s[k] : q1; q2 = (tk == k) ? a2s[k] : q2; }
          const int e = ch ? e2 : e1; const int row = row0b + 4 * w + tk;
          unsigned pos = 0u;
          if (lane < 8) pos = __hip_atomic_fetch_add(LCNT + e, 1u, __ATOMIC_RELAXED, __HIP_MEMORY_SCOPE_WORKGROUP);
          __syncthreads();
          if (F.tid < 32) { const unsigned n = LCNT[F.tid]; LBASE[F.tid] = n ? atomicAdd(cnt + F.tid * 64, n) : 0u; }
          __syncthreads();
          if (lane < 8) { pos += LBASE[e]; list[e * 8192 + pos] = row; }
          const unsigned pa = __shfl(pos, lane & ~1), pb2 = __shfl(pos, lane | 1);
          if (lane < 8 && ch == 0) { u32x4 r0; r0.x = (unsigned)e1; r0.y = (unsigned)e2; r0.z = pa; r0.w = pb2; *(u32x4*)(route + (size_t)row * 8) = r0;
              u32x2 r1; r1.x = __float_as_uint(q1); r1.y = __float_as_uint(q2); *(u32x2*)(route + (size_t)row * 8 + 4) = r1; } }
    }
}
__device__ __forceinline__ void moe_setup(Frame& F, int layer, bool want_tok, int nN) {
    LAS int* pb = (LAS int*)(F.lds + LDS_PB); LAS int* tokt = (LAS int*)(F.lds + LDS_TOK);
    const unsigned* cnt = WSP(unsigned, WS_CTL) + CW_CNT + layer * 32 * 64; const int* list = WSP(int, WS_LIST) + (size_t)layer * 32 * 8192;
    if (F.tid == 0) { int s = 0; for (int e = 0; e < 32; ++e) { pb[e] = s; s += ((int)cnt[e * 64] + 255) >> 8; } pb[32] = s; }
    __syncthreads();
    if (want_tok) {
        pg8::MoeOrder<true> S; S.pb = pb; S.tokt = tokt; S.G = F.G; S.c = F.vcu; S.nN = nN; S.estride = 0;
        for (int i = 0; i < 4; ++i) { pg8::Unit u; if (!S.next(i, u)) break;
            if (F.tid < 256) { const int pos = (u.pm - pb[u.e]) * 256 + F.tid; const int n = (int)cnt[u.e * 64]; tokt[i * 256 + F.tid] = pos < n ? list[u.e * 8192 + pos] : 0; } }
        __syncthreads();
    }
}
struct CombRow { u32x2 ya[8], yb[8], xi[8]; float w0, w1; };
struct CombRoute { u32x4 r0; u32x2 r1; };
__device__ __forceinline__ CombRoute comb_route(const unsigned* route, int row) { CombRoute r; r.r0 = *(const u32x4*)(route + (size_t)row * 8); r.r1 = *(const u32x2*)(route + (size_t)row * 8 + 4); return r; }
__device__ __forceinline__ void comb_issue(CombRow& R, const CombRoute& rt, const LAS int* pb, const bf16* Y, const bf16* xin, int row, int lane) {
    const size_t s0 = (size_t)pb[rt.r0.x] * 256 + rt.r0.z, s1 = (size_t)pb[rt.r0.y] * 256 + rt.r0.w; R.w0 = __uint_as_float(rt.r1.x); R.w1 = __uint_as_float(rt.r1.y);
#pragma unroll
    for (int j = 0; j < 8; ++j) { const int c = 4 * (64 * j + lane);
        R.ya[j] = *(const u32x2*)(Y + s0 * D + c); R.yb[j] = *(const u32x2*)(Y + s1 * D + c); R.xi[j] = *(const u32x2*)(xin + (size_t)row * D + c); }
}
template <class TO> __device__ __forceinline__ void comb_finish(const CombRow& R, const float* gate, TO* xout, bool next_mod, const float* modn, bf16* HA, int row, int lane) {
    f32x4 v[8]; const float w0 = R.w0, w1 = R.w1;
#pragma unroll
    for (int j = 0; j < 8; ++j) { const int c = 4 * (64 * j + lane); const u32x2 ya = R.ya[j], yb = R.yb[j];
        f32x4 y; y[0] = w0 * __uint_as_float(ya.x << 16) + w1 * __uint_as_float(yb.x << 16); y[1] = w0 * __uint_as_float(ya.x & 0xffff0000u) + w1 * __uint_as_float(yb.x & 0xffff0000u);
        y[2] = w0 * __uint_as_float(ya.y << 16) + w1 * __uint_as_float(yb.y << 16); y[3] = w0 * __uint_as_float(ya.y & 0xffff0000u) + w1 * __uint_as_float(yb.y & 0xffff0000u);
        const f32x4 xi = bf4_to_f32(R.xi[j]), g = *(const f32x4*)(gate + c);
        v[j] = xi + g * y;
        if constexpr (sizeof(TO) == 4) *(f32x4*)((float*)xout + (size_t)row * D + c) = v[j]; else *(u32x2*)((bf16*)xout + (size_t)row * D + c) = f32_to_bf4(v[j]); }
    if (next_mod) modulate_store(v, modn, modn + 2048, HA + (size_t)row * D, lane);
}
template <class TO> __device__ __forceinline__ void phase_combine(Frame& F, int layer, const bf16* xin, TO* xout, bool next_mod) {
    const int gw = blockIdx.x * 8 + F.wave, NGW = F.G * 8, lane = F.lane;
    const float* MOD = WSP(float, WS_MOD) + (size_t)layer * 5 * 12288; const float* MODN = WSP(float, WS_MOD) + (size_t)(layer + 1) * 5 * 12288;
    const unsigned* route = WSP(unsigned, WS_ROUTE) + (size_t)layer * TL * 8; const bf16* Y = WSP(bf16, WS_Y); bf16* HA = WSP(bf16, WS_HA);
    const LAS int* pb = (const LAS int*)(F.lds + LDS_PB);
    if (gw >= TL) return;
    CombRoute ra = comb_route(route, gw), rb = comb_route(route, min(gw + NGW, TL - 1));
    for (int row = gw; row < TL; row += 2 * NGW) {
        const int rowA = row, rowB = row + NGW; const bool hasB = rowB < TL; const int rB = hasB ? rowB : rowA;
        CombRow A, B;
        comb_issue(A, ra, pb, Y, xin, rowA, lane);
        comb_issue(B, hasB ? rb : ra, pb, Y, xin, rB, lane);
        ra = comb_route(route, min(row + 2 * NGW, TL - 1)); rb = comb_route(route, min(row + 3 * NGW, TL - 1));
        const int bA = rowA / SEQ, bB = rB / SEQ;
        comb_finish<TO>(A, MOD + (size_t)bA * 12288 + 5 * 2048, xout, next_mod, MODN + (size_t)bA * 12288, HA, rowA, lane);
        if (hasB) comb_finish<TO>(B, MOD + (size_t)bB * 12288 + 5 * 2048, xout, next_mod, MODN + (size_t)bB * 12288, HA, rowB, lane);
    }
}
__device__ __forceinline__ void phase_conv(Frame& F) {
    const bf16* GB = WSP(bf16, WS_GB); const bf16* P = WSP(bf16, WS_PGU); bf16* Z = WSP(bf16, WS_Z); const float* cw = F.in[I_CW];
    const size_t total = (size_t)TL * D / 8;
    for (size_t i = (size_t)blockIdx.x * 512 + F.tid; i < total; i += (size_t)F.G * 512) {
        const int row = (int)(i >> 8), c = (int)(i & 255) * 8, t = row % SEQ;
        const u32x4 pc = *(const u32x4*)(P + (size_t)row * D + c), gb = *(const u32x4*)(GB + (size_t)row * D + c);
        u32x4 pm = (u32x4){0u, 0u, 0u, 0u}, pp = (u32x4){0u, 0u, 0u, 0u};
        if (t > 0) pm = *(const u32x4*)(P + (size_t)(row - 1) * D + c);
        if (t < SEQ - 1) pp = *(const u32x4*)(P + (size_t)(row + 1) * D + c);
        const unsigned am[4] = {pm.x, pm.y, pm.z, pm.w}, ac[4] = {pc.x, pc.y, pc.z, pc.w}, ap[4] = {pp.x, pp.y, pp.z, pp.w}, ag[4] = {gb.x, gb.y, gb.z, gb.w};
        unsigned ow[4];
#pragma unroll
        for (int q = 0; q < 4; ++q) { float r[2];
#pragma unroll
            for (int hh = 0; hh < 2; ++hh) { const int cc = c + 2 * q + hh;
                const float vm = hh ? __uint_as_float(am[q] & 0xffff0000u) : __uint_as_float(am[q] << 16), vc = hh ? __uint_as_float(ac[q] & 0xffff0000u) : __uint_as_float(ac[q] << 16);
                const float vp = hh ? __uint_as_float(ap[q] & 0xffff0000u) : __uint_as_float(ap[q] << 16), vg = hh ? __uint_as_float(ag[q] & 0xffff0000u) : __uint_as_float(ag[q] << 16);
                r[hh] = vg * (cw[cc] * vm + cw[2048 + cc] * vc + cw[4096 + cc] * vp); }
            ow[q] = cvt_pk_bf16(r[0], r[1]); }
        u32x4 o; o.x = ow[0]; o.y = ow[1]; o.z = ow[2]; o.w = ow[3];
        *(u32x4*)(Z + (size_t)row * D + c) = o;
    }
}

constexpr int NPHASE = 18;
__global__ void __launch_bounds__(512, 2) fwd_kernel(Args args) {
    extern __shared__ __attribute__((aligned(16))) unsigned char lds_raw[];
    Frame F;
    F.lds = (LAS unsigned char*)lds_raw; F.out = args.out; F.ws = args.ws;
#pragma unroll
    for (int i = 0; i < 22; ++i) F.in[i] = args.in[i];
    F.tid = threadIdx.x; F.lane = F.tid & 63; F.wave = __builtin_amdgcn_readfirstlane(F.tid >> 6); F.G = gridDim.x;
    { const int bx = blockIdx.x; F.vcu = (F.G % 8 == 0) ? (bx % 8) * (F.G / 8) + bx / 8 : bx; }
    volatile LAS unsigned* MISC = (volatile LAS unsigned*)(F.lds + LDS_MISC);
    if (F.tid < 64) MISC[F.tid] = 0u;
    __syncthreads();
    const int lo = args.ph_lo, hi = args.ph_hi;
    XcdBarrier bar; bar.bar = WSP(unsigned, WS_CTL) + CW_BAR; bar.x = 0; bar.st = nullptr;
    if (hi - lo > 1) bar = xcd_barrier_post(WSP(unsigned, WS_CTL) + CW_BAR, MISC + 8);
#ifndef PH_MASK
#define PH_MASK 0xFFFFFFFFu
#endif
#define IN(k) (((PH_MASK >> (k)) & 1u) && lo <= (k) && (k) < hi)
#define SEAM(k) do { if (IN(k) && IN((k) + 1)) xcd_barrier(bar); } while (0)
    const float* MOD = WSP(float, WS_MOD);

    if (IN(0)) { phase0(F); } SEAM(0);
    if (IN(1)) { phase_modulate0(F); } SEAM(1);
    if (IN(2)) {
        pg8::Gemm g{WSP(bf16, WS_HA), WSP(bf16, WS_WIN_T), D}; pg8::StaticOrder S; S.init(TA, NPROJ, F.G, (int)blockIdx.x);
        pg8::EpiBf16 E{WSP(bf16, WS_PROJ), NPROJ};
        const int grp = F.vcu & 3;
        pg8::StaticOrder Sa; Sa.init(TA, NPROJ, F.G, (int)blockIdx.x); Sa.ilo = 0; Sa.ihi = grp;
        pg8::StaticOrder Sb; Sb.init(TA, NPROJ, F.G, (int)blockIdx.x); Sb.ilo = grp; Sb.ihi = 1 << 30;
        pg8::gemm_phase<pg8::EpiBf16, pg8::StaticOrder, true>(F.lds, g, Sa, E);
        convert_claim(F, 30, 0);
        pg8::gemm_phase<pg8::EpiBf16, pg8::StaticOrder, true>(F.lds, g, Sb, E);
        if (2L * F.G + (long)blockIdx.x >= (long)(TA / 256) * (NPROJ / 256)) convert_claim(F, 18, 0);
    } SEAM(2);
    if (IN(3)) { phase_prep(F); gla_g1_all(F); } SEAM(3);
    if (IN(4)) {
        if (blockIdx.x < 128) { gla_g2(F, blockIdx.x); convert_claim(F, 6, 0); }
        else { const int st = F.G > 129 ? F.G - 128 : 1; for (int u = blockIdx.x - 128; u < 256; u += st) attn_unit(F, u); }
    } SEAM(4);
    if (IN(5)) { phase_gla_out(F); } SEAM(5);
    if (IN(6)) {
        pg8::Gemm g{WSP(bf16, WS_MIX), WSP(bf16, WS_WOUT_T), D}; pg8::StaticOrder S; S.init(TL, D, F.G, (int)blockIdx.x);
        pg8::EpiResGate<false> E{F.in[I_X], WSP(bf16, WS_X1), MOD + 2 * 2048, 12288};
        if ((F.vcu & 1) == 0) convert_claim(F, 12, 0);
        pg8::gemm_phase<pg8::EpiResGate<false>, pg8::StaticOrder, false>(F.lds, g, S, E);
        convert_claim(F, 0, CV_B0);
    } SEAM(6);
#define MOE_PHASES(layer, pbase, xin, xout, nextmod) \
    if (IN(pbase)) { phase_route(F, layer, xin); } SEAM(pbase); \
    if (IN((pbase) + 1)) { \
        moe_setup(F, layer, true, 8); \
        pg8::Gemm g{WSP(bf16, WS_HA), WSP(bf16, WS_W13_T) + (size_t)(layer) * 32 * 2048 * 2048, D}; \
        pg8::MoeOrder<true> S; S.pb = (const LAS int*)(F.lds + LDS_PB); S.tokt = (const LAS int*)(F.lds + LDS_TOK); S.G = F.G; S.c = F.vcu; S.nN = 8; S.estride = (size_t)2048 * 2048 * 2; \
        pg8::EpiPair<true> E{WSP(bf16, WS_HMID), DEXP, 0, nullptr, 0}; \
        pg8::gemm_phase<pg8::EpiPair<true>, pg8::MoeOrder<true>, true>(F.lds, g, S, E); \
        { const int tot = S.pb[32] * 8, mx = (tot + F.G - 1) / F.G, mine = tot > F.vcu ? (tot - F.vcu + F.G - 1) / F.G : 0; convert_claim(F, mine < mx ? 12 : 0, (layer) == 0 ? CV_B1 : CV_B3); } \
    } SEAM((pbase) + 1); \
    if (IN((pbase) + 2)) { \
        moe_setup(F, layer, false, 8); \
        pg8::Gemm g{WSP(bf16, WS_HMID), WSP(bf16, WS_W2_T) + (size_t)(layer) * 32 * 2048 * 1024, DEXP}; \
        pg8::MoeOrder<false> S; S.pb = (const LAS int*)(F.lds + LDS_PB); S.tokt = nullptr; S.G = F.G; S.c = F.vcu; S.nN = 8; S.estride = (size_t)2048 * 1024 * 2; \
        pg8::EpiBf16 E{WSP(bf16, WS_Y), D}; \
        pg8::gemm_phase<pg8::EpiBf16, pg8::MoeOrder<false>, true>(F.lds, g, S, E); \
        if ((layer) == 0) { const int tot = S.pb[32] * 8, mx = (tot + F.G - 1) / F.G, mine = tot > F.vcu ? (tot - F.vcu + F.G - 1) / F.G : 0; if (mine < mx) convert_claim(F, 6, 0); } \
    } SEAM((pbase) + 2); \
    if (IN((pbase) + 3)) { moe_setup(F, layer, false, 8); phase_combine(F, layer, xin, xout, nextmod); }

    MOE_PHASES(0, 7, WSP(bf16, WS_X1), WSP(bf16, WS_X2), true)
    SEAM(10);
    if (IN(11)) {
        pg8::Gemm g{WSP(bf16, WS_HA), WSP(bf16, WS_CIN_T), D}; pg8::StaticOrder S; S.init(TL, 6144, F.G, (int)blockIdx.x);
        pg8::EpiPair<false> E{WSP(bf16, WS_PGU), D, 8, WSP(bf16, WS_GB), D};
        const int grp = F.vcu & 3;
        pg8::StaticOrder Sa; Sa.init(TL, 6144, F.G, (int)blockIdx.x); Sa.ilo = 0; Sa.ihi = grp;
        pg8::StaticOrder Sb; Sb.init(TL, 6144, F.G, (int)blockIdx.x); Sb.ilo = grp; Sb.ihi = 1 << 30;
        pg8::gemm_phase<pg8::EpiPair<false>, pg8::StaticOrder, true>(F.lds, g, Sa, E);
        convert_claim(F, 30, 0);
        pg8::gemm_phase<pg8::EpiPair<false>, pg8::StaticOrder, true>(F.lds, g, Sb, E);
    } SEAM(11);
    if (IN(12)) { phase_conv(F); } SEAM(12);
    if (IN(13)) {
        pg8::Gemm g{WSP(bf16, WS_Z), WSP(bf16, WS_COUT_T), D}; pg8::StaticOrder S; S.init(TL, D, F.G, (int)blockIdx.x);
        pg8::EpiResGate<true> E{WSP(bf16, WS_X2), WSP(bf16, WS_X3), MOD + 5 * 12288 + 2 * 2048, 12288};
        if ((F.vcu & 1) == 0) convert_claim(F, 12, 0);
        pg8::gemm_phase<pg8::EpiResGate<true>, pg8::StaticOrder, false>(F.lds, g, S, E);
        convert_claim(F, 0, CV_B2);
    } SEAM(13);
    MOE_PHASES(1, 14, WSP(bf16, WS_X3), F.out, false)
#undef MOE_PHASES
#undef IN
#undef SEAM
}

extern "C" void kernel_launch(void* const* d_in, const int* in_sizes, int n_in, void* d_out, int out_size, void* d_ws, size_t ws_size, hipStream_t stream) {
    static int grid = 0;
    if (grid == 0) {
        if (n_in != 22 || out_size != TL * D || ws_size < WS_END) { fprintf(stderr, "kernel_launch: unexpected problem (n_in %d, out %d, ws %zu < %zu)\n", n_in, out_size, ws_size, (size_t)WS_END); grid = -1; return; }
        int dev = 0, cus = 0, per_cu = 0;
        if (hipGetDevice(&dev) != hipSuccess || hipDeviceGetAttribute(&cus, hipDeviceAttributeMultiprocessorCount, dev) != hipSuccess) { grid = -1; return; }
        if (hipFuncSetAttribute((const void*)fwd_kernel, hipFuncAttributeMaxDynamicSharedMemorySize, LDS_BYTES) != hipSuccess) { fprintf(stderr, "kernel_launch: hipFuncSetAttribute failed\n"); grid = -1; return; }
        if (hipOccupancyMaxActiveBlocksPerMultiprocessor(&per_cu, (const void*)fwd_kernel, 512, LDS_BYTES) != hipSuccess || per_cu < 1) { fprintf(stderr, "kernel_launch: occupancy query says %d\n", per_cu); }
        (void)hipGetLastError();
        grid = cus;
    }
    if (grid < 0) return;
    (void)hipMemsetAsync((char*)d_ws + WS_CTL, 0, CTL_ZERO_BYTES, stream);
    Args a{};
    for (int i = 0; i < 22; ++i) a.in[i] = (const float*)d_in[i];
    a.out = (float*)d_out; a.ws = (unsigned char*)d_ws;
#if MK_N_LAUNCHES == 1
    a.ph_lo = 0; a.ph_hi = NPHASE;
    hipLaunchKernelGGL(fwd_kernel, dim3(grid), dim3(512), LDS_BYTES, stream, a);
#else
    for (int p = 0; p < NPHASE; ++p) { a.ph_lo = p; a.ph_hi = p + 1; hipLaunchKernelGGL(fwd_kernel, dim3(grid), dim3(512), LDS_BYTES, stream, a); }
#endif
}
```

```cpp
#include <hip/hip_runtime.h>
#include <cstdio>
#include <cstdint>

#ifndef MK_N_LAUNCHES
#define MK_N_LAUNCHES 1
#endif

#define GAS __attribute__((address_space(1)))
#define LAS __attribute__((address_space(3)))
typedef unsigned short bf16;
typedef short bf16x8 __attribute__((ext_vector_type(8)));
typedef float f32x4 __attribute__((ext_vector_type(4)));
typedef float f32x2 __attribute__((ext_vector_type(2)));
typedef unsigned u32x4 __attribute__((ext_vector_type(4)));
typedef unsigned u32x2 __attribute__((ext_vector_type(2)));

constexpr int D = 2048, BATCH = 4, SEQ = 2048, CTXL = 256;
constexpr int TL = BATCH * SEQ;
constexpr int TC = BATCH * CTXL;
constexpr int TA = TL + TC;
constexpr int NPROJ = 4864;
constexpr int C_AQ = 0, C_AK = 1024, C_AV = 1280, C_GQ = 1536, C_GK = 2048, C_GV = 2560, C_GG = 3584, C_LR = 4608;
constexpr int NEXP = 32, DEXP = 1024;
constexpr float EPS = 1e-6f;

constexpr size_t MiB = 1u << 20;
constexpr size_t WS_CTL = 0, CTL_ZERO_BYTES = 128 * 1024;
constexpr size_t WS_MOD = 1 * MiB;
constexpr size_t WS_ROUTE = 2 * MiB;
constexpr size_t WS_LIST = 3 * MiB;
constexpr size_t WS_RWT_HI = 6 * MiB;
constexpr size_t WS_RWT_LO = 7 * MiB;
constexpr size_t WS_RBIAS = 1 * MiB + 512 * 1024;
constexpr size_t WS_WIN_T = 8 * MiB;
constexpr size_t WS_WOUT_T = 28 * MiB;
constexpr size_t WS_CIN_T = 36 * MiB;
constexpr size_t WS_COUT_T = 60 * MiB;
constexpr size_t WS_W13_T = 68 * MiB;
constexpr size_t WS_W2_T = 580 * MiB;
constexpr size_t WS_HA = 836 * MiB;
constexpr size_t WS_PROJ = 872 * MiB;
constexpr size_t WS_LA = 958 * MiB;
constexpr size_t WS_VTL = 994 * MiB;
constexpr size_t WS_VTC = 998 * MiB;
constexpr size_t WS_OG = 1000 * MiB;
constexpr size_t WS_MIX = 1064 * MiB;
constexpr size_t WS_X1 = 1096 * MiB;
constexpr size_t WS_HMID = 1160 * MiB;
constexpr size_t WS_Y = 1208 * MiB;
constexpr size_t WS_X2 = 1304 * MiB;
constexpr size_t WS_GB = 1368 * MiB;
constexpr size_t WS_PGU = 1400 * MiB;
constexpr size_t WS_Z = 1432 * MiB;
constexpr size_t WS_X3 = 1464 * MiB;
constexpr size_t WS_QF = 1528 * MiB;
constexpr size_t WS_KLT = 1546 * MiB;
constexpr size_t WS_ATT = 1564 * MiB;
constexpr size_t WS_VT = 1573 * MiB;
constexpr size_t WS_DEC = 1609 * MiB;
constexpr size_t WS_END = 1610 * MiB;
constexpr int CW_BAR = 4096;
constexpr int CW_CNT = 8192;
constexpr int CW_CVT = 16384;
constexpr int CW_P0 = 16384 + 512;

constexpr int RING_BYTES = 131072;
constexpr int LDS_MISC = RING_BYTES;
constexpr int LDS_PB = RING_BYTES + 256;
constexpr int LDS_TOK = RING_BYTES + 1024;
constexpr int LDS_BYTES = 147456;

__device__ __forceinline__ float bf2f(unsigned short b) { return __uint_as_float(((unsigned)b) << 16); }
__device__ __forceinline__ unsigned cvt_pk_bf16(float lo, float hi) { unsigned r; asm volatile("v_cvt_pk_bf16_f32 %0, %1, %2" : "=v"(r) : "v"(lo), "v"(hi)); return r; }
__device__ __forceinline__ float wave_sum(float v) {
#pragma unroll
    for (int o = 1; o < 64; o <<= 1) v += __shfl_xor(v, o);
    return v;
}
__device__ __forceinline__ float silu_f(float v) { return v / (1.0f + __expf(-v)); }
__device__ __forceinline__ f32x4 bf4_to_f32(u32x2 w) { f32x4 r; r[0] = __uint_as_float(w.x << 16); r[1] = __uint_as_float(w.x & 0xffff0000u); r[2] = __uint_as_float(w.y << 16); r[3] = __uint_as_float(w.y & 0xffff0000u); return r; }
__device__ __forceinline__ u32x2 f32_to_bf4(f32x4 v) { u32x2 w; w.x = cvt_pk_bf16(v[0], v[1]); w.y = cvt_pk_bf16(v[2], v[3]); return w; }
__device__ __forceinline__ void mfma_settle(f32x4& a) { asm volatile("s_nop 7\n\ts_nop 7" : "+v"(a)); }
__device__ __forceinline__ unsigned f2bf_sw(float f) { const unsigned u = __float_as_uint(f); return (u + 0x7fffu + ((u >> 16) & 1u)) >> 16; }
__device__ __forceinline__ u32x2 f32_to_bf4_sw(f32x4 v) { u32x2 w; w.x = f2bf_sw(v[0]) | (f2bf_sw(v[1]) << 16); w.y = f2bf_sw(v[2]) | (f2bf_sw(v[3]) << 16); return w; }

namespace pg8 {
constexpr int BM = 256, BK = 64, HALF = 128, HTB = HALF * BK * 2, STAGE_BYTES = 8 * HTB, NXCD = 8, WGM = 8;
__host__ __device__ __forceinline__ int lds_byte(int r, int c) { const int st = (r >> 4) * 2 + (c >> 5), rr = r & 15, cc = c & 31, ob = rr * 64 + cc * 2; return st * 1024 + (ob ^ (((ob >> 9) & 1) << 5)); }
__host__ __device__ __forceinline__ void stage_rc(int b, int& R, int& C) { const int st = b / 1024, sb = b % 1024, swz = sb ^ (((sb >> 9) & 1) << 5); R = (st >> 1) * 16 + swz / 64; C = (st & 1) * 32 + (swz % 64) / 2; }
__host__ __device__ __forceinline__ int perm32(int rho) { const int n = rho >> 4, i = rho & 15; return 8 * (i >> 2) + 4 * n + (i & 3); }

struct Unit { int pm, pn, e; };
struct Gemm { const bf16* A; const bf16* Bt; int K; };

struct StaticOrder {
    static constexpr bool GATHER = false;
    int nM, nN, nwg, G, c, ilo, ihi;
    __device__ void init(int M, int N, int G_, int c_) { nM = M / BM; nN = N / BM; nwg = nM * nN; G = G_; c = c_; ilo = 0; ihi = 1 << 30; }
    __device__ bool next(int i0, Unit& u) const {
        const int i = i0 + ilo; if (i >= ihi) return false;
        const long L = (long)i * G + c; if (L >= nwg) return false;
        int wgid = (int)L; { const int q = nwg / NXCD, r = nwg % NXCD, xcd = wgid % NXCD, off = wgid / NXCD; wgid = (xcd < r ? xcd * (q + 1) : r * (q + 1) + (xcd - r) * q) + off; }
        const int nig = WGM * nN, gid = wgid / nig, fm = gid * WGM, gsz = (nM - fm) < WGM ? (nM - fm) : WGM;
        u.pm = fm + ((wgid % nig) % gsz); u.pn = (wgid % nig) / gsz; u.e = 0; return true;
    }
    __device__ __forceinline__ const char* b_ptr(const Gemm& g, const Unit& u, size_t tstep) const { return (const char*)g.Bt + (size_t)u.pn * tstep; }
    __device__ __forceinline__ unsigned tok(int, int) const { return 0u; }
};
template <bool GATHER_> struct MoeOrder {
    static constexpr bool GATHER = GATHER_;
    const LAS int* pb; const LAS int* tokt; int G, c, nN; size_t estride;
    __device__ bool next(int i, Unit& u) const {
        const int L = i * G + c; const int total = pb[32] * nN; if (L >= total) return false;
        int e = 0;
#pragma unroll 1
        for (int j = 1; j < 32; ++j) if (pb[j] * nN <= L) e = j;
        const int r = L - pb[e] * nN, np = pb[e + 1] - pb[e];
        u.e = e; u.pn = r / np; u.pm = pb[e] + (r % np); return true;
    }
    __device__ __forceinline__ const char* b_ptr(const Gemm& g, const Unit& u, size_t tstep) const { return (const char*)g.Bt + (size_t)u.e * estride + (size_t)u.pn * tstep; }
    __device__ __forceinline__ unsigned tok(int ui, int r) const { return (unsigned)tokt[(ui & 3) * 256 + r]; }
};

struct EpiBf16 {
    static constexpr bool PERM = true;
    bf16* O; int ldc;
    __device__ __forceinline__ void operator()(const f32x4 (&acc)[2][2][4][2], const Unit& u, int wr, int wc, int fr, int fq) const {
        const int row0 = u.pm * BM + wr * 64 + fr, col0 = u.pn * BM + wc * 32 + 8 * fq;
        { f32x4 t = acc[1][1][3][1]; mfma_settle(t); }
#pragma unroll
        for (int ai = 0; ai < 2; ++ai)
#pragma unroll
            for (int m = 0; m < 4; ++m) { bf16* rowp = O + (size_t)(row0 + ai * HALF + m * 16) * ldc + col0;
#pragma unroll
                for (int bj = 0; bj < 2; ++bj) { const f32x4 v0 = acc[ai][bj][m][0], v1 = acc[ai][bj][m][1];
                    u32x4 w; w.x = cvt_pk_bf16(v0[0], v0[1]); w.y = cvt_pk_bf16(v0[2], v0[3]); w.z = cvt_pk_bf16(v1[0], v1[1]); w.w = cvt_pk_bf16(v1[2], v1[3]);
                    *(u32x4*)(rowp + bj * HALF) = w; } }
    }
};
template <bool SILU> struct EpiPair {
    static constexpr bool PERM = true;
    bf16* O; int ldo; int pn0; bf16* P; int ldp;
    __device__ __forceinline__ void operator()(const f32x4 (&acc)[2][2][4][2], const Unit& u, int wr, int wc, int fr, int fq) const {
        const int row0 = u.pm * BM + wr * 64 + fr;
        { f32x4 t = acc[1][1][3][1]; mfma_settle(t); }
        if (u.pn < pn0) {
            const int col0 = u.pn * BM + wc * 32 + 8 * fq;
#pragma unroll
            for (int ai = 0; ai < 2; ++ai)
#pragma unroll
                for (int m = 0; m < 4; ++m) { bf16* rowp = P + (size_t)(row0 + ai * HALF + m * 16) * ldp + col0;
#pragma unroll
                    for (int bj = 0; bj < 2; ++bj) { const f32x4 v0 = acc[ai][bj][m][0], v1 = acc[ai][bj][m][1];
                        u32x4 w; w.x = cvt_pk_bf16(v0[0], v0[1]); w.y = cvt_pk_bf16(v0[2], v0[3]); w.z = cvt_pk_bf16(v1[0], v1[1]); w.w = cvt_pk_bf16(v1[2], v1[3]);
                        *(u32x4*)(rowp + bj * HALF) = w; } }
        } else {
            const int col0 = (u.pn - pn0) * HALF + wc * 32 + 8 * fq;
#pragma unroll
            for (int ai = 0; ai < 2; ++ai)
#pragma unroll
                for (int m = 0; m < 4; ++m) { bf16* rowp = O + (size_t)(row0 + ai * HALF + m * 16) * ldo + col0;
                    f32x4 g0 = acc[ai][0][m][0], g1 = acc[ai][0][m][1]; const f32x4 u0 = acc[ai][1][m][0], u1 = acc[ai][1][m][1];
                    if (SILU) {
#pragma unroll
                        for (int j = 0; j < 4; ++j) { g0[j] = silu_f(g0[j]); g1[j] = silu_f(g1[j]); } }
                    g0 = g0 * u0; g1 = g1 * u1;
                    u32x4 w; w.x = cvt_pk_bf16(g0[0], g0[1]); w.y = cvt_pk_bf16(g0[2], g0[3]); w.z = cvt_pk_bf16(g1[0], g1[1]); w.w = cvt_pk_bf16(g1[2], g1[3]);
                    *(u32x4*)rowp = w; }
        }
    }
};
template <bool BASE_BF16> struct EpiResGate {
    static constexpr bool PERM = false;
    const void* base; bf16* out; const float* gate; int gstride;
    __device__ __forceinline__ void operator()(const f32x4 (&acc)[2][2][4][2], const Unit& u, int wr, int wc, int fr, int fq) const {
        const int row0 = u.pm * BM + wr * 64 + fr, col0 = u.pn * BM + wc * 32 + 4 * fq;
        const float* gp = gate + (size_t)((u.pm * BM) / SEQ) * gstride + col0;
        f32x4 gv[2][2];
#pragma unroll
        for (int bj = 0; bj < 2; ++bj)
#pragma unroll
            for (int n = 0; n < 2; ++n) gv[bj][n] = *(const f32x4*)(gp + bj * HALF + n * 16);
#pragma unroll
        for (int ai = 0; ai < 2; ++ai)
#pragma unroll
            for (int m = 0; m < 4; ++m) { const size_t off = (size_t)(row0 + ai * HALF + m * 16) * D + col0;
#pragma unroll
                for (int bj = 0; bj < 2; ++bj)
#pragma unroll
                    for (int n = 0; n < 2; ++n) { const size_t o = off + bj * HALF + n * 16;
                        const f32x4 bs = BASE_BF16 ? bf4_to_f32(*(const u32x2*)((const bf16*)base + o)) : *(const f32x4*)((const float*)base + o);
                        *(u32x2*)(out + o) = f32_to_bf4(bs + gv[bj][n] * acc[ai][bj][m][n]); } }
    }
};

template <class Epi, class Sched, bool ALIGN_EPI>
__device__ __forceinline__ void gemm_phase(LAS unsigned char* lds, const Gemm g, const Sched& S, const Epi& E) {
    const int tid = threadIdx.x, wid = __builtin_amdgcn_readfirstlane(tid >> 6), lane = tid & 63, wr = wid >> 2, wc = wid & 3, fr = lane & 15, fq = lane >> 4;
    const int K = g.K, nt = K / BK;
    unsigned voffA[2], voffB[2]; int stR[2], stC[2];
#pragma unroll
    for (int i = 0; i < 2; ++i) { int R, C; stage_rc(tid * 16 + i * 8192, R, C); const int Rb = Epi::PERM ? ((R & ~31) + perm32(R & 31)) : R;
        stR[i] = R; stC[i] = C; voffA[i] = (unsigned)(R * K + C) * 2u; voffB[i] = (unsigned)(Rb * K + C) * 2u; }
    const size_t kstep = (size_t)(BK * 2);
    const size_t hstep = (size_t)HALF * K * 2;
    const size_t tstep = 2 * hstep;
    const unsigned ldsw = (unsigned)wid * 1024u;
    const int aoff = lds_byte(wr * 64 + fr, fq * 8), boff = lds_byte(wc * 32 + fr, fq * 8);
#define PG8_SA(b, h) (((b) * 2 + (h)) * HTB)
#define PG8_SB(b, h) ((4 + (b) * 2 + (h)) * HTB)
#define PG8_STAGE(bufoff, gbase, voff) do { _Pragma("unroll") for (int _i = 0; _i < 2; ++_i) \
        __builtin_amdgcn_global_load_lds((const unsigned*)((const char*)(gbase) + (voff)[_i]), (LAS unsigned*)(lds + (bufoff) + ldsw + _i * 8192), 16, 0, 0); } while (0)
#define PG8_STAGE_A(bufoff, h, ubase, kb, vo) do { if constexpr (Sched::GATHER) { PG8_STAGE(bufoff, (const char*)g.A + (kb), (vo)[h]); } else { PG8_STAGE(bufoff, (ubase) + (h) * hstep + (kb), voffA); } } while (0)
#define PG8_LDA(dst, b, h) do { _Pragma("unroll") for (int m = 0; m < 4; ++m) _Pragma("unroll") for (int k = 0; k < 2; ++k) dst[m][k] = *(const LAS bf16x8*)(lds + PG8_SA(b, h) + aoff + m * 2048 + k * 1024); } while (0)
#define PG8_LDB(dst, b, h) do { _Pragma("unroll") for (int n = 0; n < 2; ++n) _Pragma("unroll") for (int k = 0; k < 2; ++k) dst[n][k] = *(const LAS bf16x8*)(lds + PG8_SB(b, h) + boff + n * 2048 + k * 1024); } while (0)
#define PG8_MMA(ai, bj, At, Bt) do { __builtin_amdgcn_s_setprio(1); _Pragma("unroll") for (int m = 0; m < 4; ++m) _Pragma("unroll") for (int n = 0; n < 2; ++n) _Pragma("unroll") for (int k = 0; k < 2; ++k) \
        acc[ai][bj][m][n] = __builtin_amdgcn_mfma_f32_16x16x32_bf16(Bt[n][k], At[m][k], acc[ai][bj][m][n], 0, 0, 0); __builtin_amdgcn_s_setprio(0); } while (0)
#define PG8_WAIT_V(n) asm volatile("s_waitcnt vmcnt(" #n ")" ::: "memory")
#define PG8_WAIT_L(n) asm volatile("s_waitcnt lgkmcnt(" #n ")" ::: "memory")
#define PG8_BAR __builtin_amdgcn_s_barrier()
#define PG8_SCHED __builtin_amdgcn_sched_barrier(0)
    Unit cur, nxt; int ui = 0;
    if (!S.next(0, cur)) return;
    f32x4 acc[2][2][4][2];
#pragma unroll
    for (int a = 0; a < 2; ++a)
#pragma unroll
        for (int b = 0; b < 2; ++b)
#pragma unroll
            for (int m = 0; m < 4; ++m)
#pragma unroll
                for (int n = 0; n < 2; ++n) acc[a][b][m][n] = (f32x4){0.f, 0.f, 0.f, 0.f};
    bf16x8 At[4][2], B0[2][2], B1[2][2];
    const char* cA = (const char*)g.A + (size_t)cur.pm * tstep; const char* cB = S.b_ptr(g, cur, tstep);
    unsigned voC[2][2] = {{0u, 0u}, {0u, 0u}};
    if constexpr (Sched::GATHER) {
#pragma unroll
        for (int h = 0; h < 2; ++h)
#pragma unroll
            for (int i = 0; i < 2; ++i) voC[h][i] = (S.tok(0, h * HALF + stR[i]) * (unsigned)K + (unsigned)stC[i]) * 2u;
    }
    PG8_STAGE(PG8_SB(0, 0), cB, voffB); PG8_STAGE(PG8_SB(0, 1), cB + hstep, voffB); PG8_STAGE_A(PG8_SA(0, 0), 0, cA, 0, voC); PG8_STAGE_A(PG8_SA(0, 1), 1, cA, 0, voC);
    if (wr == 1) PG8_BAR;
    PG8_WAIT_V(2); PG8_BAR;
    PG8_STAGE(PG8_SB(1, 0), cB + kstep, voffB); PG8_STAGE_A(PG8_SA(1, 0), 0, cA, kstep, voC); PG8_STAGE(PG8_SB(1, 1), cB + hstep + kstep, voffB);
    PG8_WAIT_V(6); PG8_BAR;
    for (;;) {
        const bool has_next = S.next(ui + 1, nxt);
        const char* nA = has_next ? (const char*)g.A + (size_t)nxt.pm * tstep : cA; const char* nB = has_next ? S.b_ptr(g, nxt, tstep) : cB;
        for (int t = 0; t < nt; t += 2) {
            const bool last = (t == nt - 2);
            const char* a1 = cA; const size_t k1 = (size_t)(t + 1) * kstep;
            const char* a2 = last ? nA : cA; const size_t k2 = last ? 0 : (size_t)(t + 2) * kstep; const char* b2 = last ? nB : cB + (size_t)(t + 2) * kstep;
            const size_t k3 = k2 + kstep; const char* b3 = b2 + kstep;
            unsigned vo2[2][2] = {{0u, 0u}, {0u, 0u}};
            if constexpr (Sched::GATHER) {
                if (last && has_next) {
#pragma unroll
                    for (int h = 0; h < 2; ++h)
#pragma unroll
                        for (int i = 0; i < 2; ++i) vo2[h][i] = (S.tok(ui + 1, h * HALF + stR[i]) * (unsigned)K + (unsigned)stC[i]) * 2u;
                } else {
#pragma unroll
                    for (int h = 0; h < 2; ++h)
#pragma unroll
                        for (int i = 0; i < 2; ++i) vo2[h][i] = voC[h][i];
                }
            }
            PG8_LDB(B0, 0, 0); PG8_LDB(B1, 0, 1); PG8_SCHED; PG8_LDA(At, 0, 0); PG8_STAGE_A(PG8_SA(1, 1), 1, a1, k1, voC);
            PG8_WAIT_V(8); PG8_WAIT_L(0); PG8_BAR; PG8_MMA(0, 0, At, B0); PG8_MMA(0, 1, At, B1); PG8_BAR; PG8_SCHED;
            PG8_LDA(At, 0, 1); PG8_STAGE(PG8_SB(0, 0), b2, voffB); PG8_STAGE(PG8_SB(0, 1), b2 + hstep, voffB); PG8_STAGE_A(PG8_SA(0, 0), 0, a2, k2, vo2);
            PG8_WAIT_V(8); PG8_WAIT_L(0); PG8_BAR; PG8_MMA(1, 0, At, B0); PG8_MMA(1, 1, At, B1); PG8_BAR; PG8_SCHED;
            PG8_LDB(B0, 1, 0); PG8_LDB(B1, 1, 1); PG8_SCHED; PG8_LDA(At, 1, 0); PG8_STAGE_A(PG8_SA(0, 1), 1, a2, k2, vo2);
            PG8_WAIT_V(8); PG8_WAIT_L(0); PG8_BAR; PG8_MMA(0, 0, At, B0); PG8_MMA(0, 1, At, B1); PG8_BAR; PG8_SCHED;
            PG8_LDA(At, 1, 1); PG8_STAGE(PG8_SB(1, 0), b3, voffB); PG8_STAGE(PG8_SB(1, 1), b3 + hstep, voffB); PG8_STAGE_A(PG8_SA(1, 0), 0, a2, k3, vo2);
            PG8_WAIT_V(8); PG8_WAIT_L(0); PG8_BAR; PG8_MMA(1, 0, At, B0); PG8_MMA(1, 1, At, B1); PG8_BAR; PG8_SCHED;
            if constexpr (Sched::GATHER) { if (last) {
#pragma unroll
                for (int h = 0; h < 2; ++h)
#pragma unroll
                    for (int i = 0; i < 2; ++i) voC[h][i] = vo2[h][i]; } }
        }
        if constexpr (ALIGN_EPI) { if (wr == 0) PG8_BAR; }
        E(acc, cur, wr, wc, fr, fq);
        if (!has_next) break;
#pragma unroll
        for (int a = 0; a < 2; ++a)
#pragma unroll
            for (int b = 0; b < 2; ++b)
#pragma unroll
                for (int m = 0; m < 4; ++m)
#pragma unroll
                    for (int n = 0; n < 2; ++n) acc[a][b][m][n] = (f32x4){0.f, 0.f, 0.f, 0.f};
        cur = nxt; cA = nA; cB = nB; ++ui;
        if constexpr (ALIGN_EPI) { if (wr == 1) PG8_BAR; }
    }
    PG8_WAIT_V(0);
    if constexpr (!ALIGN_EPI) { if (wr == 0) PG8_BAR; }
    PG8_BAR;
#undef PG8_SA
#undef PG8_SB
#undef PG8_STAGE
#undef PG8_STAGE_A
#undef PG8_LDA
#undef PG8_LDB
#undef PG8_MMA
#undef PG8_WAIT_V
#undef PG8_WAIT_L
#undef PG8_BAR
#undef PG8_SCHED
}
}

#define XB_TMO      128
#define XB_XCNT(j)  (256  + 64 * (j))
#define XB_XSUB(j)  (1280 + 64 * (j))
#define XB_XGEN(j)  (2304 + 64 * (j))
#define XB_TOP      3328
#define XB_TOPGEN   3392
#define XCD_BAR_WORDS 3456
#define XB_SPIN_CAP (1u << 18)
__device__ __forceinline__ unsigned xb_ld(unsigned* p)              { return __hip_atomic_load(p, __ATOMIC_RELAXED, __HIP_MEMORY_SCOPE_AGENT); }
__device__ __forceinline__ unsigned xb_add(unsigned* p, unsigned v) { return __hip_atomic_fetch_add(p, v, __ATOMIC_RELAXED, __HIP_MEMORY_SCOPE_AGENT); }
__device__ __forceinline__ unsigned xb_xcc_id() { return (unsigned)__builtin_amdgcn_s_getreg((3 << 11) | 20) & 0xFu; }
#define XB_SPIN(cond, bar) do { unsigned _sp = 0; while (cond) { __builtin_amdgcn_s_sleep(1); \
    if ((++_sp & 255u) == 0u) { if (xb_ld(&(bar)[XB_TMO])) break; if (_sp > XB_SPIN_CAP) { atomicAdd(&(bar)[XB_TMO], 1u); break; } } } } while (0)
struct XcdBarrier { unsigned* bar; unsigned x; volatile LAS unsigned* st; };
__device__ __forceinline__ XcdBarrier xcd_barrier_post(unsigned* bar, volatile LAS unsigned* st) {
    XcdBarrier b; b.bar = bar; b.x = xb_xcc_id(); b.st = st;
    if (threadIdx.x == 0) (void)xb_add(&bar[XB_XCNT(b.x)], 1u);
    return b;
}
__device__ __forceinline__ void xcd_barrier_complete(unsigned* bar, unsigned x, unsigned& nloc, unsigned& nx) {
    const unsigned G = gridDim.x * gridDim.y * gridDim.z;
    unsigned sum, cnt, mine, sp = 0u;
    for (;;) {
        sum = 0u; cnt = 0u; mine = 0u;
#pragma unroll
        for (unsigned j = 0; j < 16; ++j) { const unsigned c = xb_ld(&bar[XB_XCNT(j)]); sum += c; cnt += (c > 0u) ? 1u : 0u; mine = (j == x) ? c : mine; }
        if (sum == G) break;
        __builtin_amdgcn_s_sleep(1);
        if ((++sp & 255u) == 0u) { if (xb_ld(&bar[XB_TMO])) break; if (sp > XB_SPIN_CAP) { atomicAdd(&bar[XB_TMO], 1u); break; } }
    }
    nloc = mine > 0u ? mine : 1u; nx = cnt > 0u ? cnt : 1u;
}
__device__ __forceinline__ void xcd_barrier(const XcdBarrier& b) {
    asm volatile("s_waitcnt vmcnt(0)" ::: "memory");
    __syncthreads();
    if (threadIdx.x == 0) {
        unsigned* bar = b.bar;
        __builtin_amdgcn_s_waitcnt(0);
        unsigned nloc = b.st[0], nx = b.st[1];
        if (nloc == 0u) { xcd_barrier_complete(bar, b.x, nloc, nx); b.st[0] = nloc; b.st[1] = nx; }
        const unsigned old = xb_add(&bar[XB_XSUB(b.x)], 1u);
        const unsigned gen = old / nloc;
        if (old + 1u == (gen + 1u) * nloc) {
            __builtin_amdgcn_fence(__ATOMIC_RELEASE, "agent");
            asm volatile("s_waitcnt vmcnt(0)" ::: "memory");
            const unsigned og = xb_add(&bar[XB_TOP], 1u);
            const unsigned tg = og / nx;
            if (og + 1u == (tg + 1u) * nx) xb_add(&bar[XB_TOPGEN], 1u);
            else XB_SPIN(xb_ld(&bar[XB_TOPGEN]) == tg, bar);
            __builtin_amdgcn_fence(__ATOMIC_ACQUIRE, "agent");
            xb_add(&bar[XB_XGEN(b.x)], 1u);
            asm volatile("s_waitcnt vmcnt(0)" ::: "memory");
        } else {
            XB_SPIN(xb_ld(&bar[XB_XGEN(b.x)]) == gen, bar);
            __builtin_amdgcn_fence(__ATOMIC_ACQUIRE, "agent");
            asm volatile("s_waitcnt vmcnt(0)" ::: "memory");
        }
    }
    __syncthreads();
}

struct Args { const float* in[22]; float* out; unsigned char* ws; int ph_lo, ph_hi; };
enum { I_X = 0, I_C, I_CTX, I_CCTX, I_MODW, I_MODB, I_AWIN, I_QN, I_KN, I_SINK, I_WA2, I_BA, I_GN, I_AWOUT, I_CWIN, I_CW, I_CWOUT, I_RW, I_RB, I_W1, I_W3, I_W2 };

struct Frame {
    LAS unsigned char* lds;
    const float* in[22]; float* out; unsigned char* ws;
    int tid, lane, wave, G, vcu;
};
#define WSP(T, off) ((T*)(F.ws + (off)))

__device__ __forceinline__ int rowmap(int kind, int n) {
    if (kind == 1) { return n < 2048 ? n : (n < 4096 ? 2048 + 256 * ((n - 2048) >> 7) + ((n - 2048) & 127) : 2048 + 256 * ((n - 4096) >> 7) + 128 + ((n - 4096) & 127)); }
    if (kind == 2) return 256 * (n >> 7) + (n & 127);
    if (kind == 3) return 256 * (n >> 7) + 128 + (n & 127);
    return n;
}
constexpr int CV_B0 = 8192, CV_B1 = 12288, CV_B2 = 20480, CV_B3 = 24576;
struct TileDesc { const float* src; bf16* dst; int K, N, kind, k0, n0; };
__device__ __forceinline__ TileDesc expert_tile(Frame& F, int layer_unused, int g) {
    const int layer = g >= CV_B1 ? 1 : 0, gl = g - layer * CV_B1; TileDesc d; int t;
    if (gl < CV_B0) { const int le = layer * 32 + (gl >> 8), r = gl & 255; t = r & 127;
        if ((r >> 7) == 0) { d.src = F.in[I_W1] + (size_t)le * 2048 * 1024; d.kind = 2; } else { d.src = F.in[I_W3] + (size_t)le * 2048 * 1024; d.kind = 3; }
        d.dst = WSP(bf16, WS_W13_T) + (size_t)le * 2048 * 2048; d.K = 2048; d.N = 1024; }
    else { const int dd = gl - CV_B0, le = layer * 32 + (dd >> 7); t = dd & 127;
        d.src = F.in[I_W2] + (size_t)le * 1024 * 2048; d.dst = WSP(bf16, WS_W2_T) + (size_t)le * 2048 * 1024; d.K = 1024; d.N = 2048; d.kind = 0; }
    const int nnt = d.N / 64; d.n0 = (t % nnt) * 64; d.k0 = (t / nnt) * 256; return d;
}
struct TileSrc { const float* p; bf16* dst; int K, kind, n0; bool ok; };
constexpr int DT0 = 8 * 76, DT1 = 8 * 32, DT2 = 8 * 96, DT3 = 8 * 32, DENSE_TILES = DT0 + DT1 + DT2 + DT3;
__device__ __forceinline__ TileDesc dense_tile(Frame& F, int g) {
    TileDesc d; int t = g < DENSE_TILES ? g : DENSE_TILES - 1, nnt; d.K = 2048;
    if (t < DT0) { d.src = F.in[I_AWIN]; d.N = 4640; d.dst = WSP(bf16, WS_WIN_T); d.kind = 0; nnt = 76; }
    else if ((t -= DT0) < DT1) { d.src = F.in[I_AWOUT]; d.N = 2048; d.dst = WSP(bf16, WS_WOUT_T); d.kind = 0; nnt = 32; }
    else if ((t -= DT1) < DT2) { d.src = F.in[I_CWIN]; d.N = 6144; d.dst = WSP(bf16, WS_CIN_T); d.kind = 1; nnt = 96; }
    else { t -= DT2; d.src = F.in[I_CWOUT]; d.N = 2048; d.dst = WSP(bf16, WS_COUT_T); d.kind = 0; nnt = 32; }
    d.n0 = (t % nnt) * 64; d.k0 = (t / nnt) * 256; return d;
}
template <bool DENSE> __device__ __forceinline__ void convert_tiles6(Frame& F, int tau0, unsigned* ctr, bool claim, volatile LAS unsigned* W) {
    constexpr int TP = 264, TB = 64 * TP * 2;
    const int ng = F.tid & 15, kqb = F.tid >> 4;
    tau0 = __builtin_amdgcn_readfirstlane(tau0);
    f32x4 va[3][2][4], vb[3][2][4]; TileSrc ta[3], tb[3];
#define CV_LOADA(V, T, t0) do { _Pragma("unroll") for (int q = 0; q < 3; ++q) { const TileDesc d = DENSE ? dense_tile(F, (t0) + q) : expert_tile(F, 0, (t0) + q); \
        T[q].ok = !DENSE || d.n0 + 4 * ng < d.N; \
        T[q].p = d.src + (size_t)d.k0 * d.N + (T[q].ok ? d.n0 + 4 * ng : 0); T[q].dst = d.dst + d.k0; T[q].K = d.K; T[q].kind = d.kind; T[q].n0 = d.n0; const int N = d.N; \
        _Pragma("unroll") for (int h = 0; h < 2; ++h) _Pragma("unroll") for (int r = 0; r < 4; ++r) { const float* p_ = T[q].p + (size_t)(4 * (kqb + 32 * h) + r) * N; \
            asm volatile("global_load_dwordx4 %0, %1, off nt" : "=v"(V[q][h][r]) : "v"(p_) : "memory"); } } } while (0)
#define CV_PIN(V) do { _Pragma("unroll") for (int q = 0; q < 3; ++q) asm volatile("" : "+v"(V[q][0][0]), "+v"(V[q][0][1]), "+v"(V[q][0][2]), "+v"(V[q][0][3]), "+v"(V[q][1][0]), "+v"(V[q][1][1]), "+v"(V[q][1][2]), "+v"(V[q][1][3])); } while (0)
#define CV_BAR() do { asm volatile("s_waitcnt lgkmcnt(0)" ::: "memory"); __builtin_amdgcn_s_barrier(); asm volatile("" ::: "memory"); } while (0)
#define CV_WRITE(V, T) do { _Pragma("unroll") for (int q = 0; q < 3; ++q) { LAS bf16* T_ = (LAS bf16*)(F.lds + q * TB); const float m_ = (DENSE && !T[q].ok) ? 0.f : 1.f; \
        _Pragma("unroll") for (int h = 0; h < 2; ++h) { const int kq = kqb + 32 * h; \
            _Pragma("unroll") for (int i = 0; i < 4; ++i) { const int n = 4 * ng + i; u32x2 w; \
                if (DENSE) { w.x = cvt_pk_bf16(V[q][h][0][i] * m_, V[q][h][1][i] * m_); w.y = cvt_pk_bf16(V[q][h][2][i] * m_, V[q][h][3][i] * m_); } \
                else { w.x = cvt_pk_bf16(V[q][h][0][i], V[q][h][1][i]); w.y = cvt_pk_bf16(V[q][h][2][i], V[q][h][3][i]); } \
                *(LAS u32x2*)(T_ + n * TP + 8 * ((kq >> 1) ^ ((n >> 4) & 3)) + 4 * (kq & 1)) = w; } } } } while (0)
#define CV_OUT(T) do { _Pragma("unroll") for (int q = 0; q < 3; ++q) { const LAS bf16* T_ = (const LAS bf16*)(F.lds + q * TB); \
        _Pragma("unroll") for (int qq = 0; qq < 4; ++qq) { const int piece = F.tid + 512 * qq, c = piece & 31, n = piece >> 5; \
            const u32x4 o = *(const LAS u32x4*)(T_ + n * TP + 8 * (c ^ ((n >> 4) & 3))); \
            __builtin_nontemporal_store(o, (u32x4*)(T[q].dst + (size_t)rowmap(T[q].kind, T[q].n0 + n) * T[q].K + 8 * c)); } } } while (0)
    CV_LOADA(va, ta, tau0);
    CV_LOADA(vb, tb, tau0 + 3);
    CV_BAR();
    asm volatile("s_waitcnt vmcnt(24)" ::: "memory"); CV_PIN(va);
    CV_WRITE(va, ta);
    CV_BAR();
    CV_OUT(ta);
    CV_BAR();
    asm volatile("s_waitcnt vmcnt(12)" ::: "memory"); CV_PIN(vb);
    CV_WRITE(vb, tb);
    CV_BAR();
    unsigned nxt = 0x40000000u; { const unsigned long long cm = __ballot(claim); unsigned long long sv; const unsigned six = 6u;
        asm volatile("s_mov_b64 %1, exec\n\ts_and_b64 exec, exec, %4\n\tglobal_atomic_add %0, %2, %3, off sc0\n\ts_mov_b64 exec, %1"
                     : "+v"(nxt), "=&s"(sv) : "v"(ctr), "v"(six), "s"(cm) : "memory", "scc"); }
    CV_OUT(tb);
    asm volatile("s_waitcnt vmcnt(12)" : "+v"(nxt) :: "memory");
    if (F.tid == 0) W[0] = nxt;
    CV_BAR();
#undef CV_LOADA
#undef CV_PIN
#undef CV_BAR
#undef CV_WRITE
#undef CV_OUT
}
__device__ __forceinline__ void convert_claim(Frame& F, int quota, int drain_to) {
    volatile LAS unsigned* W = (volatile LAS unsigned*)(F.lds + LDS_MISC) + 16;
    unsigned* ctr = WSP(unsigned, WS_CTL) + CW_CVT;
    __syncthreads();
    if (F.tid == 0) { bool want = quota > 0;
        if (!want && drain_to > 0) want = (int)__hip_atomic_load(ctr, __ATOMIC_RELAXED, __HIP_MEMORY_SCOPE_AGENT) < drain_to;
        W[0] = want ? atomicAdd(ctr, 6u) : 0x40000000u; }
    __syncthreads();
    int taken = 0;
    for (;;) {
        const int base = (int)W[0];
        if (base >= CV_B3) break;
        taken += 6;
        convert_tiles6<false>(F, base, ctr, F.tid == 0 && (taken < quota || base + 6 < drain_to), W);
    }
}
__device__ __forceinline__ void phase0(Frame& F) {
    if ((int)blockIdx.x < 192) {
        LAS float* sc = (LAS float*)F.lds;
        LAS float* red = sc + 5 * 2048;
        const float* c = F.in[I_C]; const float* cc = F.in[I_CCTX];
        for (int i = F.tid; i < 5 * 2048; i += 512) { const int r = i >> 11, k = i & 2047; const float v = r < 4 ? c[r * 2048 + k] : cc[k]; sc[i] = v / (1.0f + expf(-v)); }
        __syncthreads();
        float* MOD = WSP(float, WS_MOD);
        const int kh = F.lane >> 5, c4 = F.lane & 31;
        for (int unit = blockIdx.x; unit < 192; unit += F.G) {
            const int l = unit / 96, cg = unit % 96;
            const float* W = F.in[I_MODW] + (size_t)l * 2048 * 12288 + cg * 128 + 4 * c4 + (size_t)(F.wave * 256 + kh) * 12288;
            f32x4 acc[5];
#pragma unroll
            for (int r = 0; r < 5; ++r) acc[r] = (f32x4){0.f, 0.f, 0.f, 0.f};
#pragma unroll 1
            for (int blk = 0; blk < 8; ++blk) {
                f32x4 w[16];
#pragma unroll
                for (int u = 0; u < 16; ++u) w[u] = __builtin_nontemporal_load((const f32x4*)(W + (size_t)(2 * (16 * blk + u)) * 12288));
#pragma unroll
                for (int u = 0; u < 16; ++u) { const int k = F.wave * 256 + 2 * (16 * blk + u) + kh;
#pragma unroll
                    for (int r = 0; r < 5; ++r) { const float sv = sc[r * 2048 + k]; acc[r] += w[u] * sv; }
                    __builtin_amdgcn_sched_barrier(0); }
            }
#pragma unroll
            for (int r = 0; r < 5; ++r) *(LAS f32x4*)(red + ((F.wave * 2 + kh) * 5 + r) * 128 + 4 * c4) = acc[r];
            __syncthreads();
            for (int o = F.tid; o < 640; o += 512) { const int r = o >> 7, ccn = o & 127; float sum = 0.f;
#pragma unroll
                for (int g = 0; g < 16; ++g) sum += red[(g * 5 + r) * 128 + ccn];
                MOD[(size_t)(l * 5 + r) * 12288 + cg * 128 + ccn] = sum + F.in[I_MODB][l * 12288 + cg * 128 + ccn]; }
            __syncthreads();
        }
    }
    volatile LAS unsigned* Wq = (volatile LAS unsigned*)(F.lds + LDS_MISC) + 24; unsigned* head = WSP(unsigned, WS_CTL) + CW_P0;
    __syncthreads();
    if (F.tid == 0) Wq[0] = atomicAdd(head, 6u);
    __syncthreads();
    for (;;) {
        const int base = (int)Wq[0];
        if (base >= DENSE_TILES) break;
        convert_tiles6<true>(F, base, head, F.tid == 0, Wq);
    }
}

__device__ __forceinline__ void modulate_store(const f32x4 (&v)[8], const float* shift, const float* scale, bf16* orow, int lane) {
    float ss = 0.f;
#pragma unroll
    for (int j = 0; j < 8; ++j) ss += (v[j][0] * v[j][0] + v[j][1] * v[j][1]) + (v[j][2] * v[j][2] + v[j][3] * v[j][3]);
    const float rstd = 1.0f / sqrtf(wave_sum(ss) * (1.0f / D) + EPS);
#pragma unroll
    for (int j = 0; j < 8; ++j) { const int c = 4 * (64 * j + lane); const f32x4 sh = *(const f32x4*)(shift + c), sc = *(const f32x4*)(scale + c);
        const f32x4 y = v[j] * rstd * (sc + 1.0f) + sh;
        u32x2 w; w.x = cvt_pk_bf16(y[0], y[1]); w.y = cvt_pk_bf16(y[2], y[3]); *(u32x2*)(orow + c) = w; }
}
__device__ __forceinline__ void phase_modulate0(Frame& F) {
    const int gw = blockIdx.x * 8 + F.wave, NGW = F.G * 8; const float* MOD = WSP(float, WS_MOD); bf16* HA = WSP(bf16, WS_HA);
    for (int row = gw; row < TA; row += NGW) {
        const float* src = row < TL ? F.in[I_X] + (size_t)row * D : F.in[I_CTX] + (size_t)(row - TL) * D;
        const int mr = row < TL ? row / SEQ : 4;
        f32x4 v[8];
#pragma unroll
        for (int j = 0; j < 8; ++j) v[j] = *(const f32x4*)(src + 4 * (64 * j + F.lane));
        modulate_store(v, MOD + (size_t)mr * 12288, MOD + (size_t)mr * 12288 + 2048, HA + (size_t)row * D, F.lane);
    }
    { bf16* RH = WSP(bf16, WS_RWT_HI); bf16* RL = WSP(bf16, WS_RWT_LO); const float* rw = F.in[I_RW];
      for (int piece = blockIdx.x * 512 + F.tid; piece < 2 * 4 * 32 * 256; piece += F.G * 512) { const int e = piece & 31, k0 = ((piece >> 5) & 255) * 8, lb = piece >> 13; unsigned hi[4], lo[4];
          const float* sc = MOD + (size_t)((lb >> 2) * 5 + (lb & 3)) * 12288 + 4 * 2048 + k0; const f32x4 s0 = *(const f32x4*)sc + 1.0f, s1 = *(const f32x4*)(sc + 4) + 1.0f;
#pragma unroll
          for (int i = 0; i < 4; ++i) { const float sa = i < 2 ? s0[2 * i] : s1[2 * i - 4], sb = i < 2 ? s0[2 * i + 1] : s1[2 * i - 3];
              const float a = rw[(size_t)(k0 + 2 * i) * 32 + e] * sa, b = rw[(size_t)(k0 + 2 * i + 1) * 32 + e] * sb;
              hi[i] = cvt_pk_bf16(a, b); lo[i] = cvt_pk_bf16(a - __uint_as_float(hi[i] << 16), b - __uint_as_float(hi[i] & 0xffff0000u)); }
          u32x4 h4, l4; h4.x = hi[0]; h4.y = hi[1]; h4.z = hi[2]; h4.w = hi[3]; l4.x = lo[0]; l4.y = lo[1]; l4.z = lo[2]; l4.w = lo[3];
          const size_t fi = ((((size_t)lb * 8 + (k0 >> 8)) * 8 + ((k0 >> 5) & 7)) * 2 + (e >> 4)) * 64 + ((k0 >> 3) & 3) * 16 + (e & 15);
          *(u32x4*)(RH + fi * 8) = h4; *(u32x4*)(RL + fi * 8) = l4; }
      for (int u = blockIdx.x; u < 128; u += F.G) { const int lb = u & 7, seg = u >> 3, e = F.tid & 31, part = F.tid >> 5; LAS float* red = (LAS float*)F.lds;
          const float* sh = MOD + (size_t)((lb >> 2) * 5 + (lb & 3)) * 12288 + 3 * 2048; const int kb = seg * 128 + part * 8; float sum = 0.f;
#pragma unroll
          for (int i = 0; i < 8; ++i) sum += sh[kb + i] * rw[(size_t)(kb + i) * 32 + e];
          __syncthreads(); red[part * 32 + e] = sum; __syncthreads();
          if (F.tid < 32) { float t = 0.f;
#pragma unroll
              for (int p = 0; p < 16; ++p) t += red[p * 32 + F.tid];
              WSP(float, WS_RBIAS)[(lb * 16 + seg) * 32 + F.tid] = t; } } }
}

__device__ __forceinline__ void phase_prep(Frame& F) {
    bf16* PROJ = WSP(bf16, WS_PROJ);
    const int gw = blockIdx.x * 8 + F.wave, NGW = F.G * 8, lane = F.lane;
    const int hs = lane >> 4, sub = lane & 15, fb = 8 * (sub & 3); const bool second = (sub & 4) != 0, axis1 = (sub & 8) != 0;
    float qg[8], kg[8], invf[8];
#pragma unroll
    for (int j = 0; j < 8; ++j) { qg[j] = F.in[I_QN][8 * sub + j]; kg[j] = F.in[I_KN][8 * sub + j]; invf[j] = __expf(-(float)(fb + j) * (9.210340371976184f / 32.0f)); }
    for (int row = gw; row < TA; row += NGW) {
        bf16* pr = PROJ + (size_t)row * NPROJ;
        const bool lat = row < TL;
        float cs[8], sn[8];
        if (lat) { const int t = row % SEQ; const float pos = (float)(axis1 ? (t % 64) : (t / 64));
#pragma unroll
            for (int j = 0; j < 8; ++j) { const float a = pos * invf[j]; cs[j] = __cosf(a); sn[j] = __sinf(a); } }
        else {
#pragma unroll
            for (int j = 0; j < 8; ++j) { cs[j] = 1.f; sn[j] = 0.f; } }
        u32x4 raw[3]; bool act[3];
#pragma unroll
        for (int p = 0; p < 3; ++p) { const int h = 4 * p + hs; act[p] = (h < 10) && (lat || h >= 8);
            raw[p] = (u32x4){0u, 0u, 0u, 0u};
            if (act[p]) raw[p] = *(const u32x4*)(pr + (h < 8 ? C_AQ + h * 128 : C_AK + (h - 8) * 128) + 8 * sub); }
#pragma unroll
        for (int p = 0; p < 3; ++p) { const int h = 4 * p + hs;
            const unsigned ww[4] = {raw[p].x, raw[p].y, raw[p].z, raw[p].w}; float x[8]; float ss = 0.f;
#pragma unroll
            for (int j = 0; j < 8; ++j) { x[j] = (j & 1) ? __uint_as_float(ww[j >> 1] & 0xffff0000u) : __uint_as_float(ww[j >> 1] << 16); ss += x[j] * x[j]; }
            ss += __shfl_xor(ss, 1); ss += __shfl_xor(ss, 2); ss += __shfl_xor(ss, 4); ss += __shfl_xor(ss, 8);
            const float rstd = 1.0f / sqrtf(ss * (1.0f / 128.0f) + EPS);
            float y[8];
#pragma unroll
            for (int j = 0; j < 8; ++j) { const float yv = x[j] * rstd * (p < 2 ? qg[j] : kg[j]); const float pv = __shfl_xor(yv, 4);
                y[j] = second ? yv * cs[j] + pv * sn[j] : yv * cs[j] - pv * sn[j]; }
            u32x4 o; o.x = cvt_pk_bf16(y[0], y[1]); o.y = cvt_pk_bf16(y[2], y[3]); o.z = cvt_pk_bf16(y[4], y[5]); o.w = cvt_pk_bf16(y[6], y[7]);
            if (act[p]) *(u32x4*)(pr + (h < 8 ? C_AQ + h * 128 : C_AK + (h - 8) * 128) + 8 * sub) = o; }
    }
    LAS bf16* T = (LAS bf16*)F.lds;
    bf16* VTL = WSP(bf16, WS_VTL); bf16* VTC = WSP(bf16, WS_VTC);
    for (int u = blockIdx.x; u < 288; u += F.G) {
        const bool isl = u < 256; const int uu = isl ? u : u - 256; const int ntile = isl ? 32 : 4;
        const int b = uu / (2 * ntile), kvh = (uu / ntile) & 1, tt = uu % ntile;
        const int row0 = isl ? b * SEQ + tt * 64 : TL + b * CTXL + tt * 64;
#pragma unroll
        for (int q = 0; q < 2; ++q) { const int j = F.lane, seg = F.wave + 8 * q;
            const u32x4 w = *(const u32x4*)(PROJ + (size_t)(row0 + j) * NPROJ + C_AV + kvh * 128 + seg * 8);
            const unsigned ww[4] = {w.x, w.y, w.z, w.w};
#pragma unroll
            for (int i = 0; i < 8; ++i) T[(seg * 8 + i) * 72 + j] = (bf16)((ww[i >> 1] >> ((i & 1) * 16)) & 0xffffu); }
        __syncthreads();
#pragma unroll
        for (int q = 0; q < 2; ++q) { const int piece = F.tid + 512 * q, d = piece >> 3, seg = piece & 7;
            const u32x4 w = *(const LAS u32x4*)(T + d * 72 + seg * 8);
            bf16* dst = isl ? VTL + ((size_t)(b * 2 + kvh) * 128 + d) * SEQ + tt * 64 + seg * 8 : VTC + ((size_t)(b * 2 + kvh) * 128 + d) * CTXL + tt * 64 + seg * 8;
            *(u32x4*)dst = w; }
        __syncthreads();
    }
}

__device__ __forceinline__ void attn_unit(Frame& F, int unit) {
    const bf16* PROJ = WSP(bf16, WS_PROJ); const bf16* VTL = WSP(bf16, WS_VTL); const bf16* VTC = WSP(bf16, WS_VTC); bf16* MIX = WSP(bf16, WS_MIX);
    const int b = unit >> 6, qb = (unit >> 2) & 15, kvh = (unit >> 1) & 1, gp = unit & 1;
    const int w = F.wave, lane = F.lane, fr = lane & 15, fq = lane >> 4;
    const int hq = kvh * 4 + gp * 2 + (w >> 2), qr0 = qb * 128 + 32 * (w & 3);
    LAS bf16* Ks = (LAS bf16*)F.lds;
    LAS bf16* Vs = Ks + 64 * 136;
    LAS bf16* Ps = Vs + 128 * 72 + w * (32 * 72);
    bf16x8 Q[2][4];
#pragma unroll
    for (int mt = 0; mt < 2; ++mt)
#pragma unroll
        for (int ks = 0; ks < 4; ++ks) Q[mt][ks] = *(const bf16x8*)(PROJ + (size_t)(b * SEQ + qr0 + 16 * mt + fr) * NPROJ + C_AQ + hq * 128 + 32 * ks + 8 * fq);
    const float sinkv = F.in[I_SINK][hq];
    float mrun[2] = {sinkv, sinkv}, lrun[2] = {1.f, 1.f};
    f32x4 o[2][8];
#pragma unroll
    for (int mt = 0; mt < 2; ++mt)
#pragma unroll
        for (int dt = 0; dt < 8; ++dt) o[mt][dt] = (f32x4){0.f, 0.f, 0.f, 0.f};
    const int kt_lo = (2 * qb - 2) < 0 ? 0 : 2 * qb - 2, kt_hi = (2 * qb + 3) > 31 ? 31 : 2 * qb + 3;
    const int ntiles = 4 + (kt_hi - kt_lo + 1);
    u32x4 rk[2], rv[2];
#define ATT_LOAD(ti_) do { const bool isc_ = (ti_) < 4; const int kt_ = isc_ ? (ti_) : kt_lo + ((ti_) - 4); \
        const size_t krow0_ = isc_ ? (size_t)(TL + b * CTXL + kt_ * 64) : (size_t)(b * SEQ + kt_ * 64); \
        const bf16* vt_ = isc_ ? VTC + (size_t)(b * 2 + kvh) * 128 * CTXL + kt_ * 64 : VTL + (size_t)(b * 2 + kvh) * 128 * SEQ + kt_ * 64; const int vld_ = isc_ ? CTXL : SEQ; \
        _Pragma("unroll") for (int q = 0; q < 2; ++q) { const int piece = F.tid + 512 * q; \
            rk[q] = *(const u32x4*)(PROJ + (krow0_ + (piece >> 4)) * NPROJ + C_AK + kvh * 128 + (piece & 15) * 8); \
            rv[q] = *(const u32x4*)(vt_ + (size_t)(piece >> 3) * vld_ + (piece & 7) * 8); } } while (0)
    ATT_LOAD(0);
    for (int ti = 0; ti < ntiles; ++ti) {
        const bool isc = ti < 4; const int kt = isc ? ti : kt_lo + (ti - 4);
        __syncthreads();
#pragma unroll
        for (int q = 0; q < 2; ++q) { const int piece = F.tid + 512 * q;
            *(LAS u32x4*)(Ks + (piece >> 4) * 136 + (piece & 15) * 8) = rk[q];
            *(LAS u32x4*)(Vs + (piece >> 3) * 72 + (piece & 7) * 8) = rv[q]; }
        __syncthreads();
        if (ti + 1 < ntiles) ATT_LOAD(ti + 1);
        f32x4 s[2][4];
#pragma unroll
        for (int mt = 0; mt < 2; ++mt)
#pragma unroll
            for (int nt = 0; nt < 4; ++nt) s[mt][nt] = (f32x4){0.f, 0.f, 0.f, 0.f};
#pragma unroll
        for (int nt = 0; nt < 4; ++nt)
#pragma unroll
            for (int ks = 0; ks < 4; ++ks) { const bf16x8 kf = *(const LAS bf16x8*)(Ks + (16 * nt + fr) * 136 + 32 * ks + 8 * fq);
#pragma unroll
                for (int mt = 0; mt < 2; ++mt) s[mt][nt] = __builtin_amdgcn_mfma_f32_16x16x32_bf16(kf, Q[mt][ks], s[mt][nt], 0, 0, 0); }
#pragma unroll
        for (int mt = 0; mt < 2; ++mt) {
            const int qpos = qr0 + 16 * mt + fr;
            float mx = -3.0e38f;
#pragma unroll
            for (int nt = 0; nt < 4; ++nt)
#pragma unroll
                for (int i = 0; i < 4; ++i) { float v = s[mt][nt][i] * 0.08838834764831845f;
                    if (!isc) { const int kpos = kt * 64 + 16 * nt + 4 * fq + i; const int dd = kpos - qpos; if (dd > 128 || dd < -128) v = -3.0e38f; }
                    s[mt][nt][i] = v; mx = fmaxf(mx, v); }
            mx = fmaxf(mx, __shfl_xor(mx, 16)); mx = fmaxf(mx, __shfl_xor(mx, 32));
            const float mnew = fmaxf(mrun[mt], mx), alpha = __expf(mrun[mt] - mnew);
            float rs = 0.f;
#pragma unroll
            for (int nt = 0; nt < 4; ++nt) { f32x4 p;
#pragma unroll
                for (int i = 0; i < 4; ++i) { const float v = s[mt][nt][i]; p[i] = v < -1.0e37f ? 0.f : __expf(v - mnew); rs += p[i]; }
                u32x2 pw; pw.x = cvt_pk_bf16(p[0], p[1]); pw.y = cvt_pk_bf16(p[2], p[3]);
                *(LAS u32x2*)(Ps + (16 * mt + fr) * 72 + 16 * nt + 4 * fq) = pw; }
            rs += __shfl_xor(rs, 16); rs += __shfl_xor(rs, 32);
            lrun[mt] = lrun[mt] * alpha + rs; mrun[mt] = mnew;
#pragma unroll
            for (int dt = 0; dt < 8; ++dt) o[mt][dt] = o[mt][dt] * alpha;
        }
        asm volatile("s_waitcnt lgkmcnt(0)" ::: "memory");
#pragma unroll
        for (int ks = 0; ks < 2; ++ks) { bf16x8 pf[2];
#pragma unroll
            for (int mt = 0; mt < 2; ++mt) pf[mt] = *(const LAS bf16x8*)(Ps + (16 * mt + fr) * 72 + 32 * ks + 8 * fq);
#pragma unroll
            for (int dt = 0; dt < 8; ++dt) { const bf16x8 vf = *(const LAS bf16x8*)(Vs + (16 * dt + fr) * 72 + 32 * ks + 8 * fq);
#pragma unroll
                for (int mt = 0; mt < 2; ++mt) o[mt][dt] = __builtin_amdgcn_mfma_f32_16x16x32_bf16(vf, pf[mt], o[mt][dt], 0, 0, 0); } }
    }
#pragma unroll
    for (int mt = 0; mt < 2; ++mt) { const float inv = 1.0f / lrun[mt]; bf16* orow = MIX + (size_t)(b * SEQ + qr0 + 16 * mt + fr) * D + hq * 128 + 4 * fq;
#pragma unroll
        for (int dt = 0; dt < 8; ++dt) { const f32x4 v = o[mt][dt] * inv; u32x2 wv; wv.x = cvt_pk_bf16(v[0], v[1]); wv.y = cvt_pk_bf16(v[2], v[3]); *(u32x2*)(orow + 16 * dt) = wv; } }
#undef ATT_LOAD
}

__device__ __forceinline__ int gla_row(int b, int dir, int tp) { return tp < CTXL ? TL + b * CTXL + (dir ? CTXL - 1 - tp : tp) : b * SEQ + (dir ? SEQ - 1 - (tp - CTXL) : tp - CTXL); }
__device__ __forceinline__ void gla_g1_all(Frame& F) {
    const bf16* PROJ = WSP(bf16, WS_PROJ);
    const int tid = F.tid, lane = F.lane, fr = lane & 15, fq = lane >> 4;
    LAS bf16* VTs = (LAS bf16*)F.lds;
    LAS float* LAs = (LAS float*)F.lds;
    LAS float* LRs = (LAS float*)(F.lds + 36864);
    LAS float* WAs = (LAS float*)(F.lds + 40960);
    LAS bf16* QFs = (LAS bf16*)(F.lds + 49152);
    LAS bf16* KFs = (LAS bf16*)(F.lds + 66560);
    LAS bf16* KLTs = (LAS bf16*)(F.lds + 83968);
    u32x4 pv[4], pq[2], pk[2]; unsigned short pl[2]; float pw[4], pba;
#define G1_LOAD(un) do { const int sidx_ = (un) / 36, c_ = (un) % 36, b_ = sidx_ >> 3, h_ = (sidx_ >> 1) & 3, dir_ = sidx_ & 1, tp0_ = c_ * 64; \
        const size_t rowl_ = (size_t)gla_row(b_, dir_, tp0_ + lane) * NPROJ; \
        _Pragma("unroll") for (int q = 0; q < 4; ++q) pv[q] = *(const u32x4*)(PROJ + rowl_ + C_GV + h_ * 256 + (F.wave + 8 * q) * 8); \
        _Pragma("unroll") for (int q = 0; q < 2; ++q) { pq[q] = *(const u32x4*)(PROJ + rowl_ + C_GQ + h_ * 128 + (F.wave + 8 * q) * 8); pk[q] = *(const u32x4*)(PROJ + rowl_ + C_GK + h_ * 128 + (F.wave + 8 * q) * 8); \
            const int i_ = tid + 512 * q; pl[q] = PROJ[(size_t)gla_row(b_, dir_, tp0_ + (i_ >> 4)) * NPROJ + C_LR + dir_ * 16 + (i_ & 15)]; } \
        _Pragma("unroll") for (int q = 0; q < 4; ++q) { const int i_ = tid + 512 * q; pw[q] = F.in[I_WA2][(dir_ * 16 + (i_ >> 7)) * 512 + h_ * 128 + (i_ & 127)]; } \
        pba = F.in[I_BA][dir_ * 512 + h_ * 128 + (tid & 127)]; } while (0)
    if ((int)blockIdx.x < 1152) G1_LOAD(blockIdx.x);
    for (int unit = blockIdx.x; unit < 1152; unit += F.G) {
        const int sidx = unit / 36, c = unit % 36, h = (sidx >> 1) & 3, dir = sidx & 1;
        bf16* QFg = WSP(bf16, WS_QF) + (size_t)unit * 64 * 128; bf16* KLTg = WSP(bf16, WS_KLT) + (size_t)unit * 128 * 64; bf16* ATTg = WSP(bf16, WS_ATT) + (size_t)unit * 64 * 64;
        bf16* VTg = WSP(bf16, WS_VT) + (size_t)unit * 256 * 64; float* DECg = WSP(float, WS_DEC) + (size_t)unit * 128;
#pragma unroll
        for (int q = 0; q < 4; ++q) { const int j = lane, sg = F.wave + 8 * q; const unsigned ww[4] = {pv[q].x, pv[q].y, pv[q].z, pv[q].w};
#pragma unroll
            for (int i = 0; i < 8; ++i) VTs[(sg * 8 + i) * 72 + j] = (bf16)((ww[i >> 1] >> ((i & 1) * 16)) & 0xffffu); }
#pragma unroll
        for (int q = 0; q < 2; ++q) LRs[tid + 512 * q] = bf2f(pl[q]);
#pragma unroll
        for (int q = 0; q < 4; ++q) WAs[tid + 512 * q] = pw[q];
        const float bav = pba;
        __syncthreads();
#pragma unroll
        for (int q = 0; q < 4; ++q) { const int piece = tid + 512 * q, e = piece >> 3, sg = piece & 7;
            *(u32x4*)(VTg + (size_t)e * 64 + sg * 8) = *(const LAS u32x4*)(VTs + e * 72 + sg * 8); }
        __syncthreads();
        { const int d = tid & 127, ig = tid >> 7; float wv[16];
#pragma unroll
          for (int r = 0; r < 16; ++r) wv[r] = WAs[r * 128 + d];
          float run = 0.f;
#pragma unroll 4
          for (int ii = 0; ii < 16; ++ii) { const int i = ig * 16 + ii; float z = bav;
#pragma unroll
              for (int r = 0; r < 16; ++r) z += LRs[i * 16 + r] * wv[r];
              const float ls = (fminf(z, 0.f) - __logf(1.0f + __expf(-fabsf(z)))) * (1.0f / 16.0f);
              run += ls; LAs[i * 132 + d] = run; }
          __syncthreads();
          float off = 0.f;
#pragma unroll
          for (int sgm = 0; sgm < 3; ++sgm) if (sgm < ig) off += LAs[(sgm * 16 + 15) * 132 + d];
          __syncthreads();
          if (ig > 0) {
#pragma unroll 4
              for (int ii = 0; ii < 16; ++ii) LAs[(ig * 16 + ii) * 132 + d] += off; }
          __syncthreads();
        }
#pragma unroll
        for (int q = 0; q < 2; ++q) { const int i = lane, sg = F.wave + 8 * q, d0 = sg * 8;
            const unsigned qa[4] = {pq[q].x, pq[q].y, pq[q].z, pq[q].w}, ka[4] = {pk[q].x, pk[q].y, pk[q].z, pk[q].w};
            float qf[8], kf[8], kl[8];
#pragma unroll
            for (int ii = 0; ii < 8; ++ii) { const float bc = LAs[i * 132 + d0 + ii], bl = LAs[63 * 132 + d0 + ii];
                const float qv = (ii & 1) ? __uint_as_float(qa[ii >> 1] & 0xffff0000u) : __uint_as_float(qa[ii >> 1] << 16);
                const float kv = (ii & 1) ? __uint_as_float(ka[ii >> 1] & 0xffff0000u) : __uint_as_float(ka[ii >> 1] << 16);
                const float e1 = __expf(bc);
                qf[ii] = qv * 0.08838834764831845f * e1; kf[ii] = kv * __builtin_amdgcn_rcpf(e1); kl[ii] = kv * __expf(bl - bc); }
            u32x4 qo, ko; qo.x = cvt_pk_bf16(qf[0], qf[1]); qo.y = cvt_pk_bf16(qf[2], qf[3]); qo.z = cvt_pk_bf16(qf[4], qf[5]); qo.w = cvt_pk_bf16(qf[6], qf[7]);
            ko.x = cvt_pk_bf16(kf[0], kf[1]); ko.y = cvt_pk_bf16(kf[2], kf[3]); ko.z = cvt_pk_bf16(kf[4], kf[5]); ko.w = cvt_pk_bf16(kf[6], kf[7]);
            *(LAS u32x4*)(QFs + i * 136 + d0) = qo; *(LAS u32x4*)(KFs + i * 136 + d0) = ko;
            if (c >= 4) *(u32x4*)(QFg + (size_t)i * 128 + d0) = qo;
#pragma unroll
            for (int ii = 0; ii < 8; ++ii) KLTs[(d0 + ii) * 72 + i] = (bf16)(cvt_pk_bf16(kl[ii], 0.f) & 0xffffu); }
        if (tid < 128) DECg[tid] = __expf(LAs[63 * 132 + tid]);
        if (unit + F.G < 1152) G1_LOAD(unit + F.G);
        __syncthreads();
        if (c >= 4) {
            const int it = F.wave >> 1;
#pragma unroll
            for (int jj = 0; jj < 2; ++jj) { const int jt = 2 * (F.wave & 1) + jj; f32x4 acc = (f32x4){0.f, 0.f, 0.f, 0.f};
#pragma unroll
                for (int ks = 0; ks < 4; ++ks) { const bf16x8 kfr = *(const LAS bf16x8*)(KFs + (16 * jt + fr) * 136 + 32 * ks + 8 * fq), qfr = *(const LAS bf16x8*)(QFs + (16 * it + fr) * 136 + 32 * ks + 8 * fq);
                    acc = __builtin_amdgcn_mfma_f32_16x16x32_bf16(kfr, qfr, acc, 0, 0, 0); }
                const int i = 16 * it + fr, j0 = 16 * jt + 4 * fq;
#pragma unroll
                for (int ii = 0; ii < 4; ++ii) if (j0 + ii > i) acc[ii] = 0.f;
                u32x2 w; w.x = cvt_pk_bf16(acc[0], acc[1]); w.y = cvt_pk_bf16(acc[2], acc[3]);
                *(u32x2*)(ATTg + (size_t)i * 64 + j0) = w; }
        }
#pragma unroll
        for (int q = 0; q < 2; ++q) { const int piece = tid + 512 * q, d = piece >> 3, sg = piece & 7;
            *(u32x4*)(KLTg + (size_t)d * 64 + sg * 8) = *(const LAS u32x4*)(KLTs + d * 72 + sg * 8); }
        __syncthreads();
    }
#undef G1_LOAD
}
__device__ __forceinline__ void gla_g2(Frame& F, int blk) {
    const int sidx = blk >> 2, sl = blk & 3, b = sidx >> 3, h = (sidx >> 1) & 3, dir = sidx & 1, tid = F.tid, lane = F.lane, fr = lane & 15, fq = lane >> 4, w = F.wave;
    bf16* OG = WSP(bf16, WS_OG);
    LAS bf16* QFs = (LAS bf16*)F.lds;
    LAS bf16* ATs = (LAS bf16*)(F.lds + 17408);
    LAS bf16* VTs = (LAS bf16*)(F.lds + 26624);
    LAS bf16* KLTs = (LAS bf16*)(F.lds + 35840);
    LAS float* DECs = (LAS float*)(F.lds + 54272);
    LAS bf16* STs = (LAS bf16*)(F.lds + 54784);
    const int et_s = w >> 1, dt0 = 4 * (w & 1);
    const int it_o = w >> 1, et0 = 2 * (w & 1);
    f32x4 Sacc[4];
#pragma unroll
    for (int i = 0; i < 4; ++i) Sacc[i] = (f32x4){0.f, 0.f, 0.f, 0.f};
    u32x4 rq[2], rk[2], ra, rv; f32x4 rd;
    rq[0] = rq[1] = ra = (u32x4){0u, 0u, 0u, 0u}; rd = (f32x4){0.f, 0.f, 0.f, 0.f};
#define G2_LOAD(cc) do { const size_t un = (size_t)sidx * 36 + (cc); \
        const bf16* kg = WSP(bf16, WS_KLT) + un * 128 * 64; const bf16* vg = WSP(bf16, WS_VT) + un * 256 * 64 + (size_t)sl * 64 * 64; \
        rk[0] = *(const u32x4*)(kg + (size_t)tid * 8); rk[1] = *(const u32x4*)(kg + (size_t)(tid + 512) * 8); rv = *(const u32x4*)(vg + (size_t)tid * 8); \
        if (tid < 32) rd = *(const f32x4*)(WSP(float, WS_DEC) + un * 128 + tid * 4); \
        if ((cc) >= 4) { const bf16* qg = WSP(bf16, WS_QF) + un * 64 * 128; const bf16* ag = WSP(bf16, WS_ATT) + un * 64 * 64; \
            rq[0] = *(const u32x4*)(qg + (size_t)tid * 8); rq[1] = *(const u32x4*)(qg + (size_t)(tid + 512) * 8); ra = *(const u32x4*)(ag + (size_t)tid * 8); } } while (0)
#define G2_STORE() do { \
        { const int d = tid >> 3, sg = tid & 7; *(LAS u32x4*)(KLTs + d * 72 + sg * 8) = rk[0]; *(LAS u32x4*)(KLTs + (d + 64) * 72 + sg * 8) = rk[1]; \
          *(LAS u32x4*)(VTs + d * 72 + sg * 8) = rv; *(LAS u32x4*)(ATs + d * 72 + sg * 8) = ra; } \
        { const int i = tid >> 4, sg = tid & 15; *(LAS u32x4*)(QFs + i * 136 + sg * 8) = rq[0]; *(LAS u32x4*)(QFs + (i + 32) * 136 + sg * 8) = rq[1]; } \
        if (tid < 32) *(LAS f32x4*)(DECs + tid * 4) = rd; } while (0)
    __syncthreads();
    G2_LOAD(0); G2_STORE();
    for (int i = tid; i < 64 * 136 / 2; i += 512) ((LAS unsigned*)STs)[i] = 0u;
    __syncthreads();
    for (int c = 0; c < 36; ++c) {
        if (c + 1 < 36) G2_LOAD(c + 1);
        if (c >= 4) {
#pragma unroll
            for (int ee = 0; ee < 2; ++ee) { const int et = et0 + ee; f32x4 acc = (f32x4){0.f, 0.f, 0.f, 0.f};
#pragma unroll
                for (int ks = 0; ks < 2; ++ks) acc = __builtin_amdgcn_mfma_f32_16x16x32_bf16(*(const LAS bf16x8*)(VTs + (16 * et + fr) * 72 + 32 * ks + 8 * fq), *(const LAS bf16x8*)(ATs + (16 * it_o + fr) * 72 + 32 * ks + 8 * fq), acc, 0, 0, 0);
#pragma unroll
                for (int ks = 0; ks < 4; ++ks) acc = __builtin_amdgcn_mfma_f32_16x16x32_bf16(*(const LAS bf16x8*)(STs + (16 * et + fr) * 136 + 32 * ks + 8 * fq), *(const LAS bf16x8*)(QFs + (16 * it_o + fr) * 136 + 32 * ks + 8 * fq), acc, 0, 0, 0);
                const int tp = c * 64 + 16 * it_o + fr, lrow = b * SEQ + (dir ? SEQ - 1 - (tp - CTXL) : tp - CTXL);
                *(u32x2*)(OG + ((size_t)dir * TL + lrow) * 1024 + h * 256 + sl * 64 + 16 * et + 4 * fq) = (mfma_settle(acc), f32_to_bf4(acc)); }
        }
#pragma unroll
        for (int dd = 0; dd < 4; ++dd) { const int dt = dt0 + dd; const f32x4 dec = *(const LAS f32x4*)(DECs + 16 * dt + 4 * fq);
            f32x4 acc = Sacc[dd] * dec;
#pragma unroll
            for (int ks = 0; ks < 2; ++ks) acc = __builtin_amdgcn_mfma_f32_16x16x32_bf16(*(const LAS bf16x8*)(KLTs + (16 * dt + fr) * 72 + 32 * ks + 8 * fq), *(const LAS bf16x8*)(VTs + (16 * et_s + fr) * 72 + 32 * ks + 8 * fq), acc, 0, 0, 0);
            Sacc[dd] = acc; }
        __syncthreads();
#pragma unroll
        for (int dd = 0; dd < 4; ++dd) { mfma_settle(Sacc[dd]); u32x2 wv; wv.x = cvt_pk_bf16(Sacc[dd][0], Sacc[dd][1]); wv.y = cvt_pk_bf16(Sacc[dd][2], Sacc[dd][3]);
            *(LAS u32x2*)(STs + (16 * et_s + fr) * 136 + 16 * (dt0 + dd) + 4 * fq) = wv; }
        if (c + 1 < 36) G2_STORE();
        __syncthreads();
    }
#undef G2_LOAD
#undef G2_STORE
}

__device__ __forceinline__ void phase_gla_out(Frame& F) {
    const int gw = blockIdx.x * 8 + F.wave, NGW = F.G * 8, lane = F.lane;
    const bf16* OG = WSP(bf16, WS_OG); const bf16* PROJ = WSP(bf16, WS_PROJ); bf16* MIX = WSP(bf16, WS_MIX);
    const f32x4 gn = *(const f32x4*)(F.in[I_GN] + 4 * lane);
    for (int row = gw; row < TL; row += NGW) {
#pragma unroll
        for (int h = 0; h < 4; ++h) {
            const f32x4 of = bf4_to_f32(*(const u32x2*)(OG + (size_t)row * 1024 + h * 256 + 4 * lane)), ob = bf4_to_f32(*(const u32x2*)(OG + ((size_t)TL + row) * 1024 + h * 256 + 4 * lane));
            const f32x4 ov = of + ob;
            const float rstd = 1.0f / sqrtf(wave_sum((ov[0] * ov[0] + ov[1] * ov[1]) + (ov[2] * ov[2] + ov[3] * ov[3])) * (1.0f / 256.0f) + EPS);
            const u32x2 gw2 = *(const u32x2*)(PROJ + (size_t)row * NPROJ + C_GG + h * 256 + 4 * lane);
            const float g0 = __uint_as_float(gw2.x << 16), g1 = __uint_as_float(gw2.x & 0xffff0000u), g2 = __uint_as_float(gw2.y << 16), g3 = __uint_as_float(gw2.y & 0xffff0000u);
            const float y0 = ov[0] * rstd * gn[0] * silu_f(g0), y1 = ov[1] * rstd * gn[1] * silu_f(g1), y2 = ov[2] * rstd * gn[2] * silu_f(g2), y3 = ov[3] * rstd * gn[3] * silu_f(g3);
            u32x2 wv; wv.x = cvt_pk_bf16(y0, y1); wv.y = cvt_pk_bf16(y2, y3);
            *(u32x2*)(MIX + (size_t)row * D + 1024 + h * 256 + 4 * lane) = wv;
        }
    }
}

__device__ __forceinline__ void phase_route(Frame& F, int layer, const bf16* xin) {
    const int lane = F.lane, w = F.wave, fr = lane & 15, fq = lane >> 4;
    const float* MOD = WSP(float, WS_MOD) + (size_t)layer * 5 * 12288; bf16* HA = WSP(bf16, WS_HA);
    unsigned* route = WSP(unsigned, WS_ROUTE) + (size_t)layer * TL * 8; int* list = WSP(int, WS_LIST) + (size_t)layer * 32 * 8192;
    unsigned* cnt = WSP(unsigned, WS_CTL) + CW_CNT + layer * 32 * 64;
    const float* rb = F.in[I_RB];
    LAS unsigned char* XS = F.lds; LAS unsigned char* HI0 = F.lds + LDS_TOK + 4096;
    LAS float* RS = (LAS float*)HI0;
    LAS unsigned* LCNT = (LAS unsigned*)(HI0 + 128); LAS unsigned* LBASE = (LAS unsigned*)(HI0 + 256); LAS float* RBL = (LAS float*)(HI0 + 384);
    LAS float* LOG = (LAS float*)(HI0 + 512);
    LAS float* PART = (LAS float*)F.lds;
    for (int it = 0; it * F.G * 32 < TL; ++it) {
        const int row0b = (it * F.G + (int)blockIdx.x) * 32;
        if (row0b >= TL) break;
        const int b = row0b / SEQ; const float* shift = MOD + (size_t)b * 12288 + 3 * 2048; const float* scale = MOD + (size_t)b * 12288 + 4 * 2048;
        const bf16* RH = WSP(bf16, WS_RWT_HI) + ((size_t)((layer * 4 + b) * 8 + w) * 1024 + lane) * 8; const bf16* RL = WSP(bf16, WS_RWT_LO) + ((size_t)((layer * 4 + b) * 8 + w) * 1024 + lane) * 8;
        __syncthreads();
        if (F.tid < 32) { LCNT[F.tid] = 0u; const float* bp = WSP(float, WS_RBIAS) + (size_t)(layer * 4 + b) * 16 * 32 + F.tid; float t = 0.f;
#pragma unroll
            for (int p = 0; p < 16; ++p) t += bp[p * 32];
            RBL[F.tid] = t; }
        bf16x8 bh[8][2], bl[8][2];
        { u32x4 v[4][4];
#pragma unroll
          for (int k = 0; k < 4; ++k)
#pragma unroll
              for (int j = 0; j < 4; ++j) v[k][j] = *(const u32x4*)(xin + (size_t)(row0b + 4 * w + k) * D + 8 * (64 * j + lane));
#pragma unroll
          for (int ks = 0; ks < 4; ++ks)
#pragma unroll
              for (int nt = 0; nt < 2; ++nt) { bh[ks][nt] = *(const bf16x8*)(RH + (size_t)(ks * 2 + nt) * 512); bl[ks][nt] = *(const bf16x8*)(RL + (size_t)(ks * 2 + nt) * 512); }
#pragma unroll
          for (int k = 0; k < 4; ++k)
#pragma unroll
              for (int j = 0; j < 4; ++j) { const int rr = 4 * w + k; *(LAS u32x4*)(XS + rr * 4096 + 16 * ((64 * j + lane) ^ (rr & 15))) = v[k][j]; }
#pragma unroll
          for (int k = 0; k < 4; ++k) { float ss = 0.f; f32x4 xa[4][2];
#pragma unroll
              for (int j = 0; j < 4; ++j) { u32x2 lo2, hi2; lo2.x = v[k][j].x; lo2.y = v[k][j].y; hi2.x = v[k][j].z; hi2.y = v[k][j].w; xa[j][0] = bf4_to_f32(lo2); xa[j][1] = bf4_to_f32(hi2);
#pragma unroll
                  for (int q = 0; q < 2; ++q) ss += (xa[j][q][0] * xa[j][q][0] + xa[j][q][1] * xa[j][q][1]) + (xa[j][q][2] * xa[j][q][2] + xa[j][q][3] * xa[j][q][3]); }
              const float rsk = 1.0f / sqrtf(wave_sum(ss) * (1.0f / D) + EPS);
              if (lane == 0) RS[4 * w + k] = rsk;
#pragma unroll
              for (int j = 0; j < 4; ++j) { const int c = 8 * (64 * j + lane); u32x4 o;
#pragma unroll
                  for (int q = 0; q < 2; ++q) { const f32x4 sh = *(const f32x4*)(shift + c + 4 * q), sc = *(const f32x4*)(scale + c + 4 * q);
                      const f32x4 y = xa[j][q] * rsk * (sc + 1.0f) + sh; const u32x2 p = f32_to_bf4(y); if (q == 0) { o.x = p.x; o.y = p.y; } else { o.z = p.x; o.w = p.y; } }
                  *(u32x4*)(HA + (size_t)(row0b + 4 * w + k) * D + c) = o; } } }
#pragma unroll
        for (int ks = 4; ks < 8; ++ks)
#pragma unroll
            for (int nt = 0; nt < 2; ++nt) { bh[ks][nt] = *(const bf16x8*)(RH + (size_t)(ks * 2 + nt) * 512); bl[ks][nt] = *(const bf16x8*)(RL + (size_t)(ks * 2 + nt) * 512); }
        asm volatile("s_waitcnt lgkmcnt(0)" ::: "memory"); __builtin_amdgcn_s_barrier(); asm volatile("" ::: "memory");
        { f32x4 acc[2][2];
#pragma unroll
          for (int mt = 0; mt < 2; ++mt)
#pragma unroll
              for (int nt = 0; nt < 2; ++nt) acc[mt][nt] = (f32x4){0.f, 0.f, 0.f, 0.f};
#pragma unroll
          for (int ks = 0; ks < 8; ++ks) {
              bf16x8 ax[2];
#pragma unroll
              for (int mt = 0; mt < 2; ++mt) ax[mt] = *(const LAS bf16x8*)(XS + (16 * mt + fr) * 4096 + 16 * ((32 * w + 4 * ks + fq) ^ fr));
#pragma unroll
              for (int nt = 0; nt < 2; ++nt)
#pragma unroll
                  for (int mt = 0; mt < 2; ++mt) { acc[mt][nt] = __builtin_amdgcn_mfma_f32_16x16x32_bf16(bh[ks][nt], ax[mt], acc[mt][nt], 0, 0, 0);
                      acc[mt][nt] = __builtin_amdgcn_mfma_f32_16x16x32_bf16(bl[ks][nt], ax[mt], acc[mt][nt], 0, 0, 0); } }
          asm volatile("s_waitcnt lgkmcnt(0)" ::: "memory"); __builtin_amdgcn_s_barrier(); asm volatile("" ::: "memory");
#pragma unroll
          for (int mt = 0; mt < 2; ++mt)
#pragma unroll
              for (int nt = 0; nt < 2; ++nt) *(LAS f32x4*)(PART + (w * 32 + 16 * mt + fr) * 32 + 16 * nt + 4 * fq) = acc[mt][nt]; }
        __syncthreads();
#pragma unroll
        for (int q = 0; q < 2; ++q) { const int o = F.tid + 512 * q; float sum = 0.f;
#pragma unroll
            for (int ww = 0; ww < 8; ++ww) sum += PART[ww * 1024 + o];
            LOG[o] = RS[o >> 5] * sum + RBL[o & 31]; }
        __syncthreads();
        int i1s[4], i2s[4]; float a1s[4], a2s[4];
#pragma unroll
        for (int k = 0; k < 4; ++k) {
            const float mylg = LOG[(4 * w + k) * 32 + (lane & 31)];
            const float myscore = 1.0f / (1.0f + expf(-mylg)), mybias = myscore + rb[lane & 31];
            float m1 = -3.0e38f, m2 = -3.0e38f, w1 = 0.f, w2 = 0.f; int i1 = 0, i2 = 0;
            const int gbase = lane & 24;
#pragma unroll
            for (int i = 0; i < 8; ++i) { const float x = __shfl(mybias, gbase + i), sx = __shfl(myscore, gbase + i);
                if (x > m1) { m2 = m1; i2 = i1; w2 = w1; m1 = x; i1 = i; w1 = sx; } else if (x > m2) { m2 = x; i2 = i; w2 = sx; } }
            const float gs = m1 + m2;
            int gsel = 0; float gbest = __shfl(gs, 0);
#pragma unroll
            for (int g = 1; g < 4; ++g) { const float x = __shfl(gs, 8 * g); if (x > gbest) { gbest = x; gsel = g; } }
            i1 = __shfl(i1, 8 * gsel) + 8 * gsel; i2 = __shfl(i2, 8 * gsel) + 8 * gsel; w1 = __shfl(w1, 8 * gsel); w2 = __shfl(w2, 8 * gsel);
            const float wsum = w1 + w2; i1s[k] = i1; i2s[k] = i2; a1s[k] = w1 / wsum; a2s[k] = w2 / wsum;
        }
        { const int tk = (lane >> 1) & 3, ch = lane & 1;
          int e1 = i1s[0], e2 = i2s[0]; float q1 = a1s[0], q2 = a2s[0];
#pragma unroll
          for (int k = 1; k < 4; ++k) { e1 = (tk == k) ? i1s[k] : e1; e2 = (tk == k) ? i2s[k] : e2; q1 = (tk == k) ? a1s[k] : q1; q2 = (tk == k) ? a2s[k] : q2; }
          const int e = ch ? e2 : e1; const int row = row0b + 4 * w + tk;
          unsigned pos = 0u;
          if (lane < 8) pos = __hip_atomic_fetch_add(LCNT + e, 1u, __ATOMIC_RELAXED, __HIP_MEMORY_SCOPE_WORKGROUP);
          __syncthreads();
          if (F.tid < 32) { const unsigned n = LCNT[F.tid]; LBASE[F.tid] = n ? atomicAdd(cnt + F.tid * 64, n) : 0u; }
          __syncthreads();
          if (lane < 8) { pos += LBASE[e]; list[e * 8192 + pos] = row; }
          const unsigned pa = __shfl(pos, lane & ~1), pb2 = __shfl(pos, lane | 1);
          if (lane < 8 && ch == 0) { u32x4 r0; r0.x = (unsigned)e1; r0.y = (unsigned)e2; r0.z = pa; r0.w = pb2; *(u32x4*)(route + (size_t)row * 8) = r0;
              u32x2 r1; r1.x = __float_as_uint(q1); r1.y = __float_as_uint(q2); *(u32x2*)(route + (size_t)row * 8 + 4) = r1; } }
    }
}
__device__ __forceinline__ void moe_setup(Frame& F, int layer, bool want_tok, int nN) {
    LAS int* pb = (LAS int*)(F.lds + LDS_PB); LAS int* tokt = (LAS int*)(F.lds + LDS_TOK);
    const unsigned* cnt = WSP(unsigned, WS_CTL) + CW_CNT + layer * 32 * 64; const int* list = WSP(int, WS_LIST) + (size_t)layer * 32 * 8192;
    if (F.tid == 0) { int s = 0; for (int e = 0; e < 32; ++e) { pb[e] = s; s += ((int)cnt[e * 64] + 255) >> 8; } pb[32] = s; }
    __syncthreads();
    if (want_tok) {
        pg8::MoeOrder<true> S; S.pb = pb; S.tokt = tokt; S.G = F.G; S.c = F.vcu; S.nN = nN; S.estride = 0;
        for (int i = 0; i < 4; ++i) { pg8::Unit u; if (!S.next(i, u)) break;
            if (F.tid < 256) { const int pos = (u.pm - pb[u.e]) * 256 + F.tid; const int n = (int)cnt[u.e * 64]; tokt[i * 256 + F.tid] = pos < n ? list[u.e * 8192 + pos] : 0; } }
        __syncthreads();
    }
}
struct CombRow { u32x2 ya[8], yb[8], xi[8]; float w0, w1; };
struct CombRoute { u32x4 r0; u32x2 r1; };
__device__ __forceinline__ CombRoute comb_route(const unsigned* route, int row) { CombRoute r; r.r0 = *(const u32x4*)(route + (size_t)row * 8); r.r1 = *(const u32x2*)(route + (size_t)row * 8 + 4); return r; }
__device__ __forceinline__ void comb_issue(CombRow& R, const CombRoute& rt, const LAS int* pb, const bf16* Y, const bf16* xin, int row, int lane) {
    const size_t s0 = (size_t)pb[rt.r0.x] * 256 + rt.r0.z, s1 = (size_t)pb[rt.r0.y] * 256 + rt.r0.w; R.w0 = __uint_as_float(rt.r1.x); R.w1 = __uint_as_float(rt.r1.y);
#pragma unroll
    for (int j = 0; j < 8; ++j) { const int c = 4 * (64 * j + lane);
        R.ya[j] = *(const u32x2*)(Y + s0 * D + c); R.yb[j] = *(const u32x2*)(Y + s1 * D + c); R.xi[j] = *(const u32x2*)(xin + (size_t)row * D + c); }
}
template <class TO> __device__ __forceinline__ void comb_finish2(const CombRow& A, const CombRow& B, const float* gate, TO* xout, bool next_mod, const float* modn, bf16* HA, int row, int lane) {
    f32x4 va[8], vb[8];
#pragma unroll
    for (int j = 0; j < 8; ++j) { const int c = 4 * (64 * j + lane); const f32x4 g = *(const f32x4*)(gate + c);
#pragma unroll
        for (int h = 0; h < 2; ++h) { const CombRow& R = h ? B : A; const u32x2 ya = R.ya[j], yb = R.yb[j]; const float w0 = R.w0, w1 = R.w1;
            f32x4 y; y[0] = w0 * __uint_as_float(ya.x << 16) + w1 * __uint_as_float(yb.x << 16); y[1] = w0 * __uint_as_float(ya.x & 0xffff0000u) + w1 * __uint_as_float(yb.x & 0xffff0000u);
            y[2] = w0 * __uint_as_float(ya.y << 16) + w1 * __uint_as_float(yb.y << 16); y[3] = w0 * __uint_as_float(ya.y & 0xffff0000u) + w1 * __uint_as_float(yb.y & 0xffff0000u);
            const f32x4 v = bf4_to_f32(R.xi[j]) + g * y; if (h) vb[j] = v; else va[j] = v;
            if constexpr (sizeof(TO) == 4) *(f32x4*)((float*)xout + (size_t)(row + h) * D + c) = v; else *(u32x2*)((bf16*)xout + (size_t)(row + h) * D + c) = f32_to_bf4(v); } }
    if (next_mod) {
        float sa = 0.f, sb = 0.f;
#pragma unroll
        for (int j = 0; j < 8; ++j) { sa += (va[j][0] * va[j][0] + va[j][1] * va[j][1]) + (va[j][2] * va[j][2] + va[j][3] * va[j][3]); sb += (vb[j][0] * vb[j][0] + vb[j][1] * vb[j][1]) + (vb[j][2] * vb[j][2] + vb[j][3] * vb[j][3]); }
        const float ra = 1.0f / sqrtf(wave_sum(sa) * (1.0f / D) + EPS), rb = 1.0f / sqrtf(wave_sum(sb) * (1.0f / D) + EPS);
#pragma unroll
        for (int j = 0; j < 8; ++j) { const int c = 4 * (64 * j + lane); const f32x4 sh = *(const f32x4*)(modn + c), sc = *(const f32x4*)(modn + 2048 + c) + 1.0f;
            const f32x4 ya = va[j] * ra * sc + sh, yb = vb[j] * rb * sc + sh;
            *(u32x2*)(HA + (size_t)row * D + c) = f32_to_bf4(ya); *(u32x2*)(HA + (size_t)(row + 1) * D + c) = f32_to_bf4(yb); }
    }
}
template <class TO> __device__ __forceinline__ void phase_combine(Frame& F, int layer, const bf16* xin, TO* xout, bool next_mod) {
    const int gw = blockIdx.x * 8 + F.wave, NGW = F.G * 8, lane = F.lane;
    const float* MOD = WSP(float, WS_MOD) + (size_t)layer * 5 * 12288; const float* MODN = WSP(float, WS_MOD) + (size_t)(layer + 1) * 5 * 12288;
    const unsigned* route = WSP(unsigned, WS_ROUTE) + (size_t)layer * TL * 8; const bf16* Y = WSP(bf16, WS_Y); bf16* HA = WSP(bf16, WS_HA);
    const LAS int* pb = (const LAS int*)(F.lds + LDS_PB);
    if (2 * gw >= TL) return;
    CombRoute ra = comb_route(route, 2 * gw), rb = comb_route(route, 2 * gw + 1);
    for (int row = 2 * gw; row < TL; row += 2 * NGW) {
        CombRow A, B;
        comb_issue(A, ra, pb, Y, xin, row, lane);
        comb_issue(B, rb, pb, Y, xin, row + 1, lane);
        const int nrow = min(row + 2 * NGW, TL - 2); ra = comb_route(route, nrow); rb = comb_route(route, nrow + 1);
        const int b = row / SEQ;
        comb_finish2<TO>(A, B, MOD + (size_t)b * 12288 + 5 * 2048, xout, next_mod, MODN + (size_t)b * 12288, HA, row, lane);
    }
}
__device__ __forceinline__ void phase_conv(Frame& F) {
    const bf16* GB = WSP(bf16, WS_GB); const bf16* P = WSP(bf16, WS_PGU); bf16* Z = WSP(bf16, WS_Z); const float* cw = F.in[I_CW];
    const size_t total = (size_t)TL * D / 8;
    for (size_t i = (size_t)blockIdx.x * 512 + F.tid; i < total; i += (size_t)F.G * 512) {
        const int row = (int)(i >> 8), c = (int)(i & 255) * 8, t = row % SEQ;
        const u32x4 pc = *(const u32x4*)(P + (size_t)row * D + c), gb = *(const u32x4*)(GB + (size_t)row * D + c);
        u32x4 pm = (u32x4){0u, 0u, 0u, 0u}, pp = (u32x4){0u, 0u, 0u, 0u};
        if (t > 0) pm = *(const u32x4*)(P + (size_t)(row - 1) * D + c);
        if (t < SEQ - 1) pp = *(const u32x4*)(P + (size_t)(row + 1) * D + c);
        const unsigned am[4] = {pm.x, pm.y, pm.z, pm.w}, ac[4] = {pc.x, pc.y, pc.z, pc.w}, ap[4] = {pp.x, pp.y, pp.z, pp.w}, ag[4] = {gb.x, gb.y, gb.z, gb.w};
        unsigned ow[4];
#pragma unroll
        for (int q = 0; q < 4; ++q) { float r[2];
#pragma unroll
            for (int hh = 0; hh < 2; ++hh) { const int cc = c + 2 * q + hh;
                const float vm = hh ? __uint_as_float(am[q] & 0xffff0000u) : __uint_as_float(am[q] << 16), vc = hh ? __uint_as_float(ac[q] & 0xffff0000u) : __uint_as_float(ac[q] << 16);
                const float vp = hh ? __uint_as_float(ap[q] & 0xffff0000u) : __uint_as_float(ap[q] << 16), vg = hh ? __uint_as_float(ag[q] & 0xffff0000u) : __uint_as_float(ag[q] << 16);
                r[hh] = vg * (cw[cc] * vm + cw[2048 + cc] * vc + cw[4096 + cc] * vp); }
            ow[q] = cvt_pk_bf16(r[0], r[1]); }
        u32x4 o; o.x = ow[0]; o.y = ow[1]; o.z = ow[2]; o.w = ow[3];
        *(u32x4*)(Z + (size_t)row * D + c) = o;
    }
}

constexpr int NPHASE = 18;
__global__ void __launch_bounds__(512, 2) fwd_kernel(Args args) {
    extern __shared__ __attribute__((aligned(16))) unsigned char lds_raw[];
    Frame F;
    F.lds = (LAS unsigned char*)lds_raw; F.out = args.out; F.ws = args.ws;
#pragma unroll
    for (int i = 0; i < 22; ++i) F.in[i] = args.in[i];
    F.tid = threadIdx.x; F.lane = F.tid & 63; F.wave = __builtin_amdgcn_readfirstlane(F.tid >> 6); F.G = gridDim.x;
    { const int bx = blockIdx.x; F.vcu = (F.G % 8 == 0) ? (bx % 8) * (F.G / 8) + bx / 8 : bx; }
    volatile LAS unsigned* MISC = (volatile LAS unsigned*)(F.lds + LDS_MISC);
    if (F.tid < 64) MISC[F.tid] = 0u;
    __syncthreads();
    const int lo = args.ph_lo, hi = args.ph_hi;
    XcdBarrier bar; bar.bar = WSP(unsigned, WS_CTL) + CW_BAR; bar.x = 0; bar.st = nullptr;
    if (hi - lo > 1) bar = xcd_barrier_post(WSP(unsigned, WS_CTL) + CW_BAR, MISC + 8);
#ifndef PH_MASK
#define PH_MASK 0xFFFFFFFFu
#endif
#define IN(k) (((PH_MASK >> (k)) & 1u) && lo <= (k) && (k) < hi)
#define SEAM(k) do { if (IN(k) && IN((k) + 1)) xcd_barrier(bar); } while (0)
    const float* MOD = WSP(float, WS_MOD);

    if (IN(0)) { phase0(F); } SEAM(0);
    if (IN(1)) { phase_modulate0(F); } SEAM(1);
    if (IN(2)) {
        pg8::Gemm g{WSP(bf16, WS_HA), WSP(bf16, WS_WIN_T), D}; pg8::StaticOrder S; S.init(TA, NPROJ, F.G, (int)blockIdx.x);
        pg8::EpiBf16 E{WSP(bf16, WS_PROJ), NPROJ};
        const int grp = F.vcu & 3;
        pg8::StaticOrder Sa; Sa.init(TA, NPROJ, F.G, (int)blockIdx.x); Sa.ilo = 0; Sa.ihi = grp;
        pg8::StaticOrder Sb; Sb.init(TA, NPROJ, F.G, (int)blockIdx.x); Sb.ilo = grp; Sb.ihi = 1 << 30;
        pg8::gemm_phase<pg8::EpiBf16, pg8::StaticOrder, true>(F.lds, g, Sa, E);
        convert_claim(F, 30, 0);
        pg8::gemm_phase<pg8::EpiBf16, pg8::StaticOrder, true>(F.lds, g, Sb, E);
        if (2L * F.G + (long)blockIdx.x >= (long)(TA / 256) * (NPROJ / 256)) convert_claim(F, 18, 0);
    } SEAM(2);
    if (IN(3)) { phase_prep(F); gla_g1_all(F); } SEAM(3);
    if (IN(4)) {
        if (blockIdx.x < 128) { gla_g2(F, blockIdx.x); convert_claim(F, 6, 0); }
        else { const int st = F.G > 129 ? F.G - 128 : 1; for (int u = blockIdx.x - 128; u < 256; u += st) attn_unit(F, u); }
    } SEAM(4);
    if (IN(5)) { phase_gla_out(F); } SEAM(5);
    if (IN(6)) {
        pg8::Gemm g{WSP(bf16, WS_MIX), WSP(bf16, WS_WOUT_T), D}; pg8::StaticOrder S; S.init(TL, D, F.G, (int)blockIdx.x);
        pg8::EpiResGate<false> E{F.in[I_X], WSP(bf16, WS_X1), MOD + 2 * 2048, 12288};
        if ((F.vcu & 1) == 0) convert_claim(F, 12, 0);
        pg8::gemm_phase<pg8::EpiResGate<false>, pg8::StaticOrder, false>(F.lds, g, S, E);
        convert_claim(F, 0, CV_B0);
    } SEAM(6);
#define MOE_PHASES(layer, pbase, xin, xout, nextmod) \
    if (IN(pbase)) { phase_route(F, layer, xin); } SEAM(pbase); \
    if (IN((pbase) + 1)) { \
        moe_setup(F, layer, true, 8); \
        pg8::Gemm g{WSP(bf16, WS_HA), WSP(bf16, WS_W13_T) + (size_t)(layer) * 32 * 2048 * 2048, D}; \
        pg8::MoeOrder<true> S; S.pb = (const LAS int*)(F.lds + LDS_PB); S.tokt = (const LAS int*)(F.lds + LDS_TOK); S.G = F.G; S.c = F.vcu; S.nN = 8; S.estride = (size_t)2048 * 2048 * 2; \
        pg8::EpiPair<true> E{WSP(bf16, WS_HMID), DEXP, 0, nullptr, 0}; \
        pg8::gemm_phase<pg8::EpiPair<true>, pg8::MoeOrder<true>, true>(F.lds, g, S, E); \
        { const int tot = S.pb[32] * 8, mx = (tot + F.G - 1) / F.G, mine = tot > F.vcu ? (tot - F.vcu + F.G - 1) / F.G : 0; convert_claim(F, mine < mx ? 12 : 0, (layer) == 0 ? CV_B1 : CV_B3); } \
    } SEAM((pbase) + 1); \
    if (IN((pbase) + 2)) { \
        moe_setup(F, layer, false, 8); \
        pg8::Gemm g{WSP(bf16, WS_HMID), WSP(bf16, WS_W2_T) + (size_t)(layer) * 32 * 2048 * 1024, DEXP}; \
        pg8::MoeOrder<false> S; S.pb = (const LAS int*)(F.lds + LDS_PB); S.tokt = nullptr; S.G = F.G; S.c = F.vcu; S.nN = 8; S.estride = (size_t)2048 * 1024 * 2; \
        pg8::EpiBf16 E{WSP(bf16, WS_Y), D}; \
        pg8::gemm_phase<pg8::EpiBf16, pg8::MoeOrder<false>, true>(F.lds, g, S, E); \
        if ((layer) == 0) { const int tot = S.pb[32] * 8, mx = (tot + F.G - 1) / F.G, mine = tot > F.vcu ? (tot - F.vcu + F.G - 1) / F.G : 0; if (mine < mx) convert_claim(F, 6, 0); } \
    } SEAM((pbase) + 2); \
    if (IN((pbase) + 3)) { moe_setup(F, layer, false, 8); phase_combine(F, layer, xin, xout, nextmod); }

    MOE_PHASES(0, 7, WSP(bf16, WS_X1), WSP(bf16, WS_X2), true)
    SEAM(10);
    if (IN(11)) {
        pg8::Gemm g{WSP(bf16, WS_HA), WSP(bf16, WS_CIN_T), D}; pg8::StaticOrder S; S.init(TL, 6144, F.G, (int)blockIdx.x);
        pg8::EpiPair<false> E{WSP(bf16, WS_PGU), D, 8, WSP(bf16, WS_GB), D};
        const int grp = F.vcu & 3;
        pg8::StaticOrder Sa; Sa.init(TL, 6144, F.G, (int)blockIdx.x); Sa.ilo = 0; Sa.ihi = grp;
        pg8::StaticOrder Sb; Sb.init(TL, 6144, F.G, (int)blockIdx.x); Sb.ilo = grp; Sb.ihi = 1 << 30;
        pg8::gemm_phase<pg8::EpiPair<false>, pg8::StaticOrder, true>(F.lds, g, Sa, E);
        convert_claim(F, 30, 0);
        pg8::gemm_phase<pg8::EpiPair<false>, pg8::StaticOrder, true>(F.lds, g, Sb, E);
    } SEAM(11);
    if (IN(12)) { phase_conv(F); } SEAM(12);
    if (IN(13)) {
        pg8::Gemm g{WSP(bf16, WS_Z), WSP(bf16, WS_COUT_T), D}; pg8::StaticOrder S; S.init(TL, D, F.G, (int)blockIdx.x);
        pg8::EpiResGate<true> E{WSP(bf16, WS_X2), WSP(bf16, WS_X3), MOD + 5 * 12288 + 2 * 2048, 12288};
        if ((F.vcu & 1) == 0) convert_claim(F, 12, 0);
        pg8::gemm_phase<pg8::EpiResGate<true>, pg8::StaticOrder, false>(F.lds, g, S, E);
        convert_claim(F, 0, CV_B2);
    } SEAM(13);
    MOE_PHASES(1, 14, WSP(bf16, WS_X3), F.out, false)
#undef MOE_PHASES
#undef IN
#undef SEAM
}

extern "C" void kernel_launch(void* const* d_in, const int* in_sizes, int n_in, void* d_out, int out_size, void* d_ws, size_t ws_size, hipStream_t stream) {
    static int grid = 0;
    if (grid == 0) {
        if (n_in != 22 || out_size != TL * D || ws_size < WS_END) { fprintf(stderr, "kernel_launch: unexpected problem (n_in %d, out %d, ws %zu < %zu)\n", n_in, out_size, ws_size, (size_t)WS_END); grid = -1; return; }
        int dev = 0, cus = 0, per_cu = 0;
        if (hipGetDevice(&dev) != hipSuccess || hipDeviceGetAttribute(&cus, hipDeviceAttributeMultiprocessorCount, dev) != hipSuccess) { grid = -1; return; }
        if (hipFuncSetAttribute((const void*)fwd_kernel, hipFuncAttributeMaxDynamicSharedMemorySize, LDS_BYTES) != hipSuccess) { fprintf(stderr, "kernel_launch: hipFuncSetAttribute failed\n"); grid = -1; return; }
        if (hipOccupancyMaxActiveBlocksPerMultiprocessor(&per_cu, (const void*)fwd_kernel, 512, LDS_BYTES) != hipSuccess || per_cu < 1) { fprintf(stderr, "kernel_launch: occupancy query says %d\n", per_cu); }
        (void)hipGetLastError();
        grid = cus;
    }
    if (grid < 0) return;
    (void)hipMemsetAsync((char*)d_ws + WS_CTL, 0, CTL_ZERO_BYTES, stream);
    Args a{};
    for (int i = 0; i < 22; ++i) a.in[i] = (const float*)d_in[i];
    a.out = (float*)d_out; a.ws = (unsigned char*)d_ws;
#if MK_N_LAUNCHES == 1
    a.ph_lo = 0; a.ph_hi = NPHASE;
    hipLaunchKernelGGL(fwd_kernel, dim3(grid), dim3(512), LDS_BYTES, stream, a);
#else
    for (int p = 0; p < NPHASE; ++p) { a.ph_lo = p; a.ph_hi = p + 1; hipLaunchKernelGGL(fwd_kernel, dim3(grid), dim3(512), LDS_BYTES, stream, a); }
#endif
}
```
